# Optimizing an MI355X kernel written in HIP

```python
import math
import jax, jax.numpy as jnp
from jax import lax
import numpy as np

D_MODEL = 2048
BATCH = 4
SEQ = 2048
DEPTH = 2

A_HEADS = 16
A_KV_HEADS = 4
A_HEAD_DIM = 128
IDX_HEADS = 16
IDX_DIM = 64
TOPK_MAX = 256
B_DILATIONS = ((128, 1), (512, 4), (2048, 16))
N_GROUPS = 3
B_HEADS = 16
B_HEAD_DIM = 64
N_BUCKETS = 32
MAX_DISTANCE = 2048
BIAS_HEADS = 16
D_FF = 5632
N_EXPERTS = 8
TOP_K_EXPERTS = 2
D_FF_EXPERT = 7168
QBLOCK = 128
EPS = 1e-6

N_A = DEPTH // 2
N_B = DEPTH - N_A
N_DENSE = (DEPTH + 1) // 2
N_MOE = DEPTH // 2
A_Q = A_HEADS * A_HEAD_DIM
A_KV = A_KV_HEADS * A_HEAD_DIM
A_QI = IDX_HEADS * IDX_DIM
A_IN = A_Q + 2 * A_KV + A_QI + IDX_DIM + IDX_HEADS
B_Q = N_GROUPS * B_HEADS * B_HEAD_DIM
B_OUT = B_HEADS * B_HEAD_DIM

kernel_name = "yoco_dsa_dilated_moe_trunk"


def rmsnorm(x, g):
    xf = x.astype(jnp.float32)
    y = xf * lax.rsqrt(jnp.mean(xf * xf, axis=-1, keepdims=True) + EPS)
    return (y * g.astype(jnp.float32)).astype(x.dtype)


def modulate(h, shift, scale):
    return h * (1 + scale[:, None, :]) + shift[:, None, :]


def t5_bucket(rel):
    n = jnp.maximum(rel, 0)
    max_exact = N_BUCKETS // 2
    nf = jnp.maximum(n, 1).astype(jnp.float32)
    large = max_exact + (jnp.log(nf / max_exact) / math.log(MAX_DISTANCE / max_exact)
                         * (N_BUCKETS - max_exact)).astype(jnp.int32)
    large = jnp.minimum(large, N_BUCKETS - 1)
    return jnp.where(n < max_exact, n, large)


def swiglu(h, w1, w3, w2):
    return (jax.nn.silu(h @ w1) * (h @ w3)) @ w2


def dsa_attention(h, pos, w_in, w_out, g_qn, g_kn, rel_bias):
    b_, s_len, _ = h.shape
    proj = h @ w_in
    cuts = [A_Q, A_Q + A_KV, A_Q + 2 * A_KV, A_Q + 2 * A_KV + A_QI, A_Q + 2 * A_KV + A_QI + IDX_DIM]
    q, k, v, qi, ki, wi = jnp.split(proj, cuts, axis=-1)
    q = rmsnorm(q.reshape(b_, s_len, A_HEADS, A_HEAD_DIM), g_qn)
    k = rmsnorm(k.reshape(b_, s_len, A_KV_HEADS, A_HEAD_DIM), g_kn)
    v = v.reshape(b_, s_len, A_KV_HEADS, A_HEAD_DIM)
    qi = qi.reshape(b_, s_len, IDX_HEADS, IDX_DIM)
    wi = wi * (IDX_HEADS ** -0.5)
    topk = min(TOPK_MAX, s_len // 4)
    nq = s_len // QBLOCK
    grp = A_HEADS // A_KV_HEADS
    scale = A_HEAD_DIM ** -0.5

    def to_blocks(a):
        return jnp.moveaxis(a.reshape((b_, nq, QBLOCK) + a.shape[2:]), 1, 0)

    def block(args):
        bi, qb, qib, wib, qpos = args
        t = bi * QBLOCK + jnp.arange(QBLOCK)
        causal = jnp.arange(s_len)[None, :] <= t[:, None]
        isc = jnp.einsum('bqhd,bsd->bqhs', qib, ki, preferred_element_type=jnp.float32)
        isc = jnp.einsum('bqhs,bqh->bqs', jax.nn.relu(isc) * (IDX_DIM ** -0.5),
                         wib.astype(jnp.float32))
        isc = jnp.where(causal[None], isc, -jnp.inf)
        _, sel = lax.top_k(isc, topk)
        valid = sel <= t[None, :, None]
        flat = sel.reshape(b_, QBLOCK * topk)
        kg = jnp.take_along_axis(k, flat[:, :, None, None], axis=1).reshape(
            b_, QBLOCK, topk, A_KV_HEADS, A_HEAD_DIM)
        vg = jnp.take_along_axis(v, flat[:, :, None, None], axis=1).reshape(
            b_, QBLOCK, topk, A_KV_HEADS, A_HEAD_DIM)
        kpos = jnp.take_along_axis(pos, flat, axis=1).reshape(b_, QBLOCK, topk)
        bias = rel_bias[t5_bucket(qpos[:, :, None] - kpos)]
        bias = jnp.transpose(bias.reshape(b_, QBLOCK, topk, A_KV_HEADS, grp), (0, 1, 3, 4, 2))
        qg = qb.reshape(b_, QBLOCK, A_KV_HEADS, grp, A_HEAD_DIM)
        logits = jnp.einsum('bqkgd,bqjkd->bqkgj', qg, kg, preferred_element_type=jnp.float32) * scale + bias
        logits = jnp.where(valid[:, :, None, None, :], logits, -jnp.inf)
        p = jax.nn.softmax(logits, axis=-1)
        o = jnp.einsum('bqkgj,bqjkd->bqkgd', p.astype(vg.dtype), vg)
        return o.reshape(b_, QBLOCK, A_Q)

    outs = lax.map(block, (jnp.arange(nq), to_blocks(q), to_blocks(qi), to_blocks(wi), to_blocks(pos)))
    o = jnp.moveaxis(outs, 0, 1).reshape(b_, s_len, A_Q)
    return o @ w_out


def dilated_group(q, k, v, pos, window, r, rel_bias):
    b_, s_len, nh, hd = q.shape
    wk = window // r
    n = s_len // r
    bq = math.gcd(QBLOCK, n)
    nb = n // bq
    qs = q.reshape(b_, nb, bq, r, nh, hd)
    pad5 = ((0, 0), (wk, 0), (0, 0), (0, 0), (0, 0))
    kp = jnp.pad(k.reshape(b_, n, r, nh, hd), pad5)
    vp = jnp.pad(v.reshape(b_, n, r, nh, hd), pad5)
    pp = jnp.pad(pos.reshape(b_, n, r), ((0, 0), (wk, 0), (0, 0)))
    idx = np.arange(nb)[:, None] * bq + np.arange(bq + wk)[None, :]
    kb = kp[:, idx]
    vb = vp[:, idx]
    kpos = pp[:, idx]
    qpos = pos.reshape(b_, nb, bq, r)
    i = np.arange(bq)[:, None]
    j = np.arange(bq + wk)[None, :]
    band = (j >= i) & (j <= i + wk)
    start_ok = (np.arange(nb)[:, None, None] * bq + j[None] - wk) >= 0
    mask = jnp.asarray(band[None] & start_ok)
    logits = jnp.einsum('bnqrhd,bnkrhd->bnrhqk', qs, kb,
                        preferred_element_type=jnp.float32) * (hd ** -0.5)
    rel = qpos[:, :, :, None, :] - kpos[:, :, None, :, :]
    bias = rel_bias[t5_bucket(rel)]
    logits = logits + jnp.transpose(bias, (0, 1, 4, 5, 2, 3))
    logits = jnp.where(mask[None, :, None, None], logits, -jnp.inf)
    m = jnp.max(logits, axis=-1, keepdims=True)
    p = jnp.exp(logits - m)
    den = jnp.sum(p, axis=-1)
    num = jnp.einsum('bnrhqk,bnkrhd->bnrhqd', p.astype(vb.dtype), vb,
                     preferred_element_type=jnp.float32)
    num = jnp.transpose(num, (0, 1, 4, 2, 3, 5)).reshape(b_, s_len, nh, hd)
    den = jnp.transpose(den, (0, 1, 4, 2, 3)).reshape(b_, s_len, nh)
    m = jnp.transpose(m[..., 0], (0, 1, 4, 2, 3)).reshape(b_, s_len, nh)
    return num, den, m


def dilated_attention(h, pos, k_sh, v_sh, w_q, w_out, g_qn, rel_bias):
    b_, s_len, _ = h.shape
    q = rmsnorm((h @ w_q).reshape(b_, s_len, N_GROUPS, B_HEADS, B_HEAD_DIM), g_qn)
    nums, dens, ms = [], [], []
    for g, (window, r) in enumerate(B_DILATIONS):
        num, den, m = dilated_group(q[:, :, g], k_sh[:, :, g], v_sh[:, :, g], pos, window, r, rel_bias)
        nums.append(num); dens.append(den); ms.append(m)
    m_all = jnp.maximum(jnp.maximum(ms[0], ms[1]), ms[2])
    wts = [jnp.exp(mg - m_all) for mg in ms]
    num_tot = nums[0] * wts[0][..., None] + nums[1] * wts[1][..., None] + nums[2] * wts[2][..., None]
    den_tot = dens[0] * wts[0] + dens[1] * wts[1] + dens[2] * wts[2]
    o = (num_tot / den_tot[..., None]).astype(h.dtype).reshape(b_, s_len, B_OUT)
    return o @ w_out


def moe_swiglu(h, router, router_b, w1, w3, w2):
    logits = (h @ router).astype(jnp.float32) + router_b.astype(jnp.float32)
    topv, topi = lax.top_k(logits, TOP_K_EXPERTS)
    gates = jax.nn.softmax(topv, axis=-1)
    dense_gates = jnp.sum(jax.nn.one_hot(topi, N_EXPERTS, dtype=jnp.float32) * gates[..., None], axis=-2)
    out = jnp.zeros_like(h)
    for e in range(N_EXPERTS):
        out = out + dense_gates[..., e:e + 1].astype(h.dtype) * swiglu(h, w1[e], w3[e], w2[e])
    return out


def setup_inputs(seed: int = 0) -> dict:
    key = jax.random.key(seed)
    ks = jax.random.split(key, 32)

    def nrm(k, shape, scale):
        return jax.random.normal(k, shape, jnp.float32) * scale

    def gain(k, shape):
        return 1.0 + 0.02 * jax.random.normal(k, shape, jnp.float32)

    d = D_MODEL
    pos = (jnp.arange(SEQ, dtype=jnp.int32)[None, :]
           + jax.random.randint(ks[2], (BATCH, 1), 0, 4096, dtype=jnp.int32))
    return {
        "x": nrm(ks[0], (BATCH, SEQ, d), 1.0),
        "c": nrm(ks[1], (BATCH, d), 1.0),
        "positions": pos,
        "rel_bias": nrm(ks[3], (N_BUCKETS, BIAS_HEADS), 0.5),
        "w_mod": nrm(ks[4], (DEPTH, d, 6 * d), 0.5 * d ** -0.5),
        "b_mod": nrm(ks[5], (DEPTH, 6 * d), 0.01),
        "g_attn": gain(ks[6], (DEPTH, d)),
        "g_ffn": gain(ks[7], (DEPTH, d)),
        "a_w_in": nrm(ks[8], (N_A, d, A_IN), d ** -0.5),
        "a_w_out": nrm(ks[9], (N_A, A_Q, d), A_Q ** -0.5),
        "a_g_qn": gain(ks[10], (N_A, A_HEAD_DIM)),
        "a_g_kn": gain(ks[11], (N_A, A_HEAD_DIM)),
        "kv_w_mod": nrm(ks[12], (d, 2 * d), 0.5 * d ** -0.5),
        "kv_b_mod": nrm(ks[13], (2 * d,), 0.01),
        "kv_g": gain(ks[14], (d,)),
        "kv_w": nrm(ks[15], (d, 2 * B_Q), d ** -0.5),
        "b_g_kn": gain(ks[16], (B_HEAD_DIM,)),
        "b_w_q": nrm(ks[17], (N_B, d, B_Q), d ** -0.5),
        "b_w_out": nrm(ks[18], (N_B, B_OUT, d), B_OUT ** -0.5),
        "b_g_qn": gain(ks[19], (N_B, B_HEAD_DIM)),
        "ffn_w1": nrm(ks[20], (N_DENSE, d, D_FF), d ** -0.5),
        "ffn_w3": nrm(ks[21], (N_DENSE, d, D_FF), d ** -0.5),
        "ffn_w2": nrm(ks[22], (N_DENSE, D_FF, d), D_FF ** -0.5),
        "moe_router": nrm(ks[23], (N_MOE, d, N_EXPERTS), d ** -0.5),
        "moe_router_b": nrm(ks[24], (N_MOE, N_EXPERTS), 0.01),
        "moe_w1": nrm(ks[25], (N_MOE, N_EXPERTS, d, D_FF_EXPERT), d ** -0.5),
        "moe_w3": nrm(ks[26], (N_MOE, N_EXPERTS, d, D_FF_EXPERT), d ** -0.5),
        "moe_w2": nrm(ks[27], (N_MOE, N_EXPERTS, D_FF_EXPERT, d), D_FF_EXPERT ** -0.5),
    }


def reference(x, c, positions, rel_bias, w_mod, b_mod, g_attn, g_ffn, a_w_in, a_w_out, a_g_qn,
              a_g_kn, kv_w_mod, kv_b_mod, kv_g, kv_w, b_g_kn, b_w_q, b_w_out, b_g_qn, ffn_w1,
              ffn_w3, ffn_w2, moe_router, moe_router_b, moe_w1, moe_w3, moe_w2):
    b_, s_len, _ = x.shape
    cs = jax.nn.silu(c)
    k_sh = v_sh = None
    for l in range(DEPTH):
        mod = cs @ w_mod[l] + b_mod[l]
        sh1, sc1, gt1, sh2, sc2, gt2 = jnp.split(mod, 6, axis=-1)
        if l < N_A:
            h = modulate(rmsnorm(x, g_attn[l]), sh1, sc1)
            a = dsa_attention(h, positions, a_w_in[l], a_w_out[l], a_g_qn[l], a_g_kn[l], rel_bias)
        else:
            if l == N_A:
                kv_sh, kv_sc = jnp.split(cs @ kv_w_mod + kv_b_mod, 2, axis=-1)
                hkv = modulate(rmsnorm(x, kv_g), kv_sh, kv_sc)
                kv = (hkv @ kv_w).reshape(b_, s_len, 2, N_GROUPS, B_HEADS, B_HEAD_DIM)
                k_sh = rmsnorm(kv[:, :, 0], b_g_kn)
                v_sh = kv[:, :, 1]
            bi = l - N_A
            h = modulate(rmsnorm(x, g_attn[l]), sh1, sc1)
            a = dilated_attention(h, positions, k_sh, v_sh, b_w_q[bi], b_w_out[bi], b_g_qn[bi], rel_bias)
        x = x + gt1[:, None, :] * a
        h = modulate(rmsnorm(x, g_ffn[l]), sh2, sc2)
        if l % 2 == 0:
            f = swiglu(h, ffn_w1[l // 2], ffn_w3[l // 2], ffn_w2[l // 2])
        else:
            f = moe_swiglu(h, moe_router[l // 2], moe_router_b[l // 2], moe_w1[l // 2],
                           moe_w3[l // 2], moe_w2[l // 2])
        x = x + gt2[:, None, :] * f
    return x
```

```cpp
#include <hip/hip_runtime.h>
#include <cstdio>
#include <cstdint>
namespace pg8 {
#define PG8_LAS __attribute__((address_space(3)))
typedef unsigned short bf16_t;
typedef short bf16x8 __attribute__((ext_vector_type(8)));
typedef float f32x4 __attribute__((ext_vector_type(4)));
typedef unsigned u32x4 __attribute__((ext_vector_type(4)));
constexpr int BM = 256, BK = 64, HALF = 128, HTB = HALF * BK * 2  , STAGE_BYTES = 8 * HTB, NXCD = 8, WGM = 8;

__host__ __device__ __forceinline__ int lds_byte(int r, int c) { const int st = (r >> 4) * 2 + (c >> 5), rr = r & 15, cc = c & 31, ob = rr * 64 + cc * 2; return st * 1024 + (ob ^ (((ob >> 9) & 1) << 5)); }
__host__ __device__ __forceinline__ void stage_rc(int b, int& R, int& C) { const int st = b / 1024, sb = b % 1024, swz = sb ^ (((sb >> 9) & 1) << 5); R = (st >> 1) * 16 + swz / 64; C = (st & 1) * 32 + (swz % 64) / 2; }
__host__ __device__ __forceinline__ int perm32(int rho) { const int n = rho >> 4, i = rho & 15; return 8 * (i >> 2) + 4 * n + (i & 3); }

struct Unit { int pm, pn; };
struct Gemm { const bf16_t* A; const bf16_t* Bt; int M, N, K; };

__device__ __forceinline__ void tile_map(int L, int nM, int nN, int& pm, int& pn) {
    const int nwg = nM * nN; int wgid = L;
    { const int q = nwg / NXCD, r = nwg % NXCD, xcd = wgid % NXCD, off = wgid / NXCD; wgid = (xcd < r ? xcd * (q + 1) : r * (q + 1) + (xcd - r) * q) + off; }
    const int nig = WGM * nN, gid = wgid / nig, fm = gid * WGM, gsz = (nM - fm) < WGM ? (nM - fm) : WGM;
    pm = fm + ((wgid % nig) % gsz); pn = (wgid % nig) / gsz;
}
struct StaticOrder {
    int nM, nN, nwg, G, c;
    __device__ void init(int M, int N, int G_, int c_) { nM = M / BM; nN = N / BM; nwg = nM * nN; G = G_; c = c_; }
    __device__ bool next(int i, Unit& u) const { const long L = (long)i * G + c; if (L >= nwg) return false; tile_map((int)L, nM, nN, u.pm, u.pn); return true; }
    __device__ __forceinline__ void a_ready(const Unit&) const {}
    __device__ __forceinline__ void done(const Unit&) const {}
};
struct DualOrder {
    int nM, nN1, nN2, n1, ntot, pm_off, pn_off, G, c;
    __device__ void init(int nM_, int nN1_, int nN2_, int pm_off_, int pn_off_, int G_, int c_) { nM = nM_; nN1 = nN1_; nN2 = nN2_; n1 = nM * nN1; ntot = n1 + nM * nN2; pm_off = pm_off_; pn_off = pn_off_; G = G_; c = c_; }
    __device__ bool next(int i, Unit& u) const { const long L = (long)i * G + c; if (L >= ntot) return false;
        if (L < n1) tile_map((int)L, nM, nN1, u.pm, u.pn); else { tile_map((int)L - n1, nM, nN2, u.pm, u.pn); u.pm += pm_off; u.pn += pn_off; } return true; }
    __device__ __forceinline__ void a_ready(const Unit&) const {}
    __device__ __forceinline__ void done(const Unit&) const {}
};
struct MoeOrder {
    int toff[9]; int nN, T, total, G, c;
    __device__ bool next(int i, Unit& u) const { const long L = (long)i * G + c; if (L >= total) return false;
        const int mt = (int)(L % T), pl = (int)(L / T); int e = 0;
#pragma unroll
        for (int k = 1; k < 8; ++k) e += (mt >= toff[k]) ? 1 : 0;
        u.pm = mt; u.pn = e * nN + pl; return true; }
    __device__ __forceinline__ void a_ready(const Unit&) const {}
    __device__ __forceinline__ void done(const Unit&) const {}
};

__device__ __forceinline__ unsigned cvt_pk_bf16(float lo, float hi) { unsigned r; asm volatile("v_cvt_pk_bf16_f32 %0, %1, %2" : "=v"(r) : "v"(lo), "v"(hi)); return r; }

struct EpiBf16Sel {
    static constexpr bool PERM = true, AFTER_DRAIN = false;
    bf16_t* O0; int ld0; bf16_t* O1; int ld1; int pm_split, pn_split;
    __device__ __forceinline__ void operator()(const f32x4 (&acc)[2][2][4][2], const Unit& u, int wr, int wc, int fr, int fq) const {
        bf16_t* base = O0; int ldc = ld0, pm = u.pm, pn = u.pn;
        if (pn >= pn_split) { base = O1; ldc = ld1; pm -= pm_split; pn -= pn_split; }
        const int row0 = pm * BM + wr * 64 + fr, col0 = pn * BM + wc * 32 + 8 * fq;
#pragma unroll
        for (int ai = 0; ai < 2; ++ai)
#pragma unroll
            for (int m = 0; m < 4; ++m) { bf16_t* rowp = base + (size_t)(row0 + ai * HALF + m * 16) * ldc + col0;
#pragma unroll
                for (int bj = 0; bj < 2; ++bj) { const f32x4 v0 = acc[ai][bj][m][0], v1 = acc[ai][bj][m][1];
                    u32x4 w; w.x = cvt_pk_bf16(v0[0], v0[1]); w.y = cvt_pk_bf16(v0[2], v0[3]); w.z = cvt_pk_bf16(v1[0], v1[1]); w.w = cvt_pk_bf16(v1[2], v1[3]);
                    *(u32x4*)(rowp + bj * HALF) = w; } }
    }
};
struct EpiResGate {
    static constexpr bool PERM = false, AFTER_DRAIN = false;
    const float* base; float* out; const float* gate; int gstride;
    __device__ __forceinline__ void operator()(const f32x4 (&acc)[2][2][4][2], const Unit& u, int wr, int wc, int fr, int fq) const {
        const int row0 = u.pm * BM + wr * 64 + fr, col0 = u.pn * BM + wc * 32 + 4 * fq;
        const float* gp = gate + (size_t)(u.pm >> 3) * gstride + col0;
        f32x4 gv[2][2];
#pragma unroll
        for (int bj = 0; bj < 2; ++bj)
#pragma unroll
            for (int n = 0; n < 2; ++n) gv[bj][n] = *(const f32x4*)(gp + bj * HALF + n * 16);
#pragma unroll
        for (int ai = 0; ai < 2; ++ai)
#pragma unroll
            for (int m = 0; m < 4; ++m) { const size_t off = (size_t)(row0 + ai * HALF + m * 16) * 2048 + col0;
#pragma unroll
                for (int bj = 0; bj < 2; ++bj)
#pragma unroll
                    for (int n = 0; n < 2; ++n) { const f32x4 bs = *(const f32x4*)(base + off + bj * HALF + n * 16); *(f32x4*)(out + off + bj * HALF + n * 16) = bs + gv[bj][n] * acc[ai][bj][m][n]; }
                asm volatile("" ::: "memory"); }
    }
};
struct EpiSwiGLU {
    static constexpr bool PERM = true, AFTER_DRAIN = false;
    bf16_t* O; int ldc; int nN;
    __device__ __forceinline__ void operator()(const f32x4 (&acc)[2][2][4][2], const Unit& u, int wr, int wc, int fr, int fq) const {
        const int row0 = u.pm * BM + wr * 64 + fr, col0 = (u.pn % nN) * HALF + wc * 32 + 8 * fq;
#pragma unroll
        for (int ai = 0; ai < 2; ++ai)
#pragma unroll
            for (int m = 0; m < 4; ++m) { bf16_t* rowp = O + (size_t)(row0 + ai * HALF + m * 16) * ldc + col0;
                float r[8];
#pragma unroll
                for (int n = 0; n < 2; ++n)
#pragma unroll
                    for (int j = 0; j < 4; ++j) { const float g = acc[ai][0][m][n][j], up = acc[ai][1][m][n][j];
                        r[4 * n + j] = g * up * __builtin_amdgcn_rcpf(1.0f + __builtin_amdgcn_exp2f(-1.4426950408889634f * g)); }
                u32x4 w; w.x = cvt_pk_bf16(r[0], r[1]); w.y = cvt_pk_bf16(r[2], r[3]); w.z = cvt_pk_bf16(r[4], r[5]); w.w = cvt_pk_bf16(r[6], r[7]);
                *(u32x4*)rowp = w; }
    }
};
struct EpiRowScale {
    static constexpr bool PERM = false, AFTER_DRAIN = false;
    float* Y; const float* rs; int nN;
    __device__ __forceinline__ void operator()(const f32x4 (&acc)[2][2][4][2], const Unit& u, int wr, int wc, int fr, int fq) const {
        const int row0 = u.pm * BM + wr * 64 + fr, col0 = (u.pn % nN) * BM + wc * 32 + 4 * fq;
#pragma unroll
        for (int ai = 0; ai < 2; ++ai)
#pragma unroll
            for (int m = 0; m < 4; ++m) { const int row = row0 + ai * HALF + m * 16; const float s = rs[row]; float* rowp = Y + (size_t)row * 2048 + col0;
#pragma unroll
                for (int bj = 0; bj < 2; ++bj)
#pragma unroll
                    for (int n = 0; n < 2; ++n) *(f32x4*)(rowp + bj * HALF + n * 16) = acc[ai][bj][m][n] * s; }
    }
};

template <class Epi, class Sched, bool ALIGN_EPI = false, bool SP2 = false>
__device__ __forceinline__ void gemm_phase(PG8_LAS unsigned char* lds, const Gemm g, const Sched& S, const Epi& E) {
    const int tid = threadIdx.x, wid = __builtin_amdgcn_readfirstlane(tid >> 6), lane = tid & 63, wr = wid >> 2, wc = wid & 3, fr = lane & 15, fq = lane >> 4;
    const int K = g.K, nt = K / BK;
    unsigned voffA[2], voffB[2];
#pragma unroll
    for (int i = 0; i < 2; ++i) { int R, C; stage_rc(tid * 16 + i * 8192, R, C); const int Rb = Epi::PERM ? ((R & ~31) + perm32(R & 31)) : R;
        voffA[i] = (unsigned)(R * K + C) * 2u; voffB[i] = (unsigned)(Rb * K + C) * 2u; }
    const size_t kstep = (size_t)(BK * 2);
    const size_t hstep = (size_t)HALF * K * 2;
    const size_t tstep = 2 * hstep;
    const unsigned ldsw = (unsigned)wid * 1024u;
    const int aoff = lds_byte(wr * 64 + fr, fq * 8), boff = lds_byte(wc * 32 + fr, fq * 8);
#define PG8_SA(b, h) (((b) * 2 + (h)) * HTB)
#define PG8_SB(b, h) ((4 + (b) * 2 + (h)) * HTB)
#define PG8_STAGE(bufoff, gbase, voff) do { _Pragma("unroll") for (int _i = 0; _i < 2; ++_i) \
        __builtin_amdgcn_global_load_lds((const unsigned*)((const char*)(gbase) + (voff)[_i]), (PG8_LAS unsigned*)(lds + (bufoff) + ldsw + _i * 8192), 16, 0, 0); } while (0)
#define PG8_LDA(dst, b, h) do { _Pragma("unroll") for (int m = 0; m < 4; ++m) _Pragma("unroll") for (int k = 0; k < 2; ++k) dst[m][k] = *(const PG8_LAS bf16x8*)(lds + PG8_SA(b, h) + aoff + m * 2048 + k * 1024); } while (0)
#define PG8_LDB(dst, b, h) do { _Pragma("unroll") for (int n = 0; n < 2; ++n) _Pragma("unroll") for (int k = 0; k < 2; ++k) dst[n][k] = *(const PG8_LAS bf16x8*)(lds + PG8_SB(b, h) + boff + n * 2048 + k * 1024); } while (0)
#define PG8_MMA(ai, bj, At, Bt) do { __builtin_amdgcn_s_setprio(1); _Pragma("unroll") for (int m = 0; m < 4; ++m) _Pragma("unroll") for (int n = 0; n < 2; ++n) _Pragma("unroll") for (int k = 0; k < 2; ++k) \
        acc[ai][bj][m][n] = __builtin_amdgcn_mfma_f32_16x16x32_bf16(Bt[n][k], At[m][k], acc[ai][bj][m][n], 0, 0, 0); __builtin_amdgcn_s_setprio(0); } while (0)
#define PG8_WAIT_V(n) asm volatile("s_waitcnt vmcnt(" #n ")" ::: "memory")
#define PG8_WAIT_L(n) asm volatile("s_waitcnt lgkmcnt(" #n ")" ::: "memory")
#define PG8_BAR __builtin_amdgcn_s_barrier()
#define PG8_SCHED __builtin_amdgcn_sched_barrier(0)
    Unit cur, nxt; int ui = 0;
    if (!S.next(0, cur)) return;
    f32x4 acc[2][2][4][2];
#pragma unroll
    for (int a = 0; a < 2; ++a)
#pragma unroll
        for (int b = 0; b < 2; ++b)
#pragma unroll
            for (int m = 0; m < 4; ++m)
#pragma unroll
                for (int n = 0; n < 2; ++n) acc[a][b][m][n] = (f32x4){0.f, 0.f, 0.f, 0.f};
    bf16x8 At[4][2], B0[2][2], B1[2][2];
    const char* cA = (const char*)g.A + (size_t)cur.pm * tstep; const char* cB = (const char*)g.Bt + (size_t)cur.pn * tstep;
    S.a_ready(cur);
    if constexpr (SP2) {
        PG8_STAGE(PG8_SB(0, 0), cB, voffB); PG8_STAGE(PG8_SB(0, 1), cB + hstep, voffB); PG8_STAGE(PG8_SA(0, 0), cA, voffA); PG8_STAGE(PG8_SA(0, 1), cA + hstep, voffA);
        if (wr == 1) PG8_BAR;
        PG8_WAIT_V(2); PG8_BAR;
        PG8_STAGE(PG8_SB(1, 0), cB + kstep, voffB); PG8_STAGE(PG8_SA(1, 0), cA + kstep, voffA); PG8_STAGE(PG8_SB(1, 1), cB + hstep + kstep, voffB);
        PG8_WAIT_V(6); PG8_BAR;
    } else {
        PG8_STAGE(PG8_SB(0, 0), cB, voffB); PG8_STAGE(PG8_SA(0, 0), cA, voffA); PG8_STAGE(PG8_SB(0, 1), cB + hstep, voffB); PG8_STAGE(PG8_SA(0, 1), cA + hstep, voffA);
        if (wr == 1) PG8_BAR;
        PG8_WAIT_V(4); PG8_BAR;
        PG8_STAGE(PG8_SB(1, 0), cB + kstep, voffB); PG8_STAGE(PG8_SA(1, 0), cA + kstep, voffA); PG8_STAGE(PG8_SB(1, 1), cB + hstep + kstep, voffB);
        PG8_WAIT_V(6); PG8_BAR;
    }
    for (;;) {
        const bool has_next = S.next(ui + 1, nxt);
        const char* nA = has_next ? (const char*)g.A + (size_t)nxt.pm * tstep : cA; const char* nB = has_next ? (const char*)g.Bt + (size_t)nxt.pn * tstep : cB;
        for (int t = 0; t < nt; t += 2) {
            const bool last = (t == nt - 2);
            const char* a1 = cA + (size_t)(t + 1) * kstep;
            const char* a2 = last ? nA : cA + (size_t)(t + 2) * kstep; const char* b2 = last ? nB : cB + (size_t)(t + 2) * kstep;
            const char* a3 = a2 + kstep; const char* b3 = b2 + kstep;
            if (last && has_next) S.a_ready(nxt);
            if constexpr (SP2) {
            PG8_LDB(B0, 0, 0); PG8_LDB(B1, 0, 1); PG8_SCHED; PG8_LDA(At, 0, 0); PG8_STAGE(PG8_SA(1, 1), a1 + hstep, voffA);
            PG8_WAIT_V(8); PG8_WAIT_L(0); PG8_BAR; PG8_MMA(0, 0, At, B0); PG8_MMA(0, 1, At, B1); PG8_BAR; PG8_SCHED;
            PG8_LDA(At, 0, 1); PG8_STAGE(PG8_SB(0, 0), b2, voffB); PG8_STAGE(PG8_SB(0, 1), b2 + hstep, voffB); PG8_STAGE(PG8_SA(0, 0), a2, voffA);
            PG8_WAIT_V(8); PG8_WAIT_L(0); PG8_BAR; PG8_MMA(1, 0, At, B0); PG8_MMA(1, 1, At, B1); PG8_BAR; PG8_SCHED;
            PG8_LDB(B0, 1, 0); PG8_LDB(B1, 1, 1); PG8_SCHED; PG8_LDA(At, 1, 0); PG8_STAGE(PG8_SA(0, 1), a2 + hstep, voffA);
            PG8_WAIT_V(8); PG8_WAIT_L(0); PG8_BAR; PG8_MMA(0, 0, At, B0); PG8_MMA(0, 1, At, B1); PG8_BAR; PG8_SCHED;
            PG8_LDA(At, 1, 1); PG8_STAGE(PG8_SB(1, 0), b3, voffB); PG8_STAGE(PG8_SB(1, 1), b3 + hstep, voffB); PG8_STAGE(PG8_SA(1, 0), a3, voffA);
            PG8_WAIT_V(8); PG8_WAIT_L(0); PG8_BAR; PG8_MMA(1, 0, At, B0); PG8_MMA(1, 1, At, B1); PG8_BAR; PG8_SCHED;
            } else {
            PG8_LDB(B0, 0, 0); PG8_SCHED; PG8_LDA(At, 0, 0); PG8_STAGE(PG8_SA(1, 1), a1 + hstep, voffA);
            PG8_WAIT_L(8); PG8_BAR; PG8_WAIT_L(0); PG8_MMA(0, 0, At, B0); PG8_BAR; PG8_SCHED;
            PG8_LDB(B1, 0, 1); PG8_STAGE(PG8_SB(0, 0), b2, voffB);
            PG8_BAR; PG8_WAIT_L(0); PG8_MMA(0, 1, At, B1); PG8_BAR;
            PG8_LDA(At, 0, 1); PG8_STAGE(PG8_SA(0, 0), a2, voffA);
            PG8_BAR; PG8_WAIT_L(0); PG8_MMA(1, 0, At, B0); PG8_BAR; PG8_SCHED;
            PG8_STAGE(PG8_SB(0, 1), b2 + hstep, voffB);
            PG8_WAIT_V(6); PG8_BAR; PG8_MMA(1, 1, At, B1); PG8_BAR;
            PG8_LDB(B0, 1, 0); PG8_SCHED; PG8_LDA(At, 1, 0); PG8_STAGE(PG8_SA(0, 1), a2 + hstep, voffA);
            PG8_WAIT_L(8); PG8_BAR; PG8_WAIT_L(0); PG8_MMA(0, 0, At, B0); PG8_BAR; PG8_SCHED;
            PG8_LDB(B1, 1, 1); PG8_STAGE(PG8_SB(1, 0), b3, voffB);
            PG8_BAR; PG8_WAIT_L(0); PG8_MMA(0, 1, At, B1); PG8_BAR;
            PG8_LDA(At, 1, 1); PG8_STAGE(PG8_SA(1, 0), a3, voffA);
            PG8_BAR; PG8_WAIT_L(0); PG8_MMA(1, 0, At, B0); PG8_BAR; PG8_SCHED;
            PG8_STAGE(PG8_SB(1, 1), b3 + hstep, voffB);
            PG8_WAIT_V(6); PG8_BAR; PG8_MMA(1, 1, At, B1); PG8_BAR;
            }
        }
        if constexpr (ALIGN_EPI) { if (wr == 0) PG8_BAR; }
        if constexpr (!Epi::AFTER_DRAIN) { E(acc, cur, wr, wc, fr, fq); S.done(cur); }
        if (!has_next) break;
#pragma unroll
        for (int a = 0; a < 2; ++a)
#pragma unroll
            for (int b = 0; b < 2; ++b)
#pragma unroll
                for (int m = 0; m < 4; ++m)
#pragma unroll
                    for (int n = 0; n < 2; ++n) acc[a][b][m][n] = (f32x4){0.f, 0.f, 0.f, 0.f};
        cur = nxt; cA = nA; cB = nB; ++ui;
        if constexpr (ALIGN_EPI) { if (wr == 1) PG8_BAR; }
    }
    PG8_WAIT_V(0);
    if constexpr (!ALIGN_EPI) { if (wr == 0) PG8_BAR; }
    PG8_BAR;
    if constexpr (Epi::AFTER_DRAIN) { E.fused(acc, cur, wr, wc, fr, fq, lds, wid, lane); S.done(cur); }
#undef PG8_SA
#undef PG8_SB
#undef PG8_STAGE
#undef PG8_LDA
#undef PG8_LDB
#undef PG8_MMA
#undef PG8_WAIT_V
#undef PG8_WAIT_L
#undef PG8_BAR
#undef PG8_SCHED
}
}

constexpr int NB = 4, SEQ = 2048, DM = 2048, MTOK = NB * SEQ;
constexpr int A_IN = 4176, A_INP = 4352;
constexpr int C_Q = 0, C_K = 2048, C_V = 2560, C_QI = 3072, C_KI = 4096, C_WI = 4160;
constexpr int DFF = 5632, DFFE = 7168, NEXP = 8;
constexpr int NMOD = 28672;
constexpr float EPS = 1e-6f, LOG2E = 1.4426950408889634f;
constexpr int MROWS = 2 * MTOK + NEXP * 256;

constexpr size_t MiB = 1u << 20;
constexpr size_t WS_CTL = 0, CTL_ZERO_BYTES = 1 * MiB;
constexpr size_t WS_MOD = 1 * MiB, WS_BT = WS_MOD + 512 * 1024, WS_ROUTE = WS_MOD + 768 * 1024;
constexpr size_t WS_WIN = 2 * MiB, WS_WAOUT = 19 * MiB, WS_WF13 = 27 * MiB, WS_WF2 = 71 * MiB, WS_WKVQ = 93 * MiB, WS_WBOUT = 129 * MiB, WS_WM13 = 133 * MiB, WS_WM2 = 581 * MiB;
constexpr size_t WS_HA = 805 * MiB, WS_AR = 869 * MiB;
constexpr size_t WS_P0 = WS_AR, WS_QN = WS_AR + 68 * MiB, WS_KN = WS_AR + 100 * MiB, WS_VT = WS_AR + 108 * MiB, WS_MASK = WS_AR + 116 * MiB, WS_O = WS_AR + 118 * MiB, WS_U = WS_AR + 150 * MiB;
constexpr size_t WS_KV = WS_AR, WS_Q1 = WS_AR + 96 * MiB, WS_K1N = WS_AR + 144 * MiB, WS_Q1N = WS_AR + 192 * MiB, WS_VT1 = WS_AR + 240 * MiB, WS_OG = WS_AR + 288 * MiB, WS_LSE = WS_AR + 336 * MiB, WS_O1 = WS_AR + 338 * MiB;
constexpr size_t WS_AS = WS_AR, WS_UM = WS_AR + 72 * MiB, WS_Y = WS_AR + 324 * MiB, WS_RG = WS_AR + 468 * MiB, WS_TR = WS_AR + 469 * MiB;
constexpr size_t WS_END = WS_AR + 470 * MiB;
static_assert((size_t)A_INP * DM * 2 <= 17 * MiB && (size_t)MROWS * DFFE * 2 <= 252 * MiB && (size_t)MROWS * DM * 4 <= 144 * MiB && (size_t)MROWS * DM * 2 <= 72 * MiB, "ws map");
constexpr int CW_TMO = 0, CW_CODE = 1, CW_BAR = 4096, CW_CNT = 8192;

constexpr int RING_OFF = 0, RING_BYTES = 131072;
constexpr int LDSCTL_OFF = RING_BYTES, MISC_OFF = LDSCTL_OFF + 320;
constexpr int LDS_BYTES = 147456;
constexpr int NWAVES = 8;

#define GAS __attribute__((address_space(1)))
#define LAS __attribute__((address_space(3)))
typedef unsigned short bf16;
typedef unsigned v4u __attribute__((ext_vector_type(4)));
typedef unsigned v2u __attribute__((ext_vector_type(2)));
typedef float f32x4 __attribute__((ext_vector_type(4)));
typedef float f32x2 __attribute__((ext_vector_type(2)));
typedef float f32x16 __attribute__((ext_vector_type(16)));
typedef int i32x4 __attribute__((ext_vector_type(4)));
typedef short bf16x8 __attribute__((ext_vector_type(8)));
typedef GAS unsigned gu32;
#define RLX_AGENT __ATOMIC_RELAXED, __HIP_MEMORY_SCOPE_AGENT
#define MFMA32(a, b, c) __builtin_amdgcn_mfma_f32_32x32x16_bf16((a), (b), (c), 0, 0, 0)
__device__ __forceinline__ unsigned f2bf(float f) { unsigned u = __builtin_bit_cast(unsigned, f); return (u + 0x7fffu + ((u >> 16) & 1u)) >> 16; }
__device__ __forceinline__ unsigned pk2(float lo, float hi) { return f2bf(lo) | (f2bf(hi) << 16); }
__device__ __forceinline__ float bflo(unsigned w) { return __builtin_bit_cast(float, w << 16); }
__device__ __forceinline__ float bfhi(unsigned w) { return __builtin_bit_cast(float, w & 0xffff0000u); }
typedef float f32x2_t __attribute__((ext_vector_type(2)));
typedef __bf16 bf16x2_t __attribute__((ext_vector_type(2)));
__device__ __forceinline__ unsigned cvtpk(float lo, float hi) { f32x2_t v = {lo, hi}; bf16x2_t b = __builtin_convertvector(v, bf16x2_t); return __builtin_bit_cast(unsigned, b); }
__device__ __forceinline__ bf16x8 pack8(float a0, float a1, float a2, float a3, float a4, float a5, float a6, float a7) {
    v4u p; p.x = cvtpk(a0, a1); p.y = cvtpk(a2, a3); p.z = cvtpk(a4, a5); p.w = cvtpk(a6, a7); return __builtin_bit_cast(bf16x8, p); }
#define XB_TMO      128
#define XB_XCNT(j)  (256  + 64 * (j))
#define XB_XSUB(j)  (1280 + 64 * (j))
#define XB_XGEN(j)  (2304 + 64 * (j))
#define XB_TOP      3328
#define XB_TOPGEN   3392
#define XCD_BAR_WORDS 3456
#define XB_SPIN_CAP (1u << 18)

__device__ __forceinline__ unsigned xb_ld(unsigned* p)              { return __hip_atomic_load(p, __ATOMIC_RELAXED, __HIP_MEMORY_SCOPE_AGENT); }
__device__ __forceinline__ unsigned xb_add(unsigned* p, unsigned v) { return __hip_atomic_fetch_add(p, v, __ATOMIC_RELAXED, __HIP_MEMORY_SCOPE_AGENT); }
__device__ __forceinline__ unsigned xb_xcc_id() { return (unsigned)__builtin_amdgcn_s_getreg((3 << 11) | 20) & 0xFu; }
#define XB_SPIN(cond, bar) do { unsigned _sp = 0; while (cond) { __builtin_amdgcn_s_sleep(1); \
    if ((++_sp & 255u) == 0u) { if (xb_ld(&(bar)[XB_TMO])) break; if (_sp > XB_SPIN_CAP) { atomicAdd(&(bar)[XB_TMO], 1u); break; } } } } while (0)

struct XcdBarrier {
    unsigned* bar; unsigned x;
    volatile LAS unsigned* st;
};

__device__ __forceinline__ XcdBarrier xcd_barrier_post(unsigned* bar, volatile LAS unsigned* st) {
    XcdBarrier b; b.bar = bar; b.x = xb_xcc_id(); b.st = st;
    if (threadIdx.x == 0) (void)xb_add(&bar[XB_XCNT(b.x)], 1u);
    return b;
}
__device__ __forceinline__ void xcd_barrier_complete(unsigned* bar, unsigned x, unsigned& nloc, unsigned& nx) {
    const unsigned G = gridDim.x * gridDim.y * gridDim.z;
    unsigned sum, cnt, mine, sp = 0u;
    for (;;) {
        sum = 0u; cnt = 0u; mine = 0u;
#pragma unroll
        for (unsigned j = 0; j < 16; ++j) { const unsigned c = xb_ld(&bar[XB_XCNT(j)]); sum += c; cnt += (c > 0u) ? 1u : 0u; mine = (j == x) ? c : mine; }
        if (sum == G) break;
        __builtin_amdgcn_s_sleep(1);
        if ((++sp & 255u) == 0u) { if (xb_ld(&bar[XB_TMO])) break; if (sp > XB_SPIN_CAP) { atomicAdd(&bar[XB_TMO], 1u); break; } }
    }
    nloc = mine > 0u ? mine : 1u; nx = cnt > 0u ? cnt : 1u;
}

__device__ __forceinline__ void xcd_barrier(const XcdBarrier& b) {
    asm volatile("s_waitcnt vmcnt(0)" ::: "memory");
    __syncthreads();
    if (threadIdx.x == 0) {
        unsigned* bar = b.bar;
        __builtin_amdgcn_s_waitcnt(0);
        unsigned nloc = b.st[0], nx = b.st[1];
        if (nloc == 0u) { xcd_barrier_complete(bar, b.x, nloc, nx); b.st[0] = nloc; b.st[1] = nx; }
        const unsigned old = xb_add(&bar[XB_XSUB(b.x)], 1u);
        const unsigned gen = old / nloc;
        if (old + 1u == (gen + 1u) * nloc) {
            __builtin_amdgcn_fence(__ATOMIC_RELEASE, "agent");
            asm volatile("s_waitcnt vmcnt(0)" ::: "memory");
            const unsigned og = xb_add(&bar[XB_TOP], 1u);
            const unsigned tg = og / nx;
            if (og + 1u == (tg + 1u) * nx) xb_add(&bar[XB_TOPGEN], 1u);
            else XB_SPIN(xb_ld(&bar[XB_TOPGEN]) == tg, bar);
            __builtin_amdgcn_fence(__ATOMIC_ACQUIRE, "agent");
            xb_add(&bar[XB_XGEN(b.x)], 1u);
            asm volatile("s_waitcnt vmcnt(0)" ::: "memory");
        } else {
            XB_SPIN(xb_ld(&bar[XB_XGEN(b.x)]) == gen, bar);
            __builtin_amdgcn_fence(__ATOMIC_ACQUIRE, "agent");
            asm volatile("s_waitcnt vmcnt(0)" ::: "memory");
        }
    }
    __syncthreads();
}

struct Args { const void* in[28]; float* out; unsigned char* ws; int ph_lo, ph_hi; };
struct Frame {
    LAS unsigned char* lds; volatile LAS unsigned* MISC; gu32* ctl; unsigned char* ws;
    int tid, lane, wave, G, bid;
};
#define LDS_WAIT() asm volatile("s_waitcnt lgkmcnt(0)" ::: "memory")
__device__ __forceinline__ float wave_sum(float v) {
#pragma unroll
    for (int o = 1; o < 64; o <<= 1) v += __shfl_xor(v, o);
    return v;
}

__device__ __forceinline__ int t5_bucket(int n) {
    if (n < 16) return n;
    const float v = logf((float)n / 16.0f) / 4.852030263919617f * 16.0f;
    const int l = 16 + (int)v; return l < 31 ? l : 31;
}
__device__ __forceinline__ void cvt_tile(const float* __restrict__ src, int N, int k0, int n0, int nvalid, bf16* __restrict__ dst, size_t drow0, int Kd, int lane) {
    const int cl = lane & 15, kg = lane >> 4;
    f32x4 v[16];
    const float* sp = src + (size_t)(k0 + 16 * kg) * N + n0 + 4 * cl;
    const bool ok = 4 * cl < nvalid;
#pragma unroll
    for (int i = 0; i < 16; ++i) v[i] = ok ? *(const f32x4*)(sp + (size_t)i * N) : (f32x4){0.f, 0.f, 0.f, 0.f};
    bf16* dp = dst + (drow0 + 4 * cl) * (size_t)Kd + k0 + 16 * kg;
#pragma unroll
    for (int e = 0; e < 4; ++e) {
        v4u a, b;
        a.x = pk2(v[0][e], v[1][e]); a.y = pk2(v[2][e], v[3][e]); a.z = pk2(v[4][e], v[5][e]); a.w = pk2(v[6][e], v[7][e]);
        b.x = pk2(v[8][e], v[9][e]); b.y = pk2(v[10][e], v[11][e]); b.z = pk2(v[12][e], v[13][e]); b.w = pk2(v[14][e], v[15][e]);
        *(v4u*)(dp + (size_t)e * Kd) = a; *(v4u*)(dp + (size_t)e * Kd + 8) = b;
    }
}
__device__ __forceinline__ void p0_prologue(Frame& F, const Args& A) {
    const float* c_in = (const float*)A.in[1];
    const float* rel_bias = (const float*)A.in[3];
    float* MOD = (float*)(F.ws + WS_MOD); float* BT = (float*)(F.ws + WS_BT);
    LAS float* cs = (LAS float*)F.lds; LAS float* red = (LAS float*)(F.lds + 32768);
    for (int i = F.tid; i < NB * DM; i += NWAVES * 64) { const float v = c_in[i]; cs[i] = v / (1.0f + __expf(-v)); }
    __syncthreads();
    for (int item = F.bid; item < NMOD / 128; item += F.G) {
        const int j0 = item * 128; const float* W; const float* bias; int N, jl;
        if (j0 < 12288) { W = (const float*)A.in[4]; N = 12288; jl = j0; bias = (const float*)A.in[5]; }
        else if (j0 < 24576) { W = (const float*)A.in[4] + (size_t)DM * 12288; N = 12288; jl = j0 - 12288; bias = (const float*)A.in[5] + 12288; }
        else { W = (const float*)A.in[12]; N = 4096; jl = j0 - 24576; bias = (const float*)A.in[13]; }
        const float* wp = W + (size_t)(256 * F.wave) * N + jl + 2 * F.lane;
        float a[4][2];
#pragma unroll
        for (int b = 0; b < 4; ++b) { a[b][0] = 0.f; a[b][1] = 0.f; }
        for (int k = 0; k < 256; k += 8) {
            f32x2 w[8];
#pragma unroll
            for (int i = 0; i < 8; ++i) w[i] = *(const f32x2*)(wp + (size_t)(k + i) * N);
#pragma unroll
            for (int i = 0; i < 8; ++i)
#pragma unroll
                for (int b = 0; b < 4; ++b) { const float cv = cs[b * DM + 256 * F.wave + k + i]; a[b][0] += cv * w[i].x; a[b][1] += cv * w[i].y; }
        }
#pragma unroll
        for (int b = 0; b < 4; ++b) { red[(F.wave * 4 + b) * 128 + 2 * F.lane] = a[b][0]; red[(F.wave * 4 + b) * 128 + 2 * F.lane + 1] = a[b][1]; }
        __syncthreads();
        { const int b = F.tid >> 7, col = F.tid & 127; float s = bias[jl + col];
#pragma unroll
          for (int w = 0; w < 8; ++w) s += red[(w * 4 + b) * 128 + col];
          MOD[(size_t)b * NMOD + j0 + col] = s; }
        __syncthreads();
    }
    for (int idx = F.bid * (NWAVES * 64) + F.tid; idx < 16 * 2048; idx += F.G * NWAVES * 64) { const int h = idx >> 11, n = idx & 2047; BT[idx] = rel_bias[t5_bucket(n) * 16 + h] * LOG2E; }
    const int gw = F.bid * NWAVES + F.wave, NGW = F.G * NWAVES;
    constexpr int T_IN = 32 * 68, T_AOUT = 32 * 32, T_F1 = 32 * 88, T_F2 = 88 * 32, T_KV = 32 * 96, T_BQ = 32 * 48, T_BOUT = 16 * 32, T_ME = 3584, T_M = 8 * T_ME;
    constexpr int NITEMS = T_IN + T_AOUT + 2 * T_F1 + T_F2 + T_KV + T_BQ + T_BOUT + 3 * T_M;
    for (int it = gw; it < NITEMS; it += NGW) {
        int r = it;
        if (r < T_IN) { const int kb = r / 68, nb = r % 68; cvt_tile((const float*)A.in[8], A_IN, 64 * kb, 64 * nb, A_IN - 64 * nb, (bf16*)(F.ws + WS_WIN), (size_t)64 * nb, DM, F.lane); continue; } r -= T_IN;
        if (r < T_AOUT) { const int kb = r / 32, nb = r % 32; cvt_tile((const float*)A.in[9], DM, 64 * kb, 64 * nb, 64, (bf16*)(F.ws + WS_WAOUT), (size_t)64 * nb, DM, F.lane); continue; } r -= T_AOUT;
        if (r < T_F1) { const int kb = r / 88, nb = r % 88, n0 = 64 * nb; cvt_tile((const float*)A.in[20], DFF, 64 * kb, n0, 64, (bf16*)(F.ws + WS_WF13), (size_t)((n0 >> 7) * 256 + (n0 & 127)), DM, F.lane); continue; } r -= T_F1;
        if (r < T_F1) { const int kb = r / 88, nb = r % 88, n0 = 64 * nb; cvt_tile((const float*)A.in[21], DFF, 64 * kb, n0, 64, (bf16*)(F.ws + WS_WF13), (size_t)((n0 >> 7) * 256 + 128 + (n0 & 127)), DM, F.lane); continue; } r -= T_F1;
        if (r < T_F2) { const int kb = r / 32, nb = r % 32; cvt_tile((const float*)A.in[22], DM, 64 * kb, 64 * nb, 64, (bf16*)(F.ws + WS_WF2), (size_t)64 * nb, DFF, F.lane); continue; } r -= T_F2;
        if (r < T_KV) { const int kb = r / 96, nb = r % 96; cvt_tile((const float*)A.in[15], 6144, 64 * kb, 64 * nb, 64, (bf16*)(F.ws + WS_WKVQ), (size_t)64 * nb, DM, F.lane); continue; } r -= T_KV;
        if (r < T_BQ) { const int kb = r / 48, nb = r % 48; cvt_tile((const float*)A.in[17], 3072, 64 * kb, 64 * nb, 64, (bf16*)(F.ws + WS_WKVQ), (size_t)(6144 + 64 * nb), DM, F.lane); continue; } r -= T_BQ;
        if (r < T_BOUT) { const int kb = r / 32, nb = r % 32; cvt_tile((const float*)A.in[18], DM, 64 * kb, 64 * nb, 64, (bf16*)(F.ws + WS_WBOUT), (size_t)64 * nb, 1024, F.lane); continue; } r -= T_BOUT;
        if (r < T_M) { const int e = r / T_ME, rr = r % T_ME, kb = rr / 112, nb = rr % 112, n0 = 64 * nb;
            cvt_tile((const float*)A.in[25] + (size_t)e * DM * DFFE, DFFE, 64 * kb, n0, 64, (bf16*)(F.ws + WS_WM13), (size_t)e * 14336 + (n0 >> 7) * 256 + (n0 & 127), DM, F.lane); continue; } r -= T_M;
        if (r < T_M) { const int e = r / T_ME, rr = r % T_ME, kb = rr / 112, nb = rr % 112, n0 = 64 * nb;
            cvt_tile((const float*)A.in[26] + (size_t)e * DM * DFFE, DFFE, 64 * kb, n0, 64, (bf16*)(F.ws + WS_WM13), (size_t)e * 14336 + (n0 >> 7) * 256 + 128 + (n0 & 127), DM, F.lane); continue; } r -= T_M;
        { const int e = r / T_ME, rr = r % T_ME, kb = rr / 32, nb = rr % 32;
            cvt_tile((const float*)A.in[27] + (size_t)e * DFFE * DM, DM, 64 * kb, 64 * nb, 64, (bf16*)(F.ws + WS_WM2), (size_t)e * 2048 + 64 * nb, DFFE, F.lane); }
    }
}

__device__ __forceinline__ float row_rstd(const f32x4 (&v)[8]) {
    float ss = 0.f;
#pragma unroll
    for (int j = 0; j < 8; ++j) ss += (v[j].x * v[j].x + v[j].y * v[j].y) + (v[j].z * v[j].z + v[j].w * v[j].w);
    return 1.0f / sqrtf(wave_sum(ss) * (1.0f / DM) + EPS);
}
__device__ __forceinline__ void modulate_store(const f32x4 (&v)[8], float rstd, const float* g, const float* sh, const float* sc, bf16* orow, int lane) {
#pragma unroll
    for (int j = 0; j < 8; ++j) { const int col = 4 * lane + 256 * j;
        const f32x4 gg = *(const f32x4*)(g + col), s1 = *(const f32x4*)(sc + col), s0 = *(const f32x4*)(sh + col);
        const f32x4 y = v[j] * rstd * gg * (s1 + 1.0f) + s0;
        v2u w; w.x = pk2(y.x, y.y); w.y = pk2(y.z, y.w); *(v2u*)(orow + col) = w; }
}
__device__ __forceinline__ void normmod_phase(Frame& F, const float* X, const float* g, const float* modsh, const float* modsc, bf16* out) {
    const int gw = F.bid * NWAVES + F.wave, NGW = F.G * NWAVES;
    for (int row = gw; row < MTOK; row += NGW) { const int b = row >> 11;
        f32x4 v[8]; const float* xr = X + (size_t)row * DM + 4 * F.lane;
#pragma unroll
        for (int j = 0; j < 8; ++j) v[j] = *(const f32x4*)(xr + 256 * j);
        const float rstd = row_rstd(v);
        modulate_store(v, rstd, g, modsh + (size_t)b * NMOD, modsc + (size_t)b * NMOD, out + (size_t)row * DM, F.lane); }
}

constexpr float NEG_S = -3.0e38f;
__device__ __forceinline__ void p3_qknorm(Frame& F, const Args& A) {
    const bf16* P0 = (const bf16*)(F.ws + WS_P0); bf16* QN = (bf16*)(F.ws + WS_QN); bf16* KN = (bf16*)(F.ws + WS_KN);
    const float* gq = (const float*)A.in[10]; const float* gk = (const float*)A.in[11];
    const int gw = F.bid * NWAVES + F.wave, NGW = F.G * NWAVES, li = F.lane & 15, g4 = F.lane >> 4;
    const float QS = 0.08838834764831845f * LOG2E;
    float gqv[8], gkv[8];
#pragma unroll
    for (int e = 0; e < 8; ++e) { gqv[e] = gq[8 * li + e] * QS; gkv[e] = gk[8 * li + e]; }
    for (int tok = gw; tok < MTOK; tok += NGW) {
        const bf16* pr = P0 + (size_t)tok * A_INP;
#pragma unroll
        for (int i = 0; i < 5; ++i) { const int head = 4 * i + g4;
            const v4u w = *(const v4u*)(pr + head * 128 + 8 * li);
            float x[8] = {bflo(w.x), bfhi(w.x), bflo(w.y), bfhi(w.y), bflo(w.z), bfhi(w.z), bflo(w.w), bfhi(w.w)};
            float ss = 0.f;
#pragma unroll
            for (int e = 0; e < 8; ++e) ss += x[e] * x[e];
            ss += __shfl_xor(ss, 8); ss += __shfl_xor(ss, 4); ss += __shfl_xor(ss, 2); ss += __shfl_xor(ss, 1);
            const float rstd = 1.0f / sqrtf(ss * (1.0f / 128.0f) + EPS);
            v4u o;
            if (i < 4) { o.x = pk2(x[0] * rstd * gqv[0], x[1] * rstd * gqv[1]); o.y = pk2(x[2] * rstd * gqv[2], x[3] * rstd * gqv[3]); o.z = pk2(x[4] * rstd * gqv[4], x[5] * rstd * gqv[5]); o.w = pk2(x[6] * rstd * gqv[6], x[7] * rstd * gqv[7]);
                *(v4u*)(QN + (size_t)tok * DM + head * 128 + 8 * li) = o; }
            else { o.x = pk2(x[0] * rstd * gkv[0], x[1] * rstd * gkv[1]); o.y = pk2(x[2] * rstd * gkv[2], x[3] * rstd * gkv[3]); o.z = pk2(x[4] * rstd * gkv[4], x[5] * rstd * gkv[5]); o.w = pk2(x[6] * rstd * gkv[6], x[7] * rstd * gkv[7]);
                *(v4u*)(KN + (size_t)tok * 512 + (head - 16) * 128 + 8 * li) = o; }
        }
    }
}
__device__ __forceinline__ void p3_vtrans(Frame& F) {
    const bf16* P0 = (const bf16*)(F.ws + WS_P0); bf16* VT = (bf16*)(F.ws + WS_VT);
    LAS unsigned* tile = (LAS unsigned*)F.lds;
    for (int item = F.bid; item < MTOK / 64; item += F.G) { const int tok0 = item * 64, b = tok0 >> 11, t0 = tok0 & 2047;
        __syncthreads();
#pragma unroll
        for (int p = 0; p < 8; ++p) { const int row = p * 8 + (F.tid >> 6), cw = (F.tid & 63) * 4;
            const v4u w = *(const v4u*)(P0 + (size_t)(tok0 + row) * A_INP + C_V + 2 * cw);
            tile[row * 257 + cw] = w.x; tile[row * 257 + cw + 1] = w.y; tile[row * 257 + cw + 2] = w.z; tile[row * 257 + cw + 3] = w.w; }
        __syncthreads();
#pragma unroll
        for (int p = 0; p < 8; ++p) { const int task = p * 512 + F.tid, tg = task & 7, col = task >> 3;
            const LAS unsigned short* tp = (const LAS unsigned short*)tile + col;
            unsigned short h[8];
#pragma unroll
            for (int i = 0; i < 8; ++i) h[i] = tp[(size_t)(tg * 8 + i) * 514];
            v4u o; o.x = h[0] | ((unsigned)h[1] << 16); o.y = h[2] | ((unsigned)h[3] << 16); o.z = h[4] | ((unsigned)h[5] << 16); o.w = h[6] | ((unsigned)h[7] << 16);
            *(v4u*)(VT + ((size_t)(b * 512 + col)) * SEQ + t0 + tg * 8) = o; }
    }
    __syncthreads();
}
__device__ __forceinline__ void p3_indexer_pair(Frame& F, int pair) {
    const bf16* P0 = (const bf16*)(F.ws + WS_P0); unsigned* MASK = (unsigned*)(F.ws + WS_MASK);
    const int b = pair >> 10, t0 = (pair & 1023) * 2, lane = F.lane, c = lane & 31, hh = lane >> 5;
    const bf16* Pb = P0 + (size_t)b * SEQ * A_INP;
    const int qsel = (c >> 2) & 1, ahead = (c & 3) + 4 * (c >> 3);
    const bf16* ap = Pb + (size_t)(t0 + qsel) * A_INP + C_QI + ahead * 64 + 8 * hh;
    bf16x8 af[4];
#pragma unroll
    for (int ks = 0; ks < 4; ++ks) af[ks] = *(const bf16x8*)(ap + 16 * ks);
    const bf16* wp = Pb + (size_t)(t0 + hh) * A_INP + C_WI;
    const v4u w0 = *(const v4u*)wp, w1 = *(const v4u*)(wp + 8);
    const float WS_ = 0.25f * 0.125f;
    const float wv[16] = {bflo(w0.x) * WS_, bfhi(w0.x) * WS_, bflo(w0.y) * WS_, bfhi(w0.y) * WS_, bflo(w0.z) * WS_, bfhi(w0.z) * WS_, bflo(w0.w) * WS_, bfhi(w0.w) * WS_,
                          bflo(w1.x) * WS_, bfhi(w1.x) * WS_, bflo(w1.y) * WS_, bfhi(w1.y) * WS_, bflo(w1.z) * WS_, bfhi(w1.z) * WS_, bflo(w1.w) * WS_, bfhi(w1.w) * WS_};
    const int tq = t0 + hh, ktmax = (t0 + 1) >> 5;
    LAS float* scL = (LAS float*)(F.lds + F.wave * 16384) + lane;
    for (int kg = 0; 4 * kg <= ktmax; ++kg) {
        bf16x8 bfr[4][4];
        const bf16* bp = Pb + (size_t)(128 * kg + c) * A_INP + C_KI + 8 * hh;
#pragma unroll
        for (int u = 0; u < 4; ++u)
#pragma unroll
            for (int ks = 0; ks < 4; ++ks) bfr[u][ks] = *(const bf16x8*)(bp + (size_t)(32 * u) * A_INP + 16 * ks);
#pragma unroll
        for (int u = 0; u < 4; ++u) { f32x16 d;
#pragma unroll
            for (int t = 0; t < 16; ++t) d[t] = 0.f;
#pragma unroll
            for (int ks = 0; ks < 4; ++ks) d = MFMA32(af[ks], bfr[u][ks], d);
            float s = 0.f;
#pragma unroll
            for (int t = 0; t < 16; ++t) s += fmaxf(d[t], 0.f) * wv[t];
            scL[(4 * kg + u) * 64] = (32 * (4 * kg + u) + c <= tq) ? s : NEG_S; }
    }
    LDS_WAIT();
    float sc[64];
#pragma unroll
    for (int k = 0; k < 64; ++k) { const float v = scL[k * 64]; sc[k] = (k <= ktmax) ? v : NEG_S; }
    LDS_WAIT();
    float mx = NEG_S, mn = 3.0e38f;
#pragma unroll
    for (int k = 0; k < 64; ++k) { mx = fmaxf(mx, sc[k]); mn = (sc[k] > -1.0e38f) ? fminf(mn, sc[k]) : mn; }
#pragma unroll
    for (int o = 16; o >= 1; o >>= 1) { mx = fmaxf(mx, __shfl_xor(mx, o)); mn = fminf(mn, __shfl_xor(mn, o)); }
    bool done = (tq + 1 <= 256); float lo = mn, hi = mx, thr = done ? -1.0e38f : mn;
    for (int it = 0; it < 48; ++it) {
        if (__all(done)) break;
        const float mid = 0.5f * (lo + hi);
        int cnt = 0;
#pragma unroll
        for (int k = 0; k < 64; ++k) cnt += (sc[k] >= mid) ? 1 : 0;
#pragma unroll
        for (int o = 16; o >= 1; o >>= 1) cnt += __shfl_xor(cnt, o);
        if (!done) {
            if (!(mid > lo) || !(mid < hi)) { done = true; thr = lo; }
            else if (cnt >= 256) { lo = mid; thr = mid; done = (cnt == 256); }
            else hi = mid;
        }
    }
    unsigned wA = 0u, wB = 0u;
#pragma unroll
    for (int k = 0; k < 64; ++k) { const unsigned long long bal = __ballot(sc[k] >= thr); if (lane == k) { wA = (unsigned)bal; wB = (unsigned)(bal >> 32); } }
    MASK[((size_t)b * SEQ + t0) * 64 + lane] = wA; MASK[((size_t)b * SEQ + t0 + 1) * 64 + lane] = wB;
}

__device__ __forceinline__ int kperm(int r) { return (r & ~12) | ((r & 4) << 1) | ((r & 8) >> 1); }
__device__ __forceinline__ void p4_attn_item(Frame& F, const Args& A, int item) {
    const bf16* QN = (const bf16*)(F.ws + WS_QN); const bf16* KN = (const bf16*)(F.ws + WS_KN); const bf16* VT = (const bf16*)(F.ws + WS_VT);
    const unsigned* MASK = (const unsigned*)(F.ws + WS_MASK); const float* BT = (const float*)(F.ws + WS_BT); bf16* OB = (bf16*)(F.ws + WS_O);
    const int* pos = (const int*)A.in[2];
    const int qt = item >> 4, bk = item & 15, b = bk >> 2, kvh = bk & 3;
    LAS float* tab = (LAS float*)F.lds; LAS int* posL = (LAS int*)(F.lds + 32768);
    __syncthreads();
    for (int i = F.tid; i < 4 * 2048; i += NWAVES * 64) tab[i] = BT[kvh * 4 * 2048 + i];
    for (int i = F.tid; i < SEQ; i += NWAVES * 64) posL[i] = pos[b * SEQ + i];
    __syncthreads();
    const int w = F.wave, hd = w & 3, head = kvh * 4 + hd, qw0 = qt * 64 + 32 * (w >> 2), lane = F.lane, c = lane & 31, hh = lane >> 5;
    const size_t tokq = (size_t)b * SEQ + qw0 + c;
    const bf16* qp = QN + tokq * DM + head * 128 + 8 * hh;
    bf16x8 qf[8];
#pragma unroll
    for (int ks = 0; ks < 8; ++ks) qf[ks] = *(const bf16x8*)(qp + 16 * ks);
    const int pq = posL[qw0 + c];
    const unsigned* mrow = MASK + tokq * 64;
    const LAS float* tb = tab + hd * 2048;
    f32x16 O[4];
#pragma unroll
    for (int db = 0; db < 4; ++db)
#pragma unroll
        for (int t = 0; t < 16; ++t) O[db][t] = 0.f;
    float m = -1.0e30f, l = 0.f;
    const int ktmax = (qw0 + 31) >> 5;
    const bf16* kbase = KN + ((size_t)b * SEQ + kperm(c)) * 512 + kvh * 128 + 8 * hh;
    const bf16* vbase = VT + ((size_t)(b * 4 + kvh) * 128 + c) * SEQ + 8 * hh;
    for (int kt = 0; kt <= ktmax; ++kt) {
        const int key0 = kt * 32;
        const unsigned mw = mrow[kt] >> (8 * hh);
        bf16x8 kf[8];
#pragma unroll
        for (int ks = 0; ks < 8; ++ks) kf[ks] = *(const bf16x8*)(kbase + (size_t)key0 * 512 + 16 * ks);
        f32x16 S;
#pragma unroll
        for (int t = 0; t < 16; ++t) S[t] = 0.f;
#pragma unroll
        for (int ks = 0; ks < 8; ++ks) S = MFMA32(kf[ks], qf[ks], S);
        const i32x4 p0 = *(const LAS i32x4*)(posL + key0 + 8 * hh), p1 = *(const LAS i32x4*)(posL + key0 + 8 * hh + 4), p2 = *(const LAS i32x4*)(posL + key0 + 16 + 8 * hh), p3 = *(const LAS i32x4*)(posL + key0 + 16 + 8 * hh + 4);
        const int pk[16] = {p0.x, p0.y, p0.z, p0.w, p1.x, p1.y, p1.z, p1.w, p2.x, p2.y, p2.z, p2.w, p3.x, p3.y, p3.z, p3.w};
        float s[16]; float mx = -1.0e30f;
#pragma unroll
        for (int t = 0; t < 16; ++t) { const int bit = (t & 7) + 16 * (t >> 3);
            int idx = pq - pk[t]; idx = idx < 0 ? 0 : (idx > 2047 ? 2047 : idx);
            const float v = S[t] + tb[idx];
            s[t] = ((mw >> bit) & 1u) ? v : -1.0e30f; mx = fmaxf(mx, s[t]); }
        mx = fmaxf(mx, __shfl_xor(mx, 32));
        const float mnew = fmaxf(m, mx), alpha = __builtin_amdgcn_exp2f(m - mnew);
        float p[16]; float ls = 0.f;
#pragma unroll
        for (int t = 0; t < 16; ++t) { p[t] = (s[t] > -1.0e29f) ? __builtin_amdgcn_exp2f(s[t] - mnew) : 0.f; ls += p[t]; }
        l = l * alpha + ls; m = mnew;
#pragma unroll
        for (int db = 0; db < 4; ++db)
#pragma unroll
            for (int t = 0; t < 16; ++t) O[db][t] *= alpha;
        const bf16x8 pf0 = pack8(p[0], p[1], p[2], p[3], p[4], p[5], p[6], p[7]), pf1 = pack8(p[8], p[9], p[10], p[11], p[12], p[13], p[14], p[15]);
#pragma unroll
        for (int db = 0; db < 4; ++db) {
            const bf16x8 v0 = *(const bf16x8*)(vbase + (size_t)(32 * db) * SEQ + key0), v1 = *(const bf16x8*)(vbase + (size_t)(32 * db) * SEQ + key0 + 16);
            O[db] = MFMA32(v0, pf0, O[db]); O[db] = MFMA32(v1, pf1, O[db]); }
    }
    l += __shfl_xor(l, 32);
    const float inv = 1.0f / l;
    bf16* op = OB + tokq * DM + head * 128 + 4 * hh;
#pragma unroll
    for (int db = 0; db < 4; ++db)
#pragma unroll
        for (int g = 0; g < 4; ++g) { v2u w2; w2.x = pk2(O[db][4 * g] * inv, O[db][4 * g + 1] * inv); w2.y = pk2(O[db][4 * g + 2] * inv, O[db][4 * g + 3] * inv); *(v2u*)(op + 32 * db + 8 * g) = w2; }
}

__device__ __forceinline__ void p11_qknorm(Frame& F, const Args& A) {
    const bf16* KV = (const bf16*)(F.ws + WS_KV); const bf16* Q1 = (const bf16*)(F.ws + WS_Q1); bf16* K1N = (bf16*)(F.ws + WS_K1N); bf16* Q1N = (bf16*)(F.ws + WS_Q1N);
    const float* gk = (const float*)A.in[16]; const float* gq = (const float*)A.in[19];
    const int gw = F.bid * NWAVES + F.wave, NGW = F.G * NWAVES, li = F.lane & 7, g8 = F.lane >> 3;
    const float QS = 0.125f * LOG2E;
    float gqv[8], gkv[8];
#pragma unroll
    for (int e = 0; e < 8; ++e) { gqv[e] = gq[8 * li + e] * QS; gkv[e] = gk[8 * li + e]; }
    for (int tok = gw; tok < MTOK; tok += NGW) {
#pragma unroll
        for (int i = 0; i < 12; ++i) { const int head = 8 * (i % 6) + g8; const bool isq = i < 6;
            const bf16* src = isq ? Q1 + (size_t)tok * 3072 : KV + (size_t)tok * 6144;
            const v4u w = *(const v4u*)(src + head * 64 + 8 * li);
            float x[8] = {bflo(w.x), bfhi(w.x), bflo(w.y), bfhi(w.y), bflo(w.z), bfhi(w.z), bflo(w.w), bfhi(w.w)};
            float ss = 0.f;
#pragma unroll
            for (int e = 0; e < 8; ++e) ss += x[e] * x[e];
            ss += __shfl_xor(ss, 4); ss += __shfl_xor(ss, 2); ss += __shfl_xor(ss, 1);
            const float rstd = 1.0f / sqrtf(ss * (1.0f / 64.0f) + EPS);
            v4u o;
            if (isq) { o.x = pk2(x[0] * rstd * gqv[0], x[1] * rstd * gqv[1]); o.y = pk2(x[2] * rstd * gqv[2], x[3] * rstd * gqv[3]); o.z = pk2(x[4] * rstd * gqv[4], x[5] * rstd * gqv[5]); o.w = pk2(x[6] * rstd * gqv[6], x[7] * rstd * gqv[7]);
                *(v4u*)(Q1N + (size_t)tok * 3072 + head * 64 + 8 * li) = o; }
            else { o.x = pk2(x[0] * rstd * gkv[0], x[1] * rstd * gkv[1]); o.y = pk2(x[2] * rstd * gkv[2], x[3] * rstd * gkv[3]); o.z = pk2(x[4] * rstd * gkv[4], x[5] * rstd * gkv[5]); o.w = pk2(x[6] * rstd * gkv[6], x[7] * rstd * gkv[7]);
                *(v4u*)(K1N + (size_t)tok * 3072 + head * 64 + 8 * li) = o; }
        }
    }
}
__device__ __forceinline__ void p11_vtrans(Frame& F) {
    const bf16* KV = (const bf16*)(F.ws + WS_KV); bf16* VT1 = (bf16*)(F.ws + WS_VT1);
    LAS unsigned* tile = (LAS unsigned*)F.lds;
    for (int item = F.bid; item < NB * 3 * 16 * 4; item += F.G) {
        const int cg = item & 3, ch = (item >> 2) & 15, bg = item >> 6, g = bg % 3, b = bg / 3, t0 = ch * 128, lr = 2 * g, r = 1 << lr, nsub = SEQ >> lr;
        __syncthreads();
#pragma unroll
        for (int p = 0; p < 8; ++p) { const int row = p * 16 + (F.tid >> 5), cw = (F.tid & 31) * 4;
            const v4u w = *(const v4u*)(KV + (size_t)(b * SEQ + t0 + row) * 6144 + 3072 + g * 1024 + cg * 256 + 2 * cw);
            tile[row * 129 + cw] = w.x; tile[row * 129 + cw + 1] = w.y; tile[row * 129 + cw + 2] = w.z; tile[row * 129 + cw + 3] = w.w; }
        __syncthreads();
#pragma unroll
        for (int p = 0; p < 8; ++p) { const int task = p * 512 + F.tid, q = task & 15, col = task >> 4;
            const int rho = q & (r - 1), run = q >> lr;
            const LAS unsigned short* tp = (const LAS unsigned short*)tile + col;
            unsigned short h[8];
#pragma unroll
            for (int i = 0; i < 8; ++i) h[i] = tp[(size_t)(((8 * run + i) << lr) + rho) * 258];
            v4u o; o.x = h[0] | ((unsigned)h[1] << 16); o.y = h[2] | ((unsigned)h[3] << 16); o.z = h[4] | ((unsigned)h[5] << 16); o.w = h[6] | ((unsigned)h[7] << 16);
            *(v4u*)(VT1 + ((size_t)((b * 3 + g) * 1024 + cg * 256 + col)) * SEQ + rho * nsub + (t0 >> lr) + 8 * run) = o; }
    }
    __syncthreads();
}
__device__ __forceinline__ void p12_attn_item(Frame& F, const Args& A, int item) {
    const bf16* Q1N = (const bf16*)(F.ws + WS_Q1N); const bf16* K1N = (const bf16*)(F.ws + WS_K1N); const bf16* VT1 = (const bf16*)(F.ws + WS_VT1);
    const float* BT = (const float*)(F.ws + WS_BT); bf16* OG = (bf16*)(F.ws + WS_OG); float* LSE = (float*)(F.ws + WS_LSE);
    const int* pos = (const int*)A.in[2];
    const int jb = item & 7, head = (item >> 3) & 15, bg = item >> 7, g = bg % 3, b = bg / 3, lr = 2 * g, nsub = SEQ >> lr, tps = nsub >> 5;
    LAS float* tab = (LAS float*)F.lds; LAS int* posL = (LAS int*)(F.lds + 8192);
    __syncthreads();
    for (int i = F.tid; i < 2048; i += NWAVES * 64) { tab[i] = BT[head * 2048 + i]; posL[i] = pos[b * SEQ + i]; }
    __syncthreads();
    const int j = 8 * jb + F.wave, rho = j / tps, n0 = 32 * (j % tps), lane = F.lane, c = lane & 31, hh = lane >> 5;
    const int tq = ((n0 + c) << lr) + rho;
    const size_t tokq = (size_t)b * SEQ + tq;
    const bf16* qp = Q1N + tokq * 3072 + g * 1024 + head * 64 + 8 * hh;
    bf16x8 qf[4];
#pragma unroll
    for (int ks = 0; ks < 4; ++ks) qf[ks] = *(const bf16x8*)(qp + 16 * ks);
    const int pq = posL[tq];
    f32x16 O[2];
#pragma unroll
    for (int db = 0; db < 2; ++db)
#pragma unroll
        for (int t = 0; t < 16; ++t) O[db][t] = 0.f;
    float m = -1.0e30f, l = 0.f;
    const bf16* kcol = K1N + (size_t)b * SEQ * 3072 + g * 1024 + head * 64 + 8 * hh;
    const bf16* vbase = VT1 + ((size_t)((b * 3 + g) * 1024 + head * 64 + c)) * SEQ + rho * nsub + 8 * hh;
    const int pc = kperm(c);
    for (int kb = n0 - 128; kb <= n0; kb += 32) {
        if (kb < 0) continue;
        const bf16* kp = kcol + (size_t)(((kb + pc) << lr) + rho) * 3072;
        bf16x8 kf[4];
#pragma unroll
        for (int ks = 0; ks < 4; ++ks) kf[ks] = *(const bf16x8*)(kp + 16 * ks);
        f32x16 S;
#pragma unroll
        for (int t = 0; t < 16; ++t) S[t] = 0.f;
#pragma unroll
        for (int ks = 0; ks < 4; ++ks) S = MFMA32(kf[ks], qf[ks], S);
        float s[16]; float mx = -1.0e30f;
        const int nq = n0 + c;
#pragma unroll
        for (int t = 0; t < 16; ++t) { const int nk = kb + (t & 7) + 8 * hh + 16 * (t >> 3);
            int idx = pq - posL[(nk << lr) + rho]; idx = idx < 0 ? 0 : (idx > 2047 ? 2047 : idx);
            const float v = S[t] + tab[idx];
            s[t] = (nk <= nq && nk >= nq - 128) ? v : -1.0e30f; mx = fmaxf(mx, s[t]); }
        mx = fmaxf(mx, __shfl_xor(mx, 32));
        const float mnew = fmaxf(m, mx), alpha = __builtin_amdgcn_exp2f(m - mnew);
        float p[16]; float ls = 0.f;
#pragma unroll
        for (int t = 0; t < 16; ++t) { p[t] = (s[t] > -1.0e29f) ? __builtin_amdgcn_exp2f(s[t] - mnew) : 0.f; ls += p[t]; }
        l = l * alpha + ls; m = mnew;
#pragma unroll
        for (int db = 0; db < 2; ++db)
#pragma unroll
            for (int t = 0; t < 16; ++t) O[db][t] *= alpha;
        const bf16x8 pf0 = pack8(p[0], p[1], p[2], p[3], p[4], p[5], p[6], p[7]), pf1 = pack8(p[8], p[9], p[10], p[11], p[12], p[13], p[14], p[15]);
#pragma unroll
        for (int db = 0; db < 2; ++db) {
            const bf16x8 v0 = *(const bf16x8*)(vbase + (size_t)(32 * db) * SEQ + kb), v1 = *(const bf16x8*)(vbase + (size_t)(32 * db) * SEQ + kb + 16);
            O[db] = MFMA32(v0, pf0, O[db]); O[db] = MFMA32(v1, pf1, O[db]); }
    }
    l += __shfl_xor(l, 32);
    const float inv = 1.0f / l;
    bf16* op = OG + tokq * 3072 + g * 1024 + head * 64 + 4 * hh;
#pragma unroll
    for (int db = 0; db < 2; ++db)
#pragma unroll
        for (int gg = 0; gg < 4; ++gg) { v2u w2; w2.x = pk2(O[db][4 * gg] * inv, O[db][4 * gg + 1] * inv); w2.y = pk2(O[db][4 * gg + 2] * inv, O[db][4 * gg + 3] * inv); *(v2u*)(op + 32 * db + 8 * gg) = w2; }
    if (hh == 0) LSE[tokq * 48 + g * 16 + head] = m + __builtin_amdgcn_logf(l);
}
__device__ __forceinline__ void p13_merge(Frame& F) {
    const bf16* OG = (const bf16*)(F.ws + WS_OG); const float* LSE = (const float*)(F.ws + WS_LSE); bf16* O1 = (bf16*)(F.ws + WS_O1);
    const int gt = F.bid * (NWAVES * 64) + F.tid, NT = F.G * NWAVES * 64;
    for (int i = gt; i < MTOK * 128; i += NT) { const int tok = i >> 7, c8 = i & 127, head = c8 >> 3;
        const float l0 = LSE[(size_t)tok * 48 + head], l1 = LSE[(size_t)tok * 48 + 16 + head], l2 = LSE[(size_t)tok * 48 + 32 + head];
        const float mm = fmaxf(l0, fmaxf(l1, l2)); float w0 = __builtin_amdgcn_exp2f(l0 - mm), w1 = __builtin_amdgcn_exp2f(l1 - mm), w2 = __builtin_amdgcn_exp2f(l2 - mm);
        const float inv = 1.0f / (w0 + w1 + w2); w0 *= inv; w1 *= inv; w2 *= inv;
        const v4u a = *(const v4u*)(OG + (size_t)tok * 3072 + c8 * 8), bb = *(const v4u*)(OG + (size_t)tok * 3072 + 1024 + c8 * 8), cc = *(const v4u*)(OG + (size_t)tok * 3072 + 2048 + c8 * 8);
        v4u o;
        o.x = pk2(w0 * bflo(a.x) + w1 * bflo(bb.x) + w2 * bflo(cc.x), w0 * bfhi(a.x) + w1 * bfhi(bb.x) + w2 * bfhi(cc.x));
        o.y = pk2(w0 * bflo(a.y) + w1 * bflo(bb.y) + w2 * bflo(cc.y), w0 * bfhi(a.y) + w1 * bfhi(bb.y) + w2 * bfhi(cc.y));
        o.z = pk2(w0 * bflo(a.z) + w1 * bflo(bb.z) + w2 * bflo(cc.z), w0 * bfhi(a.z) + w1 * bfhi(bb.z) + w2 * bfhi(cc.z));
        o.w = pk2(w0 * bflo(a.w) + w1 * bflo(bb.w) + w2 * bflo(cc.w), w0 * bfhi(a.w) + w1 * bfhi(bb.w) + w2 * bfhi(cc.w));
        *(v4u*)(O1 + (size_t)tok * 1024 + c8 * 8) = o; }
}

__device__ __forceinline__ void p15_norm_route(Frame& F, const Args& A) {
    const float* X = A.out; const float* MOD = (const float*)(F.ws + WS_MOD); bf16* HA = (bf16*)(F.ws + WS_HA);
    const float* g = (const float*)A.in[7] + DM; const float* router = (const float*)A.in[23]; const float* rb = (const float*)A.in[24];
    int* r_exp = (int*)(F.ws + WS_ROUTE); int* r_pos = r_exp + 2 * MTOK; float* r_gate = (float*)(r_pos + 2 * MTOK);
    LAS float* RT = (LAS float*)F.lds;
    __syncthreads();
    for (int i = F.tid; i < DM * NEXP; i += NWAVES * 64) RT[(i & 7) * DM + (i >> 3)] = router[i];
    __syncthreads();
    const int gw = F.bid * NWAVES + F.wave, NGW = F.G * NWAVES;
    for (int row = gw; row < MTOK; row += NGW) { const int b = row >> 11;
        f32x4 v[8]; const float* xr = X + (size_t)row * DM + 4 * F.lane;
#pragma unroll
        for (int j = 0; j < 8; ++j) v[j] = *(const f32x4*)(xr + 256 * j);
        const float rstd = row_rstd(v);
        const float* sh = MOD + (size_t)b * NMOD + 12288 + 6144; const float* sc = MOD + (size_t)b * NMOD + 12288 + 8192;
        float lg[8];
#pragma unroll
        for (int e = 0; e < 8; ++e) lg[e] = 0.f;
        bf16* orow = HA + (size_t)row * DM;
#pragma unroll
        for (int j = 0; j < 8; ++j) { const int col = 4 * F.lane + 256 * j;
            const f32x4 gg = *(const f32x4*)(g + col), s1 = *(const f32x4*)(sc + col), s0 = *(const f32x4*)(sh + col);
            const f32x4 y = v[j] * rstd * gg * (s1 + 1.0f) + s0;
            v2u w; w.x = pk2(y.x, y.y); w.y = pk2(y.z, y.w); *(v2u*)(orow + col) = w;
#pragma unroll
            for (int e = 0; e < 8; ++e) { const f32x4 rr = *(const LAS f32x4*)(RT + e * DM + col); lg[e] += (y.x * rr.x + y.y * rr.y) + (y.z * rr.z + y.w * rr.w); }
            asm volatile("" ::: "memory"); }
#pragma unroll
        for (int e = 0; e < 8; ++e) lg[e] = wave_sum(lg[e]) + rb[e];
        int e0 = 0; float v0 = lg[0];
#pragma unroll
        for (int e = 1; e < 8; ++e) if (lg[e] > v0) { v0 = lg[e]; e0 = e; }
        int e1 = -1; float v1 = -3.0e38f;
#pragma unroll
        for (int e = 0; e < 8; ++e) if (e != e0 && lg[e] > v1) { v1 = lg[e]; e1 = e; }
        const float g1 = 1.0f / (1.0f + __expf(v0 - v1)), g0 = 1.0f - g1;
        if (F.lane == 0) {
            const unsigned p0 = __hip_atomic_fetch_add((unsigned*)(F.ctl + CW_CNT + 64 * e0), 1u, RLX_AGENT);
            const unsigned p1 = __hip_atomic_fetch_add((unsigned*)(F.ctl + CW_CNT + 64 * e1), 1u, RLX_AGENT);
            r_exp[2 * row] = e0; r_exp[2 * row + 1] = e1; r_pos[2 * row] = (int)p0; r_pos[2 * row + 1] = (int)p1; r_gate[2 * row] = g0; r_gate[2 * row + 1] = g1;
        }
    }
}
__device__ __forceinline__ void moe_offsets(Frame& F, int (&off)[9]) {
    off[0] = 0;
#pragma unroll
    for (int e = 0; e < 8; ++e) { const unsigned cnt = __hip_atomic_load((unsigned*)(F.ctl + CW_CNT + 64 * e), RLX_AGENT); off[e + 1] = off[e] + (int)((cnt + 255u) & ~255u); }
}
__device__ __forceinline__ void p16_gather(Frame& F) {
    const bf16* HA = (const bf16*)(F.ws + WS_HA); bf16* AS = (bf16*)(F.ws + WS_AS); float* RG = (float*)(F.ws + WS_RG); int* TR = (int*)(F.ws + WS_TR);
    const int* r_exp = (const int*)(F.ws + WS_ROUTE); const int* r_pos = r_exp + 2 * MTOK; const float* r_gate = (const float*)(r_pos + 2 * MTOK);
    int off[9]; moe_offsets(F, off);
    const int gw = F.bid * NWAVES + F.wave, NGW = F.G * NWAVES;
    for (int idx = gw; idx < 2 * MTOK; idx += NGW) {
        const int e = r_exp[idx], p = r_pos[idx]; int base = 0;
#pragma unroll
        for (int k = 1; k < 8; ++k) base = (e >= k) ? off[k] : base;
        const int row = base + p, tok = idx >> 1;
        const v4u* src = (const v4u*)(HA + (size_t)tok * DM) + F.lane; v4u* dst = (v4u*)(AS + (size_t)row * DM) + F.lane;
        const v4u a = src[0], b2 = src[64], c2 = src[128], d2 = src[192];
        dst[0] = a; dst[64] = b2; dst[128] = c2; dst[192] = d2;
        if (F.lane == 0) { RG[row] = r_gate[idx]; TR[idx] = row; }
    }
}
__device__ __forceinline__ void p19_final(Frame& F, const Args& A) {
    float* X = A.out; const float* MOD = (const float*)(F.ws + WS_MOD); const float* Y = (const float*)(F.ws + WS_Y); const int* TR = (const int*)(F.ws + WS_TR);
    const int gw = F.bid * NWAVES + F.wave, NGW = F.G * NWAVES;
    for (int row = gw; row < MTOK; row += NGW) { const int b = row >> 11; const int r0 = TR[2 * row], r1 = TR[2 * row + 1];
        const float* gt = MOD + (size_t)b * NMOD + 12288 + 10240;
        float* xr = X + (size_t)row * DM + 4 * F.lane; const float* y0 = Y + (size_t)r0 * DM + 4 * F.lane; const float* y1 = Y + (size_t)r1 * DM + 4 * F.lane;
#pragma unroll
        for (int j = 0; j < 8; ++j) { const f32x4 xv = *(const f32x4*)(xr + 256 * j), a = *(const f32x4*)(y0 + 256 * j), c2 = *(const f32x4*)(y1 + 256 * j), gg = *(const f32x4*)(gt + 4 * F.lane + 256 * j);
            *(f32x4*)(xr + 256 * j) = xv + gg * (a + c2); }
    }
}

constexpr int N_PHASES = 20;
__global__ void __launch_bounds__(NWAVES * 64, 2) yoco_fwd(Args args) {
    extern __shared__ __attribute__((aligned(16))) unsigned char lds[];
    Frame F;
    F.lds = (LAS unsigned char*)lds; F.MISC = (volatile LAS unsigned*)(F.lds + MISC_OFF);
    F.tid = threadIdx.x; F.lane = F.tid & 63; F.wave = __builtin_amdgcn_readfirstlane(F.tid >> 6); F.G = gridDim.x; F.bid = blockIdx.x;
    F.ws = args.ws; F.ctl = (gu32*)(args.ws + WS_CTL);
    for (int u = F.tid; u < (LDS_BYTES - LDSCTL_OFF) / 4; u += NWAVES * 64) ((LAS unsigned*)(F.lds + LDSCTL_OFF))[u] = 0u;
    __syncthreads();
    const int lo = args.ph_lo, hi = args.ph_hi;
    const bool one_launch = (hi - lo) > 1;
    XcdBarrier bar; bar.bar = (unsigned*)(F.ctl + CW_BAR); bar.x = 0; bar.st = nullptr;
    if (one_launch) bar = xcd_barrier_post((unsigned*)(F.ctl + CW_BAR), F.MISC + 8);
#ifndef PHASE_MASK
#define PHASE_MASK 0xFFFFFFFFu
#endif
#define IN(k) ((((PHASE_MASK) >> (k)) & 1u) && lo <= (k) && (k) < hi)
#define SEAM(k) do { if (IN(k) && IN((k) + 1)) xcd_barrier(bar); } while (0)
    float* const MOD = (float*)(F.ws + WS_MOD);
    const float* const MODc = MOD;
    bf16* const HA = (bf16*)(F.ws + WS_HA);
    const int gw = F.bid * NWAVES + F.wave, NGW = F.G * NWAVES;

    if (IN(0)) { p0_prologue(F, args); } SEAM(0);
    if (IN(1)) { normmod_phase(F, (const float*)args.in[0], (const float*)args.in[6], MODc + 0, MODc + 2048, HA); } SEAM(1);
    if (IN(2)) { pg8::Gemm g{HA, (const bf16*)(F.ws + WS_WIN), MTOK, A_INP, DM}; pg8::StaticOrder S; S.init(MTOK, A_INP, F.G, F.bid);
        pg8::EpiBf16Sel E{(bf16*)(F.ws + WS_P0), A_INP, nullptr, 0, 0, 1 << 30};
        pg8::gemm_phase<pg8::EpiBf16Sel, pg8::StaticOrder, true, true>(F.lds + RING_OFF, g, S, E); } SEAM(2);
    if (IN(3)) { p3_qknorm(F, args); p3_vtrans(F);
        for (int q = gw; q < MTOK / 4; q += NGW) {
            const int s0 = q, s1 = MTOK / 2 - 1 - q;
            p3_indexer_pair(F, (s0 & 3) * 1024 + (s0 >> 2)); p3_indexer_pair(F, (s1 & 3) * 1024 + (s1 >> 2)); } } SEAM(3);
    if (IN(4)) { for (int i = F.bid; i < 512; i += F.G) { const int item = (i < 256) ? ((31 - (i >> 4)) << 4 | (i & 15)) : (((i - 256) >> 4) << 4 | (i & 15)); p4_attn_item(F, args, item); } __syncthreads(); } SEAM(4);
    if (IN(5)) { pg8::Gemm g{(const bf16*)(F.ws + WS_O), (const bf16*)(F.ws + WS_WAOUT), MTOK, DM, DM}; pg8::StaticOrder S; S.init(MTOK, DM, F.G, F.bid);
        pg8::EpiResGate E{(const float*)args.in[0], args.out, MODc + 4096, NMOD};
        pg8::gemm_phase<pg8::EpiResGate, pg8::StaticOrder, false, true>(F.lds + RING_OFF, g, S, E); } SEAM(5);
    if (IN(6)) { normmod_phase(F, args.out, (const float*)args.in[7], MODc + 6144, MODc + 8192, HA); } SEAM(6);
    if (IN(7)) { pg8::Gemm g{HA, (const bf16*)(F.ws + WS_WF13), MTOK, 2 * DFF, DM}; pg8::StaticOrder S; S.init(MTOK, 2 * DFF, F.G, F.bid);
        pg8::EpiSwiGLU E{(bf16*)(F.ws + WS_U), DFF, 2 * DFF / 256};
        pg8::gemm_phase<pg8::EpiSwiGLU, pg8::StaticOrder, true, true>(F.lds + RING_OFF, g, S, E); } SEAM(7);
    if (IN(8)) { pg8::Gemm g{(const bf16*)(F.ws + WS_U), (const bf16*)(F.ws + WS_WF2), MTOK, DM, DFF}; pg8::StaticOrder S; S.init(MTOK, DM, F.G, F.bid);
        pg8::EpiResGate E{args.out, args.out, MODc + 10240, NMOD};
        pg8::gemm_phase<pg8::EpiResGate, pg8::StaticOrder, false, true>(F.lds + RING_OFF, g, S, E); } SEAM(8);
    if (IN(9)) { const float* X = args.out; const float* gk = (const float*)args.in[14]; const float* ga = (const float*)args.in[6] + DM;
        for (int row = gw; row < MTOK; row += NGW) { const int b = row >> 11;
            f32x4 v[8]; const float* xr = X + (size_t)row * DM + 4 * F.lane;
#pragma unroll
            for (int j = 0; j < 8; ++j) v[j] = *(const f32x4*)(xr + 256 * j);
            const float rstd = row_rstd(v);
            modulate_store(v, rstd, gk, MODc + (size_t)b * NMOD + 24576, MODc + (size_t)b * NMOD + 24576 + 2048, HA + (size_t)row * DM, F.lane);
            modulate_store(v, rstd, ga, MODc + (size_t)b * NMOD + 12288, MODc + (size_t)b * NMOD + 12288 + 2048, HA + (size_t)(MTOK + row) * DM, F.lane); } } SEAM(9);
    if (IN(10)) { pg8::Gemm g{HA, (const bf16*)(F.ws + WS_WKVQ), 2 * MTOK, 9216, DM}; pg8::DualOrder S; S.init(MTOK / 256, 24, 12, MTOK / 256, 24, F.G, F.bid);
        pg8::EpiBf16Sel E{(bf16*)(F.ws + WS_KV), 6144, (bf16*)(F.ws + WS_Q1), 3072, MTOK / 256, 24};
        pg8::gemm_phase<pg8::EpiBf16Sel, pg8::DualOrder, true, true>(F.lds + RING_OFF, g, S, E); } SEAM(10);
    if (IN(11)) { p11_qknorm(F, args); p11_vtrans(F); } SEAM(11);
    if (IN(12)) { for (int item = F.bid; item < NB * 3 * 16 * 8; item += F.G) p12_attn_item(F, args, item); __syncthreads(); } SEAM(12);
    if (IN(13)) { p13_merge(F); } SEAM(13);
    if (IN(14)) { pg8::Gemm g{(const bf16*)(F.ws + WS_O1), (const bf16*)(F.ws + WS_WBOUT), MTOK, DM, 1024}; pg8::StaticOrder S; S.init(MTOK, DM, F.G, F.bid);
        pg8::EpiResGate E{args.out, args.out, MODc + 12288 + 4096, NMOD};
        pg8::gemm_phase<pg8::EpiResGate, pg8::StaticOrder, false, true>(F.lds + RING_OFF, g, S, E); } SEAM(14);
    if (IN(15)) { p15_norm_route(F, args); } SEAM(15);
    if (IN(16)) { p16_gather(F); } SEAM(16);
    if (IN(17)) { int off[9]; moe_offsets(F, off); pg8::MoeOrder S;
#pragma unroll
        for (int e = 0; e < 9; ++e) S.toff[e] = off[e] >> 8;
        S.nN = 2 * DFFE / 256; S.T = S.toff[8]; S.total = S.T * S.nN; S.G = F.G; S.c = F.bid;
        pg8::Gemm g{(const bf16*)(F.ws + WS_AS), (const bf16*)(F.ws + WS_WM13), MROWS, 2 * DFFE, DM};
        pg8::EpiSwiGLU E{(bf16*)(F.ws + WS_UM), DFFE, 2 * DFFE / 256};
        pg8::gemm_phase<pg8::EpiSwiGLU, pg8::MoeOrder, true, true>(F.lds + RING_OFF, g, S, E); } SEAM(17);
    if (IN(18)) { int off[9]; moe_offsets(F, off); pg8::MoeOrder S;
#pragma unroll
        for (int e = 0; e < 9; ++e) S.toff[e] = off[e] >> 8;
        S.nN = DM / 256; S.T = S.toff[8]; S.total = S.T * S.nN; S.G = F.G; S.c = F.bid;
        pg8::Gemm g{(const bf16*)(F.ws + WS_UM), (const bf16*)(F.ws + WS_WM2), MROWS, DM, DFFE};
        pg8::EpiRowScale E{(float*)(F.ws + WS_Y), (const float*)(F.ws + WS_RG), DM / 256};
        pg8::gemm_phase<pg8::EpiRowScale, pg8::MoeOrder, true, true>(F.lds + RING_OFF, g, S, E); } SEAM(18);
    if (IN(19)) { p19_final(F, args); }
#undef IN
#undef SEAM
}

#ifndef MK_PER_PHASE
#define MK_PER_PHASE 0
#endif
extern "C" void kernel_launch(void* const* d_in, const int* in_sizes, int n_in, void* d_out, int out_size, void* d_ws, size_t ws_size, hipStream_t stream) {
    static int grid = 0;
    if (grid == 0) {
        if (n_in != 28 || out_size != MTOK * DM || ws_size < WS_END) { fprintf(stderr, "kernel_launch: unexpected shapes (n_in %d, out %d, ws %zu < %zu)\n", n_in, out_size, ws_size, (size_t)WS_END); grid = -1; return; }
        int dev = 0, cus = 0, per_cu = 0;
        if (hipGetDevice(&dev) != hipSuccess || hipDeviceGetAttribute(&cus, hipDeviceAttributeMultiprocessorCount, dev) != hipSuccess) { grid = -1; return; }
        if (hipFuncSetAttribute((const void*)yoco_fwd, hipFuncAttributeMaxDynamicSharedMemorySize, LDS_BYTES) != hipSuccess) { fprintf(stderr, "kernel_launch: hipFuncSetAttribute failed\n"); grid = -1; return; }
        if (hipOccupancyMaxActiveBlocksPerMultiprocessor(&per_cu, (const void*)yoco_fwd, NWAVES * 64, LDS_BYTES) != hipSuccess || per_cu < 1) fprintf(stderr, "kernel_launch: occupancy query reports %d\n", per_cu);
        (void)hipGetLastError();
        grid = cus;
    }
    if (grid < 0) return;
    if (hipMemsetAsync((char*)d_ws + WS_CTL, 0, CTL_ZERO_BYTES, stream) != hipSuccess) return;
    Args a{};
    for (int i = 0; i < 28; ++i) a.in[i] = d_in[i];
    a.out = (float*)d_out; a.ws = (unsigned char*)d_ws;
#if MK_PER_PHASE
    for (int p = 0; p < N_PHASES; ++p) { a.ph_lo = p; a.ph_hi = p + 1; hipLaunchKernelGGL(yoco_fwd, dim3(grid), dim3(NWAVES * 64), LDS_BYTES, stream, a); }
#else
    a.ph_lo = 0; a.ph_hi = N_PHASES;
    hipLaunchKernelGGL(yoco_fwd, dim3(grid), dim3(NWAVES * 64), LDS_BYTES, stream, a);
#endif
    const hipError_t le = hipPeekAtLastError();
    if (le != hipSuccess) fprintf(stderr, "kernel_launch: launch failed: %s\n", hipGetErrorName(le));
}
```

```cpp
#include <hip/hip_runtime.h>
#include <cstdio>
#include <cstdint>
namespace pg8 {
#define PG8_LAS __attribute__((address_space(3)))
typedef unsigned short bf16_t;
typedef short bf16x8 __attribute__((ext_vector_type(8)));
typedef float f32x4 __attribute__((ext_vector_type(4)));
typedef unsigned u32x4 __attribute__((ext_vector_type(4)));
constexpr int BM = 256, BK = 64, HALF = 128, HTB = HALF * BK * 2  , STAGE_BYTES = 8 * HTB, NXCD = 8, WGM = 8;

__host__ __device__ __forceinline__ int lds_byte(int r, int c) { const int st = (r >> 4) * 2 + (c >> 5), rr = r & 15, cc = c & 31, ob = rr * 64 + cc * 2; return st * 1024 + (ob ^ (((ob >> 9) & 1) << 5)); }
__host__ __device__ __forceinline__ void stage_rc(int b, int& R, int& C) { const int st = b / 1024, sb = b % 1024, swz = sb ^ (((sb >> 9) & 1) << 5); R = (st >> 1) * 16 + swz / 64; C = (st & 1) * 32 + (swz % 64) / 2; }
__host__ __device__ __forceinline__ int perm32(int rho) { const int n = rho >> 4, i = rho & 15; return 8 * (i >> 2) + 4 * n + (i & 3); }

struct Unit { int pm, pn; };
struct Gemm { const bf16_t* A; const bf16_t* Bt; int M, N, K; };

__device__ __forceinline__ void tile_map(int L, int nM, int nN, int& pm, int& pn) {
    const int nwg = nM * nN; int wgid = L;
    { const int q = nwg / NXCD, r = nwg % NXCD, xcd = wgid % NXCD, off = wgid / NXCD; wgid = (xcd < r ? xcd * (q + 1) : r * (q + 1) + (xcd - r) * q) + off; }
    const int nig = WGM * nN, gid = wgid / nig, fm = gid * WGM, gsz = (nM - fm) < WGM ? (nM - fm) : WGM;
    pm = fm + ((wgid % nig) % gsz); pn = (wgid % nig) / gsz;
}
struct StaticOrder {
    int nM, nN, nwg, G, c;
    __device__ void init(int M, int N, int G_, int c_) { nM = M / BM; nN = N / BM; nwg = nM * nN; G = G_; c = c_; }
    __device__ bool next(int i, Unit& u) const { const long L = (long)i * G + c; if (L >= nwg) return false; tile_map((int)L, nM, nN, u.pm, u.pn); return true; }
    __device__ __forceinline__ void a_ready(const Unit&) const {}
    __device__ __forceinline__ void done(const Unit&) const {}
};
struct DualOrder {
    int nM, nN1, nN2, n1, ntot, pm_off, pn_off, G, c;
    __device__ void init(int nM_, int nN1_, int nN2_, int pm_off_, int pn_off_, int G_, int c_) { nM = nM_; nN1 = nN1_; nN2 = nN2_; n1 = nM * nN1; ntot = n1 + nM * nN2; pm_off = pm_off_; pn_off = pn_off_; G = G_; c = c_; }
    __device__ bool next(int i, Unit& u) const { const long L = (long)i * G + c; if (L >= ntot) return false;
        if (L < n1) tile_map((int)L, nM, nN1, u.pm, u.pn); else { tile_map((int)L - n1, nM, nN2, u.pm, u.pn); u.pm += pm_off; u.pn += pn_off; } return true; }
    __device__ __forceinline__ void a_ready(const Unit&) const {}
    __device__ __forceinline__ void done(const Unit&) const {}
};
struct MoeOrder {
    int toff[9]; int nN, T, total, G, c;
    __device__ bool next(int i, Unit& u) const {
        long v;
        if ((G & 7) == 0) { const int x = c & 7, j = c >> 3, nper = G >> 3; const long s0 = ((long)x * total) >> 3, s1 = ((long)(x + 1) * total) >> 3; v = s0 + (long)i * nper + j; if (v >= s1) return false; }
        else { v = (long)i * G + c; if (v >= total) return false; }
        int e = 0, te = 0, te1 = toff[1];
#pragma unroll
        for (int k = 1; k < 8; ++k) { const bool ge = v >= (long)toff[k] * nN; e = ge ? k : e; te = ge ? toff[k] : te; te1 = ge ? toff[k + 1] : te1; }
        const int r = (int)(v - (long)te * nN), ne = te1 - te;
        u.pm = te + r % ne; u.pn = e * nN + r / ne; return true; }
    __device__ __forceinline__ void a_ready(const Unit&) const {}
    __device__ __forceinline__ void done(const Unit&) const {}
};

__device__ __forceinline__ unsigned cvt_pk_bf16(float lo, float hi) { unsigned r; asm volatile("v_cvt_pk_bf16_f32 %0, %1, %2" : "=v"(r) : "v"(lo), "v"(hi)); return r; }

struct EpiBf16Sel {
    static constexpr bool PERM = true, AFTER_DRAIN = false;
    bf16_t* O0; int ld0; bf16_t* O1; int ld1; int pm_split, pn_split;
    __device__ __forceinline__ void operator()(const f32x4 (&acc)[2][2][4][2], const Unit& u, int wr, int wc, int fr, int fq) const {
        bf16_t* base = O0; int ldc = ld0, pm = u.pm, pn = u.pn;
        if (pn >= pn_split) { base = O1; ldc = ld1; pm -= pm_split; pn -= pn_split; }
        const int row0 = pm * BM + wr * 64 + fr, col0 = pn * BM + wc * 32 + 8 * fq;
#pragma unroll
        for (int ai = 0; ai < 2; ++ai)
#pragma unroll
            for (int m = 0; m < 4; ++m) { bf16_t* rowp = base + (size_t)(row0 + ai * HALF + m * 16) * ldc + col0;
#pragma unroll
                for (int bj = 0; bj < 2; ++bj) { const f32x4 v0 = acc[ai][bj][m][0], v1 = acc[ai][bj][m][1];
                    u32x4 w; w.x = cvt_pk_bf16(v0[0], v0[1]); w.y = cvt_pk_bf16(v0[2], v0[3]); w.z = cvt_pk_bf16(v1[0], v1[1]); w.w = cvt_pk_bf16(v1[2], v1[3]);
                    *(u32x4*)(rowp + bj * HALF) = w; } }
    }
};
struct EpiResGate {
    static constexpr bool PERM = false, AFTER_DRAIN = false;
    const float* base; float* out; const float* gate; int gstride;
    __device__ __forceinline__ void operator()(const f32x4 (&acc)[2][2][4][2], const Unit& u, int wr, int wc, int fr, int fq) const {
        const int row0 = u.pm * BM + wr * 64 + fr, col0 = u.pn * BM + wc * 32 + 4 * fq;
        const float* gp = gate + (size_t)(u.pm >> 3) * gstride + col0;
        f32x4 gv[2][2];
#pragma unroll
        for (int bj = 0; bj < 2; ++bj)
#pragma unroll
            for (int n = 0; n < 2; ++n) gv[bj][n] = *(const f32x4*)(gp + bj * HALF + n * 16);
#pragma unroll
        for (int ai = 0; ai < 2; ++ai)
#pragma unroll
            for (int m = 0; m < 4; ++m) { const size_t off = (size_t)(row0 + ai * HALF + m * 16) * 2048 + col0;
#pragma unroll
                for (int bj = 0; bj < 2; ++bj)
#pragma unroll
                    for (int n = 0; n < 2; ++n) { const f32x4 bs = *(const f32x4*)(base + off + bj * HALF + n * 16); *(f32x4*)(out + off + bj * HALF + n * 16) = bs + gv[bj][n] * acc[ai][bj][m][n]; }
                asm volatile("" ::: "memory"); }
    }
};
struct EpiSwiGLU {
    static constexpr bool PERM = true, AFTER_DRAIN = false;
    bf16_t* O; int ldc; int nN;
    __device__ __forceinline__ void operator()(const f32x4 (&acc)[2][2][4][2], const Unit& u, int wr, int wc, int fr, int fq) const {
        const int row0 = u.pm * BM + wr * 64 + fr, col0 = (u.pn % nN) * HALF + wc * 32 + 8 * fq;
#pragma unroll
        for (int ai = 0; ai < 2; ++ai)
#pragma unroll
            for (int m = 0; m < 4; ++m) { bf16_t* rowp = O + (size_t)(row0 + ai * HALF + m * 16) * ldc + col0;
                float r[8];
#pragma unroll
                for (int n = 0; n < 2; ++n)
#pragma unroll
                    for (int j = 0; j < 4; ++j) { const float g = acc[ai][0][m][n][j], up = acc[ai][1][m][n][j];
                        r[4 * n + j] = g * up * __builtin_amdgcn_rcpf(1.0f + __builtin_amdgcn_exp2f(-1.4426950408889634f * g)); }
                u32x4 w; w.x = cvt_pk_bf16(r[0], r[1]); w.y = cvt_pk_bf16(r[2], r[3]); w.z = cvt_pk_bf16(r[4], r[5]); w.w = cvt_pk_bf16(r[6], r[7]);
                *(u32x4*)rowp = w; }
    }
};
struct EpiRowScale {
    static constexpr bool PERM = false, AFTER_DRAIN = false;
    float* Y; const float* rs; int nN;
    __device__ __forceinline__ void operator()(const f32x4 (&acc)[2][2][4][2], const Unit& u, int wr, int wc, int fr, int fq) const {
        const int row0 = u.pm * BM + wr * 64 + fr, col0 = (u.pn % nN) * BM + wc * 32 + 4 * fq;
#pragma unroll
        for (int ai = 0; ai < 2; ++ai)
#pragma unroll
            for (int m = 0; m < 4; ++m) { const int row = row0 + ai * HALF + m * 16; const float s = rs[row]; float* rowp = Y + (size_t)row * 2048 + col0;
#pragma unroll
                for (int bj = 0; bj < 2; ++bj)
#pragma unroll
                    for (int n = 0; n < 2; ++n) *(f32x4*)(rowp + bj * HALF + n * 16) = acc[ai][bj][m][n] * s; }
    }
};

template <class Epi, class Sched, bool ALIGN_EPI = false, bool SP2 = false>
__device__ __forceinline__ void gemm_phase(PG8_LAS unsigned char* lds, const Gemm g, const Sched& S, const Epi& E) {
    const int tid = threadIdx.x, wid = __builtin_amdgcn_readfirstlane(tid >> 6), lane = tid & 63, wr = wid >> 2, wc = wid & 3, fr = lane & 15, fq = lane >> 4;
    const int K = g.K, nt = K / BK;
    unsigned voffA[2], voffB[2];
#pragma unroll
    for (int i = 0; i < 2; ++i) { int R, C; stage_rc(tid * 16 + i * 8192, R, C); const int Rb = Epi::PERM ? ((R & ~31) + perm32(R & 31)) : R;
        voffA[i] = (unsigned)(R * K + C) * 2u; voffB[i] = (unsigned)(Rb * K + C) * 2u; }
    const size_t kstep = (size_t)(BK * 2);
    const size_t hstep = (size_t)HALF * K * 2;
    const size_t tstep = 2 * hstep;
    const unsigned ldsw = (unsigned)wid * 1024u;
    const int aoff = lds_byte(wr * 64 + fr, fq * 8), boff = lds_byte(wc * 32 + fr, fq * 8);
#define PG8_SA(b, h) (((b) * 2 + (h)) * HTB)
#define PG8_SB(b, h) ((4 + (b) * 2 + (h)) * HTB)
#define PG8_STAGE(bufoff, gbase, voff) do { _Pragma("unroll") for (int _i = 0; _i < 2; ++_i) \
        __builtin_amdgcn_global_load_lds((const unsigned*)((const char*)(gbase) + (voff)[_i]), (PG8_LAS unsigned*)(lds + (bufoff) + ldsw + _i * 8192), 16, 0, 0); } while (0)
#define PG8_LDA(dst, b, h) do { _Pragma("unroll") for (int m = 0; m < 4; ++m) _Pragma("unroll") for (int k = 0; k < 2; ++k) dst[m][k] = *(const PG8_LAS bf16x8*)(lds + PG8_SA(b, h) + aoff + m * 2048 + k * 1024); } while (0)
#define PG8_LDB(dst, b, h) do { _Pragma("unroll") for (int n = 0; n < 2; ++n) _Pragma("unroll") for (int k = 0; k < 2; ++k) dst[n][k] = *(const PG8_LAS bf16x8*)(lds + PG8_SB(b, h) + boff + n * 2048 + k * 1024); } while (0)
#define PG8_MMA(ai, bj, At, Bt) do { __builtin_amdgcn_s_setprio(1); _Pragma("unroll") for (int m = 0; m < 4; ++m) _Pragma("unroll") for (int n = 0; n < 2; ++n) _Pragma("unroll") for (int k = 0; k < 2; ++k) \
        acc[ai][bj][m][n] = __builtin_amdgcn_mfma_f32_16x16x32_bf16(Bt[n][k], At[m][k], acc[ai][bj][m][n], 0, 0, 0); __builtin_amdgcn_s_setprio(0); } while (0)
#define PG8_WAIT_V(n) asm volatile("s_waitcnt vmcnt(" #n ")" ::: "memory")
#define PG8_WAIT_L(n) asm volatile("s_waitcnt lgkmcnt(" #n ")" ::: "memory")
#define PG8_BAR __builtin_amdgcn_s_barrier()
#define PG8_SCHED __builtin_amdgcn_sched_barrier(0)
    Unit cur, nxt; int ui = 0;
    if (!S.next(0, cur)) return;
    f32x4 acc[2][2][4][2];
#pragma unroll
    for (int a = 0; a < 2; ++a)
#pragma unroll
        for (int b = 0; b < 2; ++b)
#pragma unroll
            for (int m = 0; m < 4; ++m)
#pragma unroll
                for (int n = 0; n < 2; ++n) acc[a][b][m][n] = (f32x4){0.f, 0.f, 0.f, 0.f};
    bf16x8 At[4][2], B0[2][2], B1[2][2];
    const char* cA = (const char*)g.A + (size_t)cur.pm * tstep; const char* cB = (const char*)g.Bt + (size_t)cur.pn * tstep;
    S.a_ready(cur);
    if constexpr (SP2) {
        PG8_STAGE(PG8_SB(0, 0), cB, voffB); PG8_STAGE(PG8_SB(0, 1), cB + hstep, voffB); PG8_STAGE(PG8_SA(0, 0), cA, voffA); PG8_STAGE(PG8_SA(0, 1), cA + hstep, voffA);
        if (wr == 1) PG8_BAR;
        PG8_WAIT_V(2); PG8_BAR;
        PG8_STAGE(PG8_SB(1, 0), cB + kstep, voffB); PG8_STAGE(PG8_SA(1, 0), cA + kstep, voffA); PG8_STAGE(PG8_SB(1, 1), cB + hstep + kstep, voffB);
        PG8_WAIT_V(6); PG8_BAR;
    } else {
        PG8_STAGE(PG8_SB(0, 0), cB, voffB); PG8_STAGE(PG8_SA(0, 0), cA, voffA); PG8_STAGE(PG8_SB(0, 1), cB + hstep, voffB); PG8_STAGE(PG8_SA(0, 1), cA + hstep, voffA);
        if (wr == 1) PG8_BAR;
        PG8_WAIT_V(4); PG8_BAR;
        PG8_STAGE(PG8_SB(1, 0), cB + kstep, voffB); PG8_STAGE(PG8_SA(1, 0), cA + kstep, voffA); PG8_STAGE(PG8_SB(1, 1), cB + hstep + kstep, voffB);
        PG8_WAIT_V(6); PG8_BAR;
    }
    for (;;) {
        const bool has_next = S.next(ui + 1, nxt);
        const char* nA = has_next ? (const char*)g.A + (size_t)nxt.pm * tstep : cA; const char* nB = has_next ? (const char*)g.Bt + (size_t)nxt.pn * tstep : cB;
        for (int t = 0; t < nt; t += 2) {
            const bool last = (t == nt - 2);
            const char* a1 = cA + (size_t)(t + 1) * kstep;
            const char* a2 = last ? nA : cA + (size_t)(t + 2) * kstep; const char* b2 = last ? nB : cB + (size_t)(t + 2) * kstep;
            const char* a3 = a2 + kstep; const char* b3 = b2 + kstep;
            if (last && has_next) S.a_ready(nxt);
            if constexpr (SP2) {
            PG8_LDB(B0, 0, 0); PG8_LDB(B1, 0, 1); PG8_SCHED; PG8_LDA(At, 0, 0); PG8_STAGE(PG8_SA(1, 1), a1 + hstep, voffA);
            PG8_WAIT_V(8); PG8_WAIT_L(0); PG8_BAR; PG8_MMA(0, 0, At, B0); PG8_MMA(0, 1, At, B1); PG8_BAR; PG8_SCHED;
            PG8_LDA(At, 0, 1); PG8_STAGE(PG8_SB(0, 0), b2, voffB); PG8_STAGE(PG8_SB(0, 1), b2 + hstep, voffB); PG8_STAGE(PG8_SA(0, 0), a2, voffA);
            PG8_WAIT_V(8); PG8_WAIT_L(0); PG8_BAR; PG8_MMA(1, 0, At, B0); PG8_MMA(1, 1, At, B1); PG8_BAR; PG8_SCHED;
            PG8_LDB(B0, 1, 0); PG8_LDB(B1, 1, 1); PG8_SCHED; PG8_LDA(At, 1, 0); PG8_STAGE(PG8_SA(0, 1), a2 + hstep, voffA);
            PG8_WAIT_V(8); PG8_WAIT_L(0); PG8_BAR; PG8_MMA(0, 0, At, B0); PG8_MMA(0, 1, At, B1); PG8_BAR; PG8_SCHED;
            PG8_LDA(At, 1, 1); PG8_STAGE(PG8_SB(1, 0), b3, voffB); PG8_STAGE(PG8_SB(1, 1), b3 + hstep, voffB); PG8_STAGE(PG8_SA(1, 0), a3, voffA);
            PG8_WAIT_V(8); PG8_WAIT_L(0); PG8_BAR; PG8_MMA(1, 0, At, B0); PG8_MMA(1, 1, At, B1); PG8_BAR; PG8_SCHED;
            } else {
            PG8_LDB(B0, 0, 0); PG8_SCHED; PG8_LDA(At, 0, 0); PG8_STAGE(PG8_SA(1, 1), a1 + hstep, voffA);
            PG8_WAIT_L(8); PG8_BAR; PG8_WAIT_L(0); PG8_MMA(0, 0, At, B0); PG8_BAR; PG8_SCHED;
            PG8_LDB(B1, 0, 1); PG8_STAGE(PG8_SB(0, 0), b2, voffB);
            PG8_BAR; PG8_WAIT_L(0); PG8_MMA(0, 1, At, B1); PG8_BAR;
            PG8_LDA(At, 0, 1); PG8_STAGE(PG8_SA(0, 0), a2, voffA);
            PG8_BAR; PG8_WAIT_L(0); PG8_MMA(1, 0, At, B0); PG8_BAR; PG8_SCHED;
            PG8_STAGE(PG8_SB(0, 1), b2 + hstep, voffB);
            PG8_WAIT_V(6); PG8_BAR; PG8_MMA(1, 1, At, B1); PG8_BAR;
            PG8_LDB(B0, 1, 0); PG8_SCHED; PG8_LDA(At, 1, 0); PG8_STAGE(PG8_SA(0, 1), a2 + hstep, voffA);
            PG8_WAIT_L(8); PG8_BAR; PG8_WAIT_L(0); PG8_MMA(0, 0, At, B0); PG8_BAR; PG8_SCHED;
            PG8_LDB(B1, 1, 1); PG8_STAGE(PG8_SB(1, 0), b3, voffB);
            PG8_BAR; PG8_WAIT_L(0); PG8_MMA(0, 1, At, B1); PG8_BAR;
            PG8_LDA(At, 1, 1); PG8_STAGE(PG8_SA(1, 0), a3, voffA);
            PG8_BAR; PG8_WAIT_L(0); PG8_MMA(1, 0, At, B0); PG8_BAR; PG8_SCHED;
            PG8_STAGE(PG8_SB(1, 1), b3 + hstep, voffB);
            PG8_WAIT_V(6); PG8_BAR; PG8_MMA(1, 1, At, B1); PG8_BAR;
            }
        }
        if constexpr (ALIGN_EPI) { if (wr == 0) PG8_BAR; }
        if constexpr (!Epi::AFTER_DRAIN) { E(acc, cur, wr, wc, fr, fq); S.done(cur); }
        if (!has_next) break;
#pragma unroll
        for (int a = 0; a < 2; ++a)
#pragma unroll
            for (int b = 0; b < 2; ++b)
#pragma unroll
                for (int m = 0; m < 4; ++m)
#pragma unroll
                    for (int n = 0; n < 2; ++n) acc[a][b][m][n] = (f32x4){0.f, 0.f, 0.f, 0.f};
        cur = nxt; cA = nA; cB = nB; ++ui;
        if constexpr (ALIGN_EPI) { if (wr == 1) PG8_BAR; }
    }
    PG8_WAIT_V(0);
    if constexpr (!ALIGN_EPI) { if (wr == 0) PG8_BAR; }
    PG8_BAR;
    if constexpr (Epi::AFTER_DRAIN) { E.fused(acc, cur, wr, wc, fr, fq, lds, wid, lane); S.done(cur); }
#undef PG8_SA
#undef PG8_SB
#undef PG8_STAGE
#undef PG8_LDA
#undef PG8_LDB
#undef PG8_MMA
#undef PG8_WAIT_V
#undef PG8_WAIT_L
#undef PG8_BAR
#undef PG8_SCHED
}
}

constexpr int NB = 4, SEQ = 2048, DM = 2048, MTOK = NB * SEQ;
constexpr int A_IN = 4176, A_INP = 4352;
constexpr int C_Q = 0, C_K = 2048, C_V = 2560, C_QI = 3072, C_KI = 4096, C_WI = 4160;
constexpr int DFF = 5632, DFFE = 7168, NEXP = 8;
constexpr int NMOD = 28672;
constexpr float EPS = 1e-6f, LOG2E = 1.4426950408889634f;
constexpr int MROWS = 2 * MTOK + NEXP * 256;

constexpr size_t MiB = 1u << 20;
constexpr size_t WS_CTL = 0, CTL_ZERO_BYTES = 1 * MiB;
constexpr size_t WS_MOD = 1 * MiB, WS_BT = WS_MOD + 512 * 1024, WS_ROUTE = WS_MOD + 768 * 1024;
constexpr size_t WS_WIN = 2 * MiB, WS_WAOUT = 19 * MiB, WS_WF13 = 27 * MiB, WS_WF2 = 71 * MiB, WS_WKVQ = 93 * MiB, WS_WBOUT = 129 * MiB, WS_WM13 = 133 * MiB, WS_WM2 = 581 * MiB;
constexpr size_t WS_HA = 805 * MiB, WS_AR = 869 * MiB;
constexpr size_t WS_P0 = WS_AR, WS_QN = WS_AR + 68 * MiB, WS_KN = WS_AR + 100 * MiB, WS_VT = WS_AR + 108 * MiB, WS_MASK = WS_AR + 116 * MiB, WS_O = WS_AR + 118 * MiB, WS_U = WS_AR + 150 * MiB;
constexpr size_t WS_KV = WS_AR, WS_Q1 = WS_AR + 96 * MiB, WS_K1N = WS_AR + 144 * MiB, WS_Q1N = WS_AR + 192 * MiB, WS_VT1 = WS_AR + 240 * MiB, WS_OG = WS_AR + 288 * MiB, WS_LSE = WS_AR + 336 * MiB, WS_O1 = WS_AR + 338 * MiB;
constexpr size_t WS_AS = WS_AR, WS_UM = WS_AR + 72 * MiB, WS_Y = WS_AR + 324 * MiB, WS_RG = WS_AR + 468 * MiB, WS_TR = WS_AR + 469 * MiB;
constexpr size_t WS_END = WS_AR + 470 * MiB;
static_assert((size_t)A_INP * DM * 2 <= 17 * MiB && (size_t)MROWS * DFFE * 2 <= 252 * MiB && (size_t)MROWS * DM * 4 <= 144 * MiB && (size_t)MROWS * DM * 2 <= 72 * MiB, "ws map");
constexpr int CW_TMO = 0, CW_CODE = 1, CW_BAR = 4096, CW_CNT = 8192;

constexpr int RING_OFF = 0, RING_BYTES = 131072;
constexpr int LDSCTL_OFF = RING_BYTES, MISC_OFF = LDSCTL_OFF + 320;
constexpr int LDS_BYTES = 147456;
constexpr int NWAVES = 8;

#define GAS __attribute__((address_space(1)))
#define LAS __attribute__((address_space(3)))
typedef unsigned short bf16;
typedef unsigned v4u __attribute__((ext_vector_type(4)));
typedef unsigned v2u __attribute__((ext_vector_type(2)));
typedef float f32x4 __attribute__((ext_vector_type(4)));
typedef float f32x2 __attribute__((ext_vector_type(2)));
typedef float f32x16 __attribute__((ext_vector_type(16)));
typedef int i32x4 __attribute__((ext_vector_type(4)));
typedef short bf16x8 __attribute__((ext_vector_type(8)));
typedef GAS unsigned gu32;
#define RLX_AGENT __ATOMIC_RELAXED, __HIP_MEMORY_SCOPE_AGENT
#define MFMA32(a, b, c) __builtin_amdgcn_mfma_f32_32x32x16_bf16((a), (b), (c), 0, 0, 0)
__device__ __forceinline__ unsigned f2bf(float f) { unsigned u = __builtin_bit_cast(unsigned, f); return (u + 0x7fffu + ((u >> 16) & 1u)) >> 16; }
__device__ __forceinline__ unsigned pk2(float lo, float hi) { return f2bf(lo) | (f2bf(hi) << 16); }
__device__ __forceinline__ float bflo(unsigned w) { return __builtin_bit_cast(float, w << 16); }
__device__ __forceinline__ float bfhi(unsigned w) { return __builtin_bit_cast(float, w & 0xffff0000u); }
typedef float f32x2_t __attribute__((ext_vector_type(2)));
typedef __bf16 bf16x2_t __attribute__((ext_vector_type(2)));
__device__ __forceinline__ unsigned cvtpk(float lo, float hi) { f32x2_t v = {lo, hi}; bf16x2_t b = __builtin_convertvector(v, bf16x2_t); return __builtin_bit_cast(unsigned, b); }
__device__ __forceinline__ bf16x8 pack8(float a0, float a1, float a2, float a3, float a4, float a5, float a6, float a7) {
    v4u p; p.x = cvtpk(a0, a1); p.y = cvtpk(a2, a3); p.z = cvtpk(a4, a5); p.w = cvtpk(a6, a7); return __builtin_bit_cast(bf16x8, p); }
#define XB_TMO      128
#define XB_XCNT(j)  (256  + 64 * (j))
#define XB_XSUB(j)  (1280 + 64 * (j))
#define XB_XGEN(j)  (2304 + 64 * (j))
#define XB_TOP      3328
#define XB_TOPGEN   3392
#define XCD_BAR_WORDS 3456
#define XB_SPIN_CAP (1u << 18)

__device__ __forceinline__ unsigned xb_ld(unsigned* p)              { return __hip_atomic_load(p, __ATOMIC_RELAXED, __HIP_MEMORY_SCOPE_AGENT); }
__device__ __forceinline__ unsigned xb_add(unsigned* p, unsigned v) { return __hip_atomic_fetch_add(p, v, __ATOMIC_RELAXED, __HIP_MEMORY_SCOPE_AGENT); }
__device__ __forceinline__ unsigned xb_xcc_id() { return (unsigned)__builtin_amdgcn_s_getreg((3 << 11) | 20) & 0xFu; }
#define XB_SPIN(cond, bar) do { unsigned _sp = 0; while (cond) { __builtin_amdgcn_s_sleep(1); \
    if ((++_sp & 255u) == 0u) { if (xb_ld(&(bar)[XB_TMO])) break; if (_sp > XB_SPIN_CAP) { atomicAdd(&(bar)[XB_TMO], 1u); break; } } } } while (0)

struct XcdBarrier {
    unsigned* bar; unsigned x;
    volatile LAS unsigned* st;
};

__device__ __forceinline__ XcdBarrier xcd_barrier_post(unsigned* bar, volatile LAS unsigned* st) {
    XcdBarrier b; b.bar = bar; b.x = xb_xcc_id(); b.st = st;
    if (threadIdx.x == 0) (void)xb_add(&bar[XB_XCNT(b.x)], 1u);
    return b;
}
__device__ __forceinline__ void xcd_barrier_complete(unsigned* bar, unsigned x, unsigned& nloc, unsigned& nx) {
    const unsigned G = gridDim.x * gridDim.y * gridDim.z;
    unsigned sum, cnt, mine, sp = 0u;
    for (;;) {
        sum = 0u; cnt = 0u; mine = 0u;
#pragma unroll
        for (unsigned j = 0; j < 16; ++j) { const unsigned c = xb_ld(&bar[XB_XCNT(j)]); sum += c; cnt += (c > 0u) ? 1u : 0u; mine = (j == x) ? c : mine; }
        if (sum == G) break;
        __builtin_amdgcn_s_sleep(1);
        if ((++sp & 255u) == 0u) { if (xb_ld(&bar[XB_TMO])) break; if (sp > XB_SPIN_CAP) { atomicAdd(&bar[XB_TMO], 1u); break; } }
    }
    nloc = mine > 0u ? mine : 1u; nx = cnt > 0u ? cnt : 1u;
}

__device__ __forceinline__ void xcd_barrier(const XcdBarrier& b) {
    asm volatile("s_waitcnt vmcnt(0)" ::: "memory");
    __syncthreads();
    if (threadIdx.x == 0) {
        unsigned* bar = b.bar;
        __builtin_amdgcn_s_waitcnt(0);
        unsigned nloc = b.st[0], nx = b.st[1];
        if (nloc == 0u) { xcd_barrier_complete(bar, b.x, nloc, nx); b.st[0] = nloc; b.st[1] = nx; }
        const unsigned old = xb_add(&bar[XB_XSUB(b.x)], 1u);
        const unsigned gen = old / nloc;
        if (old + 1u == (gen + 1u) * nloc) {
            __builtin_amdgcn_fence(__ATOMIC_RELEASE, "agent");
            asm volatile("s_waitcnt vmcnt(0)" ::: "memory");
            const unsigned og = xb_add(&bar[XB_TOP], 1u);
            const unsigned tg = og / nx;
            if (og + 1u == (tg + 1u) * nx) xb_add(&bar[XB_TOPGEN], 1u);
            else XB_SPIN(xb_ld(&bar[XB_TOPGEN]) == tg, bar);
            __builtin_amdgcn_fence(__ATOMIC_ACQUIRE, "agent");
            xb_add(&bar[XB_XGEN(b.x)], 1u);
            asm volatile("s_waitcnt vmcnt(0)" ::: "memory");
        } else {
            XB_SPIN(xb_ld(&bar[XB_XGEN(b.x)]) == gen, bar);
            __builtin_amdgcn_fence(__ATOMIC_ACQUIRE, "agent");
            asm volatile("s_waitcnt vmcnt(0)" ::: "memory");
        }
    }
    __syncthreads();
}

struct Args { const void* in[28]; float* out; unsigned char* ws; int ph_lo, ph_hi; };
struct Frame {
    LAS unsigned char* lds; volatile LAS unsigned* MISC; gu32* ctl; unsigned char* ws;
    int tid, lane, wave, G, bid;
};
#define LDS_WAIT() asm volatile("s_waitcnt lgkmcnt(0)" ::: "memory")
__device__ __forceinline__ float wave_sum(float v) {
#pragma unroll
    for (int o = 1; o < 64; o <<= 1) v += __shfl_xor(v, o);
    return v;
}

__device__ __forceinline__ int t5_bucket(int n) {
    if (n < 16) return n;
    const float v = logf((float)n / 16.0f) / 4.852030263919617f * 16.0f;
    const int l = 16 + (int)v; return l < 31 ? l : 31;
}
__device__ __forceinline__ void cvt_tile(const float* __restrict__ src, int N, int k0, int n0, int nvalid, bf16* __restrict__ dst, size_t drow0, int Kd, int lane) {
    const int cl = lane & 15, kg = lane >> 4;
    f32x4 v[16];
    const float* sp = src + (size_t)(k0 + 16 * kg) * N + n0 + 4 * cl;
    const bool ok = 4 * cl < nvalid;
#pragma unroll
    for (int i = 0; i < 16; ++i) v[i] = ok ? *(const f32x4*)(sp + (size_t)i * N) : (f32x4){0.f, 0.f, 0.f, 0.f};
    bf16* dp = dst + (drow0 + 4 * cl) * (size_t)Kd + k0 + 16 * kg;
#pragma unroll
    for (int e = 0; e < 4; ++e) {
        v4u a, b;
        a.x = pk2(v[0][e], v[1][e]); a.y = pk2(v[2][e], v[3][e]); a.z = pk2(v[4][e], v[5][e]); a.w = pk2(v[6][e], v[7][e]);
        b.x = pk2(v[8][e], v[9][e]); b.y = pk2(v[10][e], v[11][e]); b.z = pk2(v[12][e], v[13][e]); b.w = pk2(v[14][e], v[15][e]);
        *(v4u*)(dp + (size_t)e * Kd) = a; *(v4u*)(dp + (size_t)e * Kd + 8) = b;
    }
}
__device__ __forceinline__ void p0_prologue(Frame& F, const Args& A) {
    const float* c_in = (const float*)A.in[1];
    const float* rel_bias = (const float*)A.in[3];
    float* MOD = (float*)(F.ws + WS_MOD); float* BT = (float*)(F.ws + WS_BT);
    LAS float* cs = (LAS float*)F.lds; LAS float* red = (LAS float*)(F.lds + 32768);
    for (int i = F.tid; i < NB * DM; i += NWAVES * 64) { const float v = c_in[i]; cs[i] = v / (1.0f + __expf(-v)); }
    __syncthreads();
    for (int item = F.bid; item < NMOD / 128; item += F.G) {
        const int j0 = item * 128; const float* W; const float* bias; int N, jl;
        if (j0 < 12288) { W = (const float*)A.in[4]; N = 12288; jl = j0; bias = (const float*)A.in[5]; }
        else if (j0 < 24576) { W = (const float*)A.in[4] + (size_t)DM * 12288; N = 12288; jl = j0 - 12288; bias = (const float*)A.in[5] + 12288; }
        else { W = (const float*)A.in[12]; N = 4096; jl = j0 - 24576; bias = (const float*)A.in[13]; }
        const float* wp = W + (size_t)(256 * F.wave) * N + jl + 2 * F.lane;
        float a[4][2];
#pragma unroll
        for (int b = 0; b < 4; ++b) { a[b][0] = 0.f; a[b][1] = 0.f; }
        for (int k = 0; k < 256; k += 8) {
            f32x2 w[8];
#pragma unroll
            for (int i = 0; i < 8; ++i) w[i] = *(const f32x2*)(wp + (size_t)(k + i) * N);
#pragma unroll
            for (int i = 0; i < 8; ++i)
#pragma unroll
                for (int b = 0; b < 4; ++b) { const float cv = cs[b * DM + 256 * F.wave + k + i]; a[b][0] += cv * w[i].x; a[b][1] += cv * w[i].y; }
        }
#pragma unroll
        for (int b = 0; b < 4; ++b) { red[(F.wave * 4 + b) * 128 + 2 * F.lane] = a[b][0]; red[(F.wave * 4 + b) * 128 + 2 * F.lane + 1] = a[b][1]; }
        __syncthreads();
        { const int b = F.tid >> 7, col = F.tid & 127; float s = bias[jl + col];
#pragma unroll
          for (int w = 0; w < 8; ++w) s += red[(w * 4 + b) * 128 + col];
          MOD[(size_t)b * NMOD + j0 + col] = s; }
        __syncthreads();
    }
    for (int idx = F.bid * (NWAVES * 64) + F.tid; idx < 16 * 2048; idx += F.G * NWAVES * 64) { const int h = idx >> 11, n = idx & 2047; BT[idx] = rel_bias[t5_bucket(n) * 16 + h] * LOG2E; }
    const int gw = F.bid * NWAVES + F.wave, NGW = F.G * NWAVES;
    constexpr int T_IN = 32 * 68, T_AOUT = 32 * 32, T_F1 = 32 * 88, T_F2 = 88 * 32, T_KV = 32 * 96, T_BQ = 32 * 48, T_BOUT = 16 * 32, T_ME = 3584, T_M = 8 * T_ME;
    constexpr int NITEMS = T_IN + T_AOUT + 2 * T_F1 + T_F2 + T_KV + T_BQ + T_BOUT + 3 * T_M;
    for (int it = gw; it < NITEMS; it += NGW) {
        int r = it;
        if (r < T_IN) { const int kb = r / 68, nb = r % 68; cvt_tile((const float*)A.in[8], A_IN, 64 * kb, 64 * nb, A_IN - 64 * nb, (bf16*)(F.ws + WS_WIN), (size_t)64 * nb, DM, F.lane); continue; } r -= T_IN;
        if (r < T_AOUT) { const int kb = r / 32, nb = r % 32; cvt_tile((const float*)A.in[9], DM, 64 * kb, 64 * nb, 64, (bf16*)(F.ws + WS_WAOUT), (size_t)64 * nb, DM, F.lane); continue; } r -= T_AOUT;
        if (r < T_F1) { const int kb = r / 88, nb = r % 88, n0 = 64 * nb; cvt_tile((const float*)A.in[20], DFF, 64 * kb, n0, 64, (bf16*)(F.ws + WS_WF13), (size_t)((n0 >> 7) * 256 + (n0 & 127)), DM, F.lane); continue; } r -= T_F1;
        if (r < T_F1) { const int kb = r / 88, nb = r % 88, n0 = 64 * nb; cvt_tile((const float*)A.in[21], DFF, 64 * kb, n0, 64, (bf16*)(F.ws + WS_WF13), (size_t)((n0 >> 7) * 256 + 128 + (n0 & 127)), DM, F.lane); continue; } r -= T_F1;
        if (r < T_F2) { const int kb = r / 32, nb = r % 32; cvt_tile((const float*)A.in[22], DM, 64 * kb, 64 * nb, 64, (bf16*)(F.ws + WS_WF2), (size_t)64 * nb, DFF, F.lane); continue; } r -= T_F2;
        if (r < T_KV) { const int kb = r / 96, nb = r % 96; cvt_tile((const float*)A.in[15], 6144, 64 * kb, 64 * nb, 64, (bf16*)(F.ws + WS_WKVQ), (size_t)64 * nb, DM, F.lane); continue; } r -= T_KV;
        if (r < T_BQ) { const int kb = r / 48, nb = r % 48; cvt_tile((const float*)A.in[17], 3072, 64 * kb, 64 * nb, 64, (bf16*)(F.ws + WS_WKVQ), (size_t)(6144 + 64 * nb), DM, F.lane); continue; } r -= T_BQ;
        if (r < T_BOUT) { const int kb = r / 32, nb = r % 32; cvt_tile((const float*)A.in[18], DM, 64 * kb, 64 * nb, 64, (bf16*)(F.ws + WS_WBOUT), (size_t)64 * nb, 1024, F.lane); continue; } r -= T_BOUT;
        if (r < T_M) { const int e = r / T_ME, rr = r % T_ME, kb = rr / 112, nb = rr % 112, n0 = 64 * nb;
            cvt_tile((const float*)A.in[25] + (size_t)e * DM * DFFE, DFFE, 64 * kb, n0, 64, (bf16*)(F.ws + WS_WM13), (size_t)e * 14336 + (n0 >> 7) * 256 + (n0 & 127), DM, F.lane); continue; } r -= T_M;
        if (r < T_M) { const int e = r / T_ME, rr = r % T_ME, kb = rr / 112, nb = rr % 112, n0 = 64 * nb;
            cvt_tile((const float*)A.in[26] + (size_t)e * DM * DFFE, DFFE, 64 * kb, n0, 64, (bf16*)(F.ws + WS_WM13), (size_t)e * 14336 + (n0 >> 7) * 256 + 128 + (n0 & 127), DM, F.lane); continue; } r -= T_M;
        { const int e = r / T_ME, rr = r % T_ME, kb = rr / 32, nb = rr % 32;
            cvt_tile((const float*)A.in[27] + (size_t)e * DFFE * DM, DM, 64 * kb, 64 * nb, 64, (bf16*)(F.ws + WS_WM2), (size_t)e * 2048 + 64 * nb, DFFE, F.lane); }
    }
}

__device__ __forceinline__ float row_rstd(const f32x4 (&v)[8]) {
    float ss = 0.f;
#pragma unroll
    for (int j = 0; j < 8; ++j) ss += (v[j].x * v[j].x + v[j].y * v[j].y) + (v[j].z * v[j].z + v[j].w * v[j].w);
    return 1.0f / sqrtf(wave_sum(ss) * (1.0f / DM) + EPS);
}
__device__ __forceinline__ void modulate_store(const f32x4 (&v)[8], float rstd, const float* g, const float* sh, const float* sc, bf16* orow, int lane) {
#pragma unroll
    for (int j = 0; j < 8; ++j) { const int col = 4 * lane + 256 * j;
        const f32x4 gg = *(const f32x4*)(g + col), s1 = *(const f32x4*)(sc + col), s0 = *(const f32x4*)(sh + col);
        const f32x4 y = v[j] * rstd * gg * (s1 + 1.0f) + s0;
        v2u w; w.x = pk2(y.x, y.y); w.y = pk2(y.z, y.w); *(v2u*)(orow + col) = w; }
}
__device__ __forceinline__ void normmod_phase(Frame& F, const float* X, const float* g, const float* modsh, const float* modsc, bf16* out) {
    const int gw = F.bid * NWAVES + F.wave, NGW = F.G * NWAVES;
    for (int row = gw; row < MTOK; row += NGW) { const int b = row >> 11;
        f32x4 v[8]; const float* xr = X + (size_t)row * DM + 4 * F.lane;
#pragma unroll
        for (int j = 0; j < 8; ++j) v[j] = *(const f32x4*)(xr + 256 * j);
        const float rstd = row_rstd(v);
        modulate_store(v, rstd, g, modsh + (size_t)b * NMOD, modsc + (size_t)b * NMOD, out + (size_t)row * DM, F.lane); }
}

constexpr float NEG_S = -3.0e38f;
__device__ __forceinline__ void p3_qknorm(Frame& F, const Args& A) {
    const bf16* P0 = (const bf16*)(F.ws + WS_P0); bf16* QN = (bf16*)(F.ws + WS_QN); bf16* KN = (bf16*)(F.ws + WS_KN);
    const float* gq = (const float*)A.in[10]; const float* gk = (const float*)A.in[11];
    const int gw = F.bid * NWAVES + F.wave, NGW = F.G * NWAVES, li = F.lane & 15, g4 = F.lane >> 4;
    const float QS = 0.08838834764831845f * LOG2E;
    float gqv[8], gkv[8];
#pragma unroll
    for (int e = 0; e < 8; ++e) { gqv[e] = gq[8 * li + e] * QS; gkv[e] = gk[8 * li + e]; }
    for (int tok = gw; tok < MTOK; tok += NGW) {
        const bf16* pr = P0 + (size_t)tok * A_INP;
#pragma unroll
        for (int i = 0; i < 5; ++i) { const int head = 4 * i + g4;
            const v4u w = *(const v4u*)(pr + head * 128 + 8 * li);
            float x[8] = {bflo(w.x), bfhi(w.x), bflo(w.y), bfhi(w.y), bflo(w.z), bfhi(w.z), bflo(w.w), bfhi(w.w)};
            float ss = 0.f;
#pragma unroll
            for (int e = 0; e < 8; ++e) ss += x[e] * x[e];
            ss += __shfl_xor(ss, 8); ss += __shfl_xor(ss, 4); ss += __shfl_xor(ss, 2); ss += __shfl_xor(ss, 1);
            const float rstd = 1.0f / sqrtf(ss * (1.0f / 128.0f) + EPS);
            v4u o;
            if (i < 4) { o.x = pk2(x[0] * rstd * gqv[0], x[1] * rstd * gqv[1]); o.y = pk2(x[2] * rstd * gqv[2], x[3] * rstd * gqv[3]); o.z = pk2(x[4] * rstd * gqv[4], x[5] * rstd * gqv[5]); o.w = pk2(x[6] * rstd * gqv[6], x[7] * rstd * gqv[7]);
                *(v4u*)(QN + (size_t)tok * DM + head * 128 + 8 * li) = o; }
            else { o.x = pk2(x[0] * rstd * gkv[0], x[1] * rstd * gkv[1]); o.y = pk2(x[2] * rstd * gkv[2], x[3] * rstd * gkv[3]); o.z = pk2(x[4] * rstd * gkv[4], x[5] * rstd * gkv[5]); o.w = pk2(x[6] * rstd * gkv[6], x[7] * rstd * gkv[7]);
                *(v4u*)(KN + (size_t)tok * 512 + (head - 16) * 128 + 8 * li) = o; }
        }
    }
}
__device__ __forceinline__ void p3_vtrans(Frame& F) {
    const bf16* P0 = (const bf16*)(F.ws + WS_P0); bf16* VT = (bf16*)(F.ws + WS_VT);
    LAS unsigned* tile = (LAS unsigned*)F.lds;
    for (int item = F.bid; item < MTOK / 64; item += F.G) { const int tok0 = item * 64, b = tok0 >> 11, t0 = tok0 & 2047;
        __syncthreads();
#pragma unroll
        for (int p = 0; p < 8; ++p) { const int row = p * 8 + (F.tid >> 6), cw = (F.tid & 63) * 4;
            const v4u w = *(const v4u*)(P0 + (size_t)(tok0 + row) * A_INP + C_V + 2 * cw);
            tile[row * 257 + cw] = w.x; tile[row * 257 + cw + 1] = w.y; tile[row * 257 + cw + 2] = w.z; tile[row * 257 + cw + 3] = w.w; }
        __syncthreads();
#pragma unroll
        for (int p = 0; p < 8; ++p) { const int task = p * 512 + F.tid, tg = task & 7, col = task >> 3;
            const LAS unsigned short* tp = (const LAS unsigned short*)tile + col;
            unsigned short h[8];
#pragma unroll
            for (int i = 0; i < 8; ++i) h[i] = tp[(size_t)(tg * 8 + i) * 514];
            v4u o; o.x = h[0] | ((unsigned)h[1] << 16); o.y = h[2] | ((unsigned)h[3] << 16); o.z = h[4] | ((unsigned)h[5] << 16); o.w = h[6] | ((unsigned)h[7] << 16);
            *(v4u*)(VT + ((size_t)(b * 512 + col)) * SEQ + t0 + tg * 8) = o; }
    }
    __syncthreads();
}
__device__ __forceinline__ void p3_indexer_pair(Frame& F, int pair) {
    const bf16* P0 = (const bf16*)(F.ws + WS_P0); unsigned* MASK = (unsigned*)(F.ws + WS_MASK);
    const int b = pair >> 10, t0 = (pair & 1023) * 2, lane = F.lane, c = lane & 31, hh = lane >> 5;
    const bf16* Pb = P0 + (size_t)b * SEQ * A_INP;
    const int qsel = (c >> 2) & 1, ahead = (c & 3) + 4 * (c >> 3);
    const bf16* ap = Pb + (size_t)(t0 + qsel) * A_INP + C_QI + ahead * 64 + 8 * hh;
    bf16x8 af[4];
#pragma unroll
    for (int ks = 0; ks < 4; ++ks) af[ks] = *(const bf16x8*)(ap + 16 * ks);
    const bf16* wp = Pb + (size_t)(t0 + hh) * A_INP + C_WI;
    const v4u w0 = *(const v4u*)wp, w1 = *(const v4u*)(wp + 8);
    const float WS_ = 0.25f * 0.125f;
    const float wv[16] = {bflo(w0.x) * WS_, bfhi(w0.x) * WS_, bflo(w0.y) * WS_, bfhi(w0.y) * WS_, bflo(w0.z) * WS_, bfhi(w0.z) * WS_, bflo(w0.w) * WS_, bfhi(w0.w) * WS_,
                          bflo(w1.x) * WS_, bfhi(w1.x) * WS_, bflo(w1.y) * WS_, bfhi(w1.y) * WS_, bflo(w1.z) * WS_, bfhi(w1.z) * WS_, bflo(w1.w) * WS_, bfhi(w1.w) * WS_};
    const int tq = t0 + hh, ktmax = (t0 + 1) >> 5;
    LAS float* scL = (LAS float*)(F.lds + F.wave * 16384) + lane;
    for (int kg = 0; 4 * kg <= ktmax; ++kg) {
        bf16x8 bfr[4][4];
        const bf16* bp = Pb + (size_t)(128 * kg + c) * A_INP + C_KI + 8 * hh;
#pragma unroll
        for (int u = 0; u < 4; ++u)
#pragma unroll
            for (int ks = 0; ks < 4; ++ks) bfr[u][ks] = *(const bf16x8*)(bp + (size_t)(32 * u) * A_INP + 16 * ks);
#pragma unroll
        for (int u = 0; u < 4; ++u) { f32x16 d;
#pragma unroll
            for (int t = 0; t < 16; ++t) d[t] = 0.f;
#pragma unroll
            for (int ks = 0; ks < 4; ++ks) d = MFMA32(af[ks], bfr[u][ks], d);
            float s = 0.f;
#pragma unroll
            for (int t = 0; t < 16; ++t) s += fmaxf(d[t], 0.f) * wv[t];
            scL[(4 * kg + u) * 64] = (32 * (4 * kg + u) + c <= tq) ? s : NEG_S; }
    }
    LDS_WAIT();
    float sc[64];
#pragma unroll
    for (int k = 0; k < 64; ++k) { const float v = scL[k * 64]; sc[k] = (k <= ktmax) ? v : NEG_S; }
    LDS_WAIT();
    float mx = NEG_S, mn = 3.0e38f;
#pragma unroll
    for (int k = 0; k < 64; ++k) { mx = fmaxf(mx, sc[k]); mn = (sc[k] > -1.0e38f) ? fminf(mn, sc[k]) : mn; }
#pragma unroll
    for (int o = 16; o >= 1; o >>= 1) { mx = fmaxf(mx, __shfl_xor(mx, o)); mn = fminf(mn, __shfl_xor(mn, o)); }
    bool done = (tq + 1 <= 256); float lo = mn, hi = mx, thr = done ? -1.0e38f : mn;
    for (int it = 0; it < 48; ++it) {
        if (__all(done)) break;
        const float mid = 0.5f * (lo + hi);
        int cnt = 0;
#pragma unroll
        for (int k = 0; k < 64; ++k) cnt += (sc[k] >= mid) ? 1 : 0;
#pragma unroll
        for (int o = 16; o >= 1; o >>= 1) cnt += __shfl_xor(cnt, o);
        if (!done) {
            if (!(mid > lo) || !(mid < hi)) { done = true; thr = lo; }
            else if (cnt >= 256) { lo = mid; thr = mid; done = (cnt == 256); }
            else hi = mid;
        }
    }
    unsigned wA = 0u, wB = 0u;
#pragma unroll
    for (int k = 0; k < 64; ++k) { const unsigned long long bal = __ballot(sc[k] >= thr); if (lane == k) { wA = (unsigned)bal; wB = (unsigned)(bal >> 32); } }
    MASK[((size_t)b * SEQ + t0) * 64 + lane] = wA; MASK[((size_t)b * SEQ + t0 + 1) * 64 + lane] = wB;
}

__device__ __forceinline__ int kperm(int r) { return (r & ~12) | ((r & 4) << 1) | ((r & 8) >> 1); }
__device__ __forceinline__ void p4_attn_item(Frame& F, const Args& A, int item) {
    const bf16* QN = (const bf16*)(F.ws + WS_QN); const bf16* KN = (const bf16*)(F.ws + WS_KN); const bf16* VT = (const bf16*)(F.ws + WS_VT);
    const unsigned* MASK = (const unsigned*)(F.ws + WS_MASK); const float* BT = (const float*)(F.ws + WS_BT); bf16* OB = (bf16*)(F.ws + WS_O);
    const int* pos = (const int*)A.in[2];
    const int qt = item >> 4, bk = item & 15, b = bk >> 2, kvh = bk & 3;
    LAS float* tab = (LAS float*)F.lds; LAS int* posL = (LAS int*)(F.lds + 32768);
    __syncthreads();
    for (int i = F.tid; i < 4 * 2048; i += NWAVES * 64) tab[i] = BT[kvh * 4 * 2048 + i];
    for (int i = F.tid; i < SEQ; i += NWAVES * 64) posL[i] = pos[b * SEQ + i];
    __syncthreads();
    const int w = F.wave, hd = w & 3, head = kvh * 4 + hd, qw0 = qt * 64 + 32 * (w >> 2), lane = F.lane, c = lane & 31, hh = lane >> 5;
    const size_t tokq = (size_t)b * SEQ + qw0 + c;
    const bf16* qp = QN + tokq * DM + head * 128 + 8 * hh;
    bf16x8 qf[8];
#pragma unroll
    for (int ks = 0; ks < 8; ++ks) qf[ks] = *(const bf16x8*)(qp + 16 * ks);
    const int pq = posL[qw0 + c];
    const unsigned* mrow = MASK + tokq * 64;
    const LAS float* tb = tab + hd * 2048;
    f32x16 O[4];
#pragma unroll
    for (int db = 0; db < 4; ++db)
#pragma unroll
        for (int t = 0; t < 16; ++t) O[db][t] = 0.f;
    float m = -1.0e30f, l = 0.f;
    const int ktmax = (qw0 + 31) >> 5;
    const bf16* kbase = KN + ((size_t)b * SEQ + kperm(c)) * 512 + kvh * 128 + 8 * hh;
    const bf16* vbase = VT + ((size_t)(b * 4 + kvh) * 128 + c) * SEQ + 8 * hh;
    for (int kt = 0; kt <= ktmax; ++kt) {
        const int key0 = kt * 32;
        const unsigned mw = mrow[kt] >> (8 * hh);
        bf16x8 kf[8];
#pragma unroll
        for (int ks = 0; ks < 8; ++ks) kf[ks] = *(const bf16x8*)(kbase + (size_t)key0 * 512 + 16 * ks);
        f32x16 S;
#pragma unroll
        for (int t = 0; t < 16; ++t) S[t] = 0.f;
#pragma unroll
        for (int ks = 0; ks < 8; ++ks) S = MFMA32(kf[ks], qf[ks], S);
        const i32x4 p0 = *(const LAS i32x4*)(posL + key0 + 8 * hh), p1 = *(const LAS i32x4*)(posL + key0 + 8 * hh + 4), p2 = *(const LAS i32x4*)(posL + key0 + 16 + 8 * hh), p3 = *(const LAS i32x4*)(posL + key0 + 16 + 8 * hh + 4);
        const int pk[16] = {p0.x, p0.y, p0.z, p0.w, p1.x, p1.y, p1.z, p1.w, p2.x, p2.y, p2.z, p2.w, p3.x, p3.y, p3.z, p3.w};
        float s[16]; float mx = -1.0e30f;
#pragma unroll
        for (int t = 0; t < 16; ++t) { const int bit = (t & 7) + 16 * (t >> 3);
            int idx = pq - pk[t]; idx = idx < 0 ? 0 : (idx > 2047 ? 2047 : idx);
            const float v = S[t] + tb[idx];
            s[t] = ((mw >> bit) & 1u) ? v : -1.0e30f; mx = fmaxf(mx, s[t]); }
        mx = fmaxf(mx, __shfl_xor(mx, 32));
        const float mnew = fmaxf(m, mx), alpha = __builtin_amdgcn_exp2f(m - mnew);
        float p[16]; float ls = 0.f;
#pragma unroll
        for (int t = 0; t < 16; ++t) { p[t] = (s[t] > -1.0e29f) ? __builtin_amdgcn_exp2f(s[t] - mnew) : 0.f; ls += p[t]; }
        l = l * alpha + ls; m = mnew;
#pragma unroll
        for (int db = 0; db < 4; ++db)
#pragma unroll
            for (int t = 0; t < 16; ++t) O[db][t] *= alpha;
        const bf16x8 pf0 = pack8(p[0], p[1], p[2], p[3], p[4], p[5], p[6], p[7]), pf1 = pack8(p[8], p[9], p[10], p[11], p[12], p[13], p[14], p[15]);
#pragma unroll
        for (int db = 0; db < 4; ++db) {
            const bf16x8 v0 = *(const bf16x8*)(vbase + (size_t)(32 * db) * SEQ + key0), v1 = *(const bf16x8*)(vbase + (size_t)(32 * db) * SEQ + key0 + 16);
            O[db] = MFMA32(v0, pf0, O[db]); O[db] = MFMA32(v1, pf1, O[db]); }
    }
    l += __shfl_xor(l, 32);
    const float inv = 1.0f / l;
    bf16* op = OB + tokq * DM + head * 128 + 4 * hh;
#pragma unroll
    for (int db = 0; db < 4; ++db)
#pragma unroll
        for (int g = 0; g < 4; ++g) { v2u w2; w2.x = pk2(O[db][4 * g] * inv, O[db][4 * g + 1] * inv); w2.y = pk2(O[db][4 * g + 2] * inv, O[db][4 * g + 3] * inv); *(v2u*)(op + 32 * db + 8 * g) = w2; }
}

__device__ __forceinline__ void p11_qknorm(Frame& F, const Args& A) {
    const bf16* KV = (const bf16*)(F.ws + WS_KV); const bf16* Q1 = (const bf16*)(F.ws + WS_Q1); bf16* K1N = (bf16*)(F.ws + WS_K1N); bf16* Q1N = (bf16*)(F.ws + WS_Q1N);
    const float* gk = (const float*)A.in[16]; const float* gq = (const float*)A.in[19];
    const int gw = F.bid * NWAVES + F.wave, NGW = F.G * NWAVES, li = F.lane & 7, g8 = F.lane >> 3;
    const float QS = 0.125f * LOG2E;
    float gqv[8], gkv[8];
#pragma unroll
    for (int e = 0; e < 8; ++e) { gqv[e] = gq[8 * li + e] * QS; gkv[e] = gk[8 * li + e]; }
    for (int tok = gw; tok < MTOK; tok += NGW) {
#pragma unroll
        for (int i = 0; i < 12; ++i) { const int head = 8 * (i % 6) + g8; const bool isq = i < 6;
            const bf16* src = isq ? Q1 + (size_t)tok * 3072 : KV + (size_t)tok * 6144;
            const v4u w = *(const v4u*)(src + head * 64 + 8 * li);
            float x[8] = {bflo(w.x), bfhi(w.x), bflo(w.y), bfhi(w.y), bflo(w.z), bfhi(w.z), bflo(w.w), bfhi(w.w)};
            float ss = 0.f;
#pragma unroll
            for (int e = 0; e < 8; ++e) ss += x[e] * x[e];
            ss += __shfl_xor(ss, 4); ss += __shfl_xor(ss, 2); ss += __shfl_xor(ss, 1);
            const float rstd = 1.0f / sqrtf(ss * (1.0f / 64.0f) + EPS);
            v4u o;
            if (isq) { o.x = pk2(x[0] * rstd * gqv[0], x[1] * rstd * gqv[1]); o.y = pk2(x[2] * rstd * gqv[2], x[3] * rstd * gqv[3]); o.z = pk2(x[4] * rstd * gqv[4], x[5] * rstd * gqv[5]); o.w = pk2(x[6] * rstd * gqv[6], x[7] * rstd * gqv[7]);
                *(v4u*)(Q1N + (size_t)tok * 3072 + head * 64 + 8 * li) = o; }
            else { o.x = pk2(x[0] * rstd * gkv[0], x[1] * rstd * gkv[1]); o.y = pk2(x[2] * rstd * gkv[2], x[3] * rstd * gkv[3]); o.z = pk2(x[4] * rstd * gkv[4], x[5] * rstd * gkv[5]); o.w = pk2(x[6] * rstd * gkv[6], x[7] * rstd * gkv[7]);
                *(v4u*)(K1N + (size_t)tok * 3072 + head * 64 + 8 * li) = o; }
        }
    }
}
__device__ __forceinline__ void p11_vtrans(Frame& F) {
    const bf16* KV = (const bf16*)(F.ws + WS_KV); bf16* VT1 = (bf16*)(F.ws + WS_VT1);
    LAS unsigned* tile = (LAS unsigned*)F.lds;
    for (int item = F.bid; item < NB * 3 * 16 * 4; item += F.G) {
        const int cg = item & 3, ch = (item >> 2) & 15, bg = item >> 6, g = bg % 3, b = bg / 3, t0 = ch * 128, lr = 2 * g, r = 1 << lr, nsub = SEQ >> lr;
        __syncthreads();
#pragma unroll
        for (int p = 0; p < 8; ++p) { const int row = p * 16 + (F.tid >> 5), cw = (F.tid & 31) * 4;
            const v4u w = *(const v4u*)(KV + (size_t)(b * SEQ + t0 + row) * 6144 + 3072 + g * 1024 + cg * 256 + 2 * cw);
            tile[row * 129 + cw] = w.x; tile[row * 129 + cw + 1] = w.y; tile[row * 129 + cw + 2] = w.z; tile[row * 129 + cw + 3] = w.w; }
        __syncthreads();
#pragma unroll
        for (int p = 0; p < 8; ++p) { const int task = p * 512 + F.tid, q = task & 15, col = task >> 4;
            const int rho = q & (r - 1), run = q >> lr;
            const LAS unsigned short* tp = (const LAS unsigned short*)tile + col;
            unsigned short h[8];
#pragma unroll
            for (int i = 0; i < 8; ++i) h[i] = tp[(size_t)(((8 * run + i) << lr) + rho) * 258];
            v4u o; o.x = h[0] | ((unsigned)h[1] << 16); o.y = h[2] | ((unsigned)h[3] << 16); o.z = h[4] | ((unsigned)h[5] << 16); o.w = h[6] | ((unsigned)h[7] << 16);
            *(v4u*)(VT1 + ((size_t)((b * 3 + g) * 1024 + cg * 256 + col)) * SEQ + rho * nsub + (t0 >> lr) + 8 * run) = o; }
    }
    __syncthreads();
}
__device__ __forceinline__ void p12_attn_item(Frame& F, const Args& A, int item) {
    const bf16* Q1N = (const bf16*)(F.ws + WS_Q1N); const bf16* K1N = (const bf16*)(F.ws + WS_K1N); const bf16* VT1 = (const bf16*)(F.ws + WS_VT1);
    const float* BT = (const float*)(F.ws + WS_BT); bf16* OG = (bf16*)(F.ws + WS_OG); float* LSE = (float*)(F.ws + WS_LSE);
    const int* pos = (const int*)A.in[2];
    const int jb = item & 7, head = (item >> 3) & 15, bg = item >> 7, g = bg % 3, b = bg / 3, lr = 2 * g, nsub = SEQ >> lr, tps = nsub >> 5;
    LAS float* tab = (LAS float*)F.lds; LAS int* posL = (LAS int*)(F.lds + 8192);
    __syncthreads();
    for (int i = F.tid; i < 2048; i += NWAVES * 64) { tab[i] = BT[head * 2048 + i]; posL[i] = pos[b * SEQ + i]; }
    __syncthreads();
    const int j = 8 * jb + F.wave, rho = j / tps, n0 = 32 * (j % tps), lane = F.lane, c = lane & 31, hh = lane >> 5;
    const int tq = ((n0 + c) << lr) + rho;
    const size_t tokq = (size_t)b * SEQ + tq;
    const bf16* qp = Q1N + tokq * 3072 + g * 1024 + head * 64 + 8 * hh;
    bf16x8 qf[4];
#pragma unroll
    for (int ks = 0; ks < 4; ++ks) qf[ks] = *(const bf16x8*)(qp + 16 * ks);
    const int pq = posL[tq];
    f32x16 O[2];
#pragma unroll
    for (int db = 0; db < 2; ++db)
#pragma unroll
        for (int t = 0; t < 16; ++t) O[db][t] = 0.f;
    float m = -1.0e30f, l = 0.f;
    const bf16* kcol = K1N + (size_t)b * SEQ * 3072 + g * 1024 + head * 64 + 8 * hh;
    const bf16* vbase = VT1 + ((size_t)((b * 3 + g) * 1024 + head * 64 + c)) * SEQ + rho * nsub + 8 * hh;
    const int pc = kperm(c);
    for (int kb = n0 - 128; kb <= n0; kb += 32) {
        if (kb < 0) continue;
        const bf16* kp = kcol + (size_t)(((kb + pc) << lr) + rho) * 3072;
        bf16x8 kf[4];
#pragma unroll
        for (int ks = 0; ks < 4; ++ks) kf[ks] = *(const bf16x8*)(kp + 16 * ks);
        f32x16 S;
#pragma unroll
        for (int t = 0; t < 16; ++t) S[t] = 0.f;
#pragma unroll
        for (int ks = 0; ks < 4; ++ks) S = MFMA32(kf[ks], qf[ks], S);
        float s[16]; float mx = -1.0e30f;
        const int nq = n0 + c;
#pragma unroll
        for (int t = 0; t < 16; ++t) { const int nk = kb + (t & 7) + 8 * hh + 16 * (t >> 3);
            int idx = pq - posL[(nk << lr) + rho]; idx = idx < 0 ? 0 : (idx > 2047 ? 2047 : idx);
            const float v = S[t] + tab[idx];
            s[t] = (nk <= nq && nk >= nq - 128) ? v : -1.0e30f; mx = fmaxf(mx, s[t]); }
        mx = fmaxf(mx, __shfl_xor(mx, 32));
        const float mnew = fmaxf(m, mx), alpha = __builtin_amdgcn_exp2f(m - mnew);
        float p[16]; float ls = 0.f;
#pragma unroll
        for (int t = 0; t < 16; ++t) { p[t] = (s[t] > -1.0e29f) ? __builtin_amdgcn_exp2f(s[t] - mnew) : 0.f; ls += p[t]; }
        l = l * alpha + ls; m = mnew;
#pragma unroll
        for (int db = 0; db < 2; ++db)
#pragma unroll
            for (int t = 0; t < 16; ++t) O[db][t] *= alpha;
        const bf16x8 pf0 = pack8(p[0], p[1], p[2], p[3], p[4], p[5], p[6], p[7]), pf1 = pack8(p[8], p[9], p[10], p[11], p[12], p[13], p[14], p[15]);
#pragma unroll
        for (int db = 0; db < 2; ++db) {
            const bf16x8 v0 = *(const bf16x8*)(vbase + (size_t)(32 * db) * SEQ + kb), v1 = *(const bf16x8*)(vbase + (size_t)(32 * db) * SEQ + kb + 16);
            O[db] = MFMA32(v0, pf0, O[db]); O[db] = MFMA32(v1, pf1, O[db]); }
    }
    l += __shfl_xor(l, 32);
    const float inv = 1.0f / l;
    bf16* op = OG + tokq * 3072 + g * 1024 + head * 64 + 4 * hh;
#pragma unroll
    for (int db = 0; db < 2; ++db)
#pragma unroll
        for (int gg = 0; gg < 4; ++gg) { v2u w2; w2.x = pk2(O[db][4 * gg] * inv, O[db][4 * gg + 1] * inv); w2.y = pk2(O[db][4 * gg + 2] * inv, O[db][4 * gg + 3] * inv); *(v2u*)(op + 32 * db + 8 * gg) = w2; }
    if (hh == 0) LSE[tokq * 48 + g * 16 + head] = m + __builtin_amdgcn_logf(l);
}
__device__ __forceinline__ void p13_merge(Frame& F) {
    const bf16* OG = (const bf16*)(F.ws + WS_OG); const float* LSE = (const float*)(F.ws + WS_LSE); bf16* O1 = (bf16*)(F.ws + WS_O1);
    const int gt = F.bid * (NWAVES * 64) + F.tid, NT = F.G * NWAVES * 64;
    for (int i = gt; i < MTOK * 128; i += NT) { const int tok = i >> 7, c8 = i & 127, head = c8 >> 3;
        const float l0 = LSE[(size_t)tok * 48 + head], l1 = LSE[(size_t)tok * 48 + 16 + head], l2 = LSE[(size_t)tok * 48 + 32 + head];
        const float mm = fmaxf(l0, fmaxf(l1, l2)); float w0 = __builtin_amdgcn_exp2f(l0 - mm), w1 = __builtin_amdgcn_exp2f(l1 - mm), w2 = __builtin_amdgcn_exp2f(l2 - mm);
        const float inv = 1.0f / (w0 + w1 + w2); w0 *= inv; w1 *= inv; w2 *= inv;
        const v4u a = *(const v4u*)(OG + (size_t)tok * 3072 + c8 * 8), bb = *(const v4u*)(OG + (size_t)tok * 3072 + 1024 + c8 * 8), cc = *(const v4u*)(OG + (size_t)tok * 3072 + 2048 + c8 * 8);
        v4u o;
        o.x = pk2(w0 * bflo(a.x) + w1 * bflo(bb.x) + w2 * bflo(cc.x), w0 * bfhi(a.x) + w1 * bfhi(bb.x) + w2 * bfhi(cc.x));
        o.y = pk2(w0 * bflo(a.y) + w1 * bflo(bb.y) + w2 * bflo(cc.y), w0 * bfhi(a.y) + w1 * bfhi(bb.y) + w2 * bfhi(cc.y));
        o.z = pk2(w0 * bflo(a.z) + w1 * bflo(bb.z) + w2 * bflo(cc.z), w0 * bfhi(a.z) + w1 * bfhi(bb.z) + w2 * bfhi(cc.z));
        o.w = pk2(w0 * bflo(a.w) + w1 * bflo(bb.w) + w2 * bflo(cc.w), w0 * bfhi(a.w) + w1 * bfhi(bb.w) + w2 * bfhi(cc.w));
        *(v4u*)(O1 + (size_t)tok * 1024 + c8 * 8) = o; }
}

__device__ __forceinline__ void p15_norm_route(Frame& F, const Args& A) {
    const float* X = A.out; const float* MOD = (const float*)(F.ws + WS_MOD); bf16* HA = (bf16*)(F.ws + WS_HA);
    const float* g = (const float*)A.in[7] + DM; const float* router = (const float*)A.in[23]; const float* rb = (const float*)A.in[24];
    int* r_exp = (int*)(F.ws + WS_ROUTE); int* r_pos = r_exp + 2 * MTOK; float* r_gate = (float*)(r_pos + 2 * MTOK);
    LAS float* RT = (LAS float*)F.lds;
    __syncthreads();
    for (int i = F.tid; i < DM * NEXP; i += NWAVES * 64) RT[(i & 7) * DM + (i >> 3)] = router[i];
    __syncthreads();
    const int gw = F.bid * NWAVES + F.wave, NGW = F.G * NWAVES;
    for (int row = gw; row < MTOK; row += NGW) { const int b = row >> 11;
        f32x4 v[8]; const float* xr = X + (size_t)row * DM + 4 * F.lane;
#pragma unroll
        for (int j = 0; j < 8; ++j) v[j] = *(const f32x4*)(xr + 256 * j);
        const float rstd = row_rstd(v);
        const float* sh = MOD + (size_t)b * NMOD + 12288 + 6144; const float* sc = MOD + (size_t)b * NMOD + 12288 + 8192;
        float lg[8];
#pragma unroll
        for (int e = 0; e < 8; ++e) lg[e] = 0.f;
        bf16* orow = HA + (size_t)row * DM;
#pragma unroll
        for (int j = 0; j < 8; ++j) { const int col = 4 * F.lane + 256 * j;
            const f32x4 gg = *(const f32x4*)(g + col), s1 = *(const f32x4*)(sc + col), s0 = *(const f32x4*)(sh + col);
            const f32x4 y = v[j] * rstd * gg * (s1 + 1.0f) + s0;
            v2u w; w.x = pk2(y.x, y.y); w.y = pk2(y.z, y.w); *(v2u*)(orow + col) = w;
#pragma unroll
            for (int e = 0; e < 8; ++e) { const f32x4 rr = *(const LAS f32x4*)(RT + e * DM + col); lg[e] += (y.x * rr.x + y.y * rr.y) + (y.z * rr.z + y.w * rr.w); }
            asm volatile("" ::: "memory"); }
#pragma unroll
        for (int e = 0; e < 8; ++e) lg[e] = wave_sum(lg[e]) + rb[e];
        int e0 = 0; float v0 = lg[0];
#pragma unroll
        for (int e = 1; e < 8; ++e) if (lg[e] > v0) { v0 = lg[e]; e0 = e; }
        int e1 = -1; float v1 = -3.0e38f;
#pragma unroll
        for (int e = 0; e < 8; ++e) if (e != e0 && lg[e] > v1) { v1 = lg[e]; e1 = e; }
        const float g1 = 1.0f / (1.0f + __expf(v0 - v1)), g0 = 1.0f - g1;
        if (F.lane == 0) {
            const unsigned p0 = __hip_atomic_fetch_add((unsigned*)(F.ctl + CW_CNT + 64 * e0), 1u, RLX_AGENT);
            const unsigned p1 = __hip_atomic_fetch_add((unsigned*)(F.ctl + CW_CNT + 64 * e1), 1u, RLX_AGENT);
            r_exp[2 * row] = e0; r_exp[2 * row + 1] = e1; r_pos[2 * row] = (int)p0; r_pos[2 * row + 1] = (int)p1; r_gate[2 * row] = g0; r_gate[2 * row + 1] = g1;
        }
    }
}
__device__ __forceinline__ void moe_offsets(Frame& F, int (&off)[9]) {
    off[0] = 0;
#pragma unroll
    for (int e = 0; e < 8; ++e) { const unsigned cnt = __hip_atomic_load((unsigned*)(F.ctl + CW_CNT + 64 * e), RLX_AGENT); off[e + 1] = off[e] + (int)((cnt + 255u) & ~255u); }
}
__device__ __forceinline__ void p16_gather(Frame& F) {
    const bf16* HA = (const bf16*)(F.ws + WS_HA); bf16* AS = (bf16*)(F.ws + WS_AS); float* RG = (float*)(F.ws + WS_RG); int* TR = (int*)(F.ws + WS_TR);
    const int* r_exp = (const int*)(F.ws + WS_ROUTE); const int* r_pos = r_exp + 2 * MTOK; const float* r_gate = (const float*)(r_pos + 2 * MTOK);
    int off[9]; moe_offsets(F, off);
    const int gw = F.bid * NWAVES + F.wave, NGW = F.G * NWAVES;
    for (int idx = gw; idx < 2 * MTOK; idx += NGW) {
        const int e = r_exp[idx], p = r_pos[idx]; int base = 0;
#pragma unroll
        for (int k = 1; k < 8; ++k) base = (e >= k) ? off[k] : base;
        const int row = base + p, tok = idx >> 1;
        const v4u* src = (const v4u*)(HA + (size_t)tok * DM) + F.lane; v4u* dst = (v4u*)(AS + (size_t)row * DM) + F.lane;
        const v4u a = src[0], b2 = src[64], c2 = src[128], d2 = src[192];
        dst[0] = a; dst[64] = b2; dst[128] = c2; dst[192] = d2;
        if (F.lane == 0) { RG[row] = r_gate[idx]; TR[idx] = row; }
    }
}
__device__ __forceinline__ void p19_final(Frame& F, const Args& A) {
    float* X = A.out; const float* MOD = (const float*)(F.ws + WS_MOD); const float* Y = (const float*)(F.ws + WS_Y); const int* TR = (const int*)(F.ws + WS_TR);
    const int gw = F.bid * NWAVES + F.wave, NGW = F.G * NWAVES;
    for (int row = gw; row < MTOK; row += NGW) { const int b = row >> 11; const int r0 = TR[2 * row], r1 = TR[2 * row + 1];
        const float* gt = MOD + (size_t)b * NMOD + 12288 + 10240;
        float* xr = X + (size_t)row * DM + 4 * F.lane; const float* y0 = Y + (size_t)r0 * DM + 4 * F.lane; const float* y1 = Y + (size_t)r1 * DM + 4 * F.lane;
#pragma unroll
        for (int j = 0; j < 8; ++j) { const f32x4 xv = *(const f32x4*)(xr + 256 * j), a = *(const f32x4*)(y0 + 256 * j), c2 = *(const f32x4*)(y1 + 256 * j), gg = *(const f32x4*)(gt + 4 * F.lane + 256 * j);
            *(f32x4*)(xr + 256 * j) = xv + gg * (a + c2); }
    }
}

constexpr int N_PHASES = 20;
__global__ void __launch_bounds__(NWAVES * 64, 2) yoco_fwd(Args args) {
    extern __shared__ __attribute__((aligned(16))) unsigned char lds[];
    Frame F;
    F.lds = (LAS unsigned char*)lds; F.MISC = (volatile LAS unsigned*)(F.lds + MISC_OFF);
    F.tid = threadIdx.x; F.lane = F.tid & 63; F.wave = __builtin_amdgcn_readfirstlane(F.tid >> 6); F.G = gridDim.x; F.bid = blockIdx.x;
    F.ws = args.ws; F.ctl = (gu32*)(args.ws + WS_CTL);
    for (int u = F.tid; u < (LDS_BYTES - LDSCTL_OFF) / 4; u += NWAVES * 64) ((LAS unsigned*)(F.lds + LDSCTL_OFF))[u] = 0u;
    __syncthreads();
    const int lo = args.ph_lo, hi = args.ph_hi;
    const bool one_launch = (hi - lo) > 1;
    XcdBarrier bar; bar.bar = (unsigned*)(F.ctl + CW_BAR); bar.x = 0; bar.st = nullptr;
    if (one_launch) bar = xcd_barrier_post((unsigned*)(F.ctl + CW_BAR), F.MISC + 8);
#ifndef PROBE_DUP
#define PROBE_DUP -1
#endif
#define REPS(k) ((PROBE_DUP) == (k) ? 2 : 1)
#ifndef PHASE_MASK
#define PHASE_MASK 0xFFFFFFFFu
#endif
#define IN(k) ((((PHASE_MASK) >> (k)) & 1u) && lo <= (k) && (k) < hi)
#define SEAM(k) do { if (IN(k) && IN((k) + 1)) xcd_barrier(bar); } while (0)
    float* const MOD = (float*)(F.ws + WS_MOD);
    const float* const MODc = MOD;
    bf16* const HA = (bf16*)(F.ws + WS_HA);
    const int gw = F.bid * NWAVES + F.wave, NGW = F.G * NWAVES;

    if (IN(0)) for (int rep_ = 0; rep_ < REPS(0); ++rep_) { p0_prologue(F, args); } SEAM(0);
    if (IN(1)) for (int rep_ = 0; rep_ < REPS(1); ++rep_) { normmod_phase(F, (const float*)args.in[0], (const float*)args.in[6], MODc + 0, MODc + 2048, HA); } SEAM(1);
    if (IN(2)) for (int rep_ = 0; rep_ < REPS(2); ++rep_) { pg8::Gemm g{HA, (const bf16*)(F.ws + WS_WIN), MTOK, A_INP, DM}; pg8::StaticOrder S; S.init(MTOK, A_INP, F.G, F.bid);
        pg8::EpiBf16Sel E{(bf16*)(F.ws + WS_P0), A_INP, nullptr, 0, 0, 1 << 30};
        pg8::gemm_phase<pg8::EpiBf16Sel, pg8::StaticOrder, true, true>(F.lds + RING_OFF, g, S, E); } SEAM(2);
    if (IN(3)) for (int rep_ = 0; rep_ < REPS(3); ++rep_) { p3_qknorm(F, args); p3_vtrans(F);
        for (int q = gw; q < MTOK / 4; q += NGW) {
            const int s0 = q, s1 = MTOK / 2 - 1 - q;
            p3_indexer_pair(F, (s0 & 3) * 1024 + (s0 >> 2)); p3_indexer_pair(F, (s1 & 3) * 1024 + (s1 >> 2)); } } SEAM(3);
    if (IN(4)) for (int rep_ = 0; rep_ < REPS(4); ++rep_) { for (int i = F.bid; i < 512; i += F.G) { const int item = (i < 256) ? ((31 - (i >> 4)) << 4 | (i & 15)) : (((i - 256) >> 4) << 4 | (i & 15)); p4_attn_item(F, args, item); } __syncthreads(); } SEAM(4);
    if (IN(5)) for (int rep_ = 0; rep_ < REPS(5); ++rep_) { pg8::Gemm g{(const bf16*)(F.ws + WS_O), (const bf16*)(F.ws + WS_WAOUT), MTOK, DM, DM}; pg8::StaticOrder S; S.init(MTOK, DM, F.G, F.bid);
        pg8::EpiResGate E{(const float*)args.in[0], args.out, MODc + 4096, NMOD};
        pg8::gemm_phase<pg8::EpiResGate, pg8::StaticOrder, false, true>(F.lds + RING_OFF, g, S, E); } SEAM(5);
    if (IN(6)) for (int rep_ = 0; rep_ < REPS(6); ++rep_) { normmod_phase(F, args.out, (const float*)args.in[7], MODc + 6144, MODc + 8192, HA); } SEAM(6);
    if (IN(7)) for (int rep_ = 0; rep_ < REPS(7); ++rep_) { pg8::Gemm g{HA, (const bf16*)(F.ws + WS_WF13), MTOK, 2 * DFF, DM}; pg8::StaticOrder S; S.init(MTOK, 2 * DFF, F.G, F.bid);
        pg8::EpiSwiGLU E{(bf16*)(F.ws + WS_U), DFF, 2 * DFF / 256};
        pg8::gemm_phase<pg8::EpiSwiGLU, pg8::StaticOrder, true, true>(F.lds + RING_OFF, g, S, E); } SEAM(7);
    if (IN(8)) for (int rep_ = 0; rep_ < REPS(8); ++rep_) { pg8::Gemm g{(const bf16*)(F.ws + WS_U), (const bf16*)(F.ws + WS_WF2), MTOK, DM, DFF}; pg8::StaticOrder S; S.init(MTOK, DM, F.G, F.bid);
        pg8::EpiResGate E{args.out, args.out, MODc + 10240, NMOD};
        pg8::gemm_phase<pg8::EpiResGate, pg8::StaticOrder, false, true>(F.lds + RING_OFF, g, S, E); } SEAM(8);
    if (IN(9)) for (int rep_ = 0; rep_ < REPS(9); ++rep_) { const float* X = args.out; const float* gk = (const float*)args.in[14]; const float* ga = (const float*)args.in[6] + DM;
        for (int row = gw; row < MTOK; row += NGW) { const int b = row >> 11;
            f32x4 v[8]; const float* xr = X + (size_t)row * DM + 4 * F.lane;
#pragma unroll
            for (int j = 0; j < 8; ++j) v[j] = *(const f32x4*)(xr + 256 * j);
            const float rstd = row_rstd(v);
            modulate_store(v, rstd, gk, MODc + (size_t)b * NMOD + 24576, MODc + (size_t)b * NMOD + 24576 + 2048, HA + (size_t)row * DM, F.lane);
            modulate_store(v, rstd, ga, MODc + (size_t)b * NMOD + 12288, MODc + (size_t)b * NMOD + 12288 + 2048, HA + (size_t)(MTOK + row) * DM, F.lane); } } SEAM(9);
    if (IN(10)) for (int rep_ = 0; rep_ < REPS(10); ++rep_) { pg8::Gemm g{HA, (const bf16*)(F.ws + WS_WKVQ), 2 * MTOK, 9216, DM}; pg8::DualOrder S; S.init(MTOK / 256, 24, 12, MTOK / 256, 24, F.G, F.bid);
        pg8::EpiBf16Sel E{(bf16*)(F.ws + WS_KV), 6144, (bf16*)(F.ws + WS_Q1), 3072, MTOK / 256, 24};
        pg8::gemm_phase<pg8::EpiBf16Sel, pg8::DualOrder, true, true>(F.lds + RING_OFF, g, S, E); } SEAM(10);
    if (IN(11)) for (int rep_ = 0; rep_ < REPS(11); ++rep_) { p11_qknorm(F, args); p11_vtrans(F); } SEAM(11);
    if (IN(12)) for (int rep_ = 0; rep_ < REPS(12); ++rep_) { for (int item = F.bid; item < NB * 3 * 16 * 8; item += F.G) p12_attn_item(F, args, item); __syncthreads(); } SEAM(12);
    if (IN(13)) for (int rep_ = 0; rep_ < REPS(13); ++rep_) { p13_merge(F); } SEAM(13);
    if (IN(14)) for (int rep_ = 0; rep_ < REPS(14); ++rep_) { pg8::Gemm g{(const bf16*)(F.ws + WS_O1), (const bf16*)(F.ws + WS_WBOUT), MTOK, DM, 1024}; pg8::StaticOrder S; S.init(MTOK, DM, F.G, F.bid);
        pg8::EpiResGate E{args.out, args.out, MODc + 12288 + 4096, NMOD};
        pg8::gemm_phase<pg8::EpiResGate, pg8::StaticOrder, false, true>(F.lds + RING_OFF, g, S, E); } SEAM(14);
    if (IN(15)) for (int rep_ = 0; rep_ < REPS(15); ++rep_) { p15_norm_route(F, args); } SEAM(15);
    if (IN(16)) for (int rep_ = 0; rep_ < REPS(16); ++rep_) { p16_gather(F); } SEAM(16);
    if (IN(17)) for (int rep_ = 0; rep_ < REPS(17); ++rep_) { int off[9]; moe_offsets(F, off); pg8::MoeOrder S;
#pragma unroll
        for (int e = 0; e < 9; ++e) S.toff[e] = off[e] >> 8;
        S.nN = 2 * DFFE / 256; S.T = S.toff[8]; S.total = S.T * S.nN; S.G = F.G; S.c = F.bid;
        pg8::Gemm g{(const bf16*)(F.ws + WS_AS), (const bf16*)(F.ws + WS_WM13), MROWS, 2 * DFFE, DM};
        pg8::EpiSwiGLU E{(bf16*)(F.ws + WS_UM), DFFE, 2 * DFFE / 256};
        pg8::gemm_phase<pg8::EpiSwiGLU, pg8::MoeOrder, true, true>(F.lds + RING_OFF, g, S, E); } SEAM(17);
    if (IN(18)) for (int rep_ = 0; rep_ < REPS(18); ++rep_) { int off[9]; moe_offsets(F, off); pg8::MoeOrder S;
#pragma unroll
        for (int e = 0; e < 9; ++e) S.toff[e] = off[e] >> 8;
        S.nN = DM / 256; S.T = S.toff[8]; S.total = S.T * S.nN; S.G = F.G; S.c = F.bid;
        pg8::Gemm g{(const bf16*)(F.ws + WS_UM), (const bf16*)(F.ws + WS_WM2), MROWS, DM, DFFE};
        pg8::EpiRowScale E{(float*)(F.ws + WS_Y), (const float*)(F.ws + WS_RG), DM / 256};
        pg8::gemm_phase<pg8::EpiRowScale, pg8::MoeOrder, true, true>(F.lds + RING_OFF, g, S, E); } SEAM(18);
    if (IN(19)) for (int rep_ = 0; rep_ < REPS(19); ++rep_) { p19_final(F, args); }
#undef IN
#undef SEAM
}

#ifndef MK_PER_PHASE
#define MK_PER_PHASE 0
#endif
extern "C" void kernel_launch(void* const* d_in, const int* in_sizes, int n_in, void* d_out, int out_size, void* d_ws, size_t ws_size, hipStream_t stream) {
    static int grid = 0;
    if (grid == 0) {
        if (n_in != 28 || out_size != MTOK * DM || ws_size < WS_END) { fprintf(stderr, "kernel_launch: unexpected shapes (n_in %d, out %d, ws %zu < %zu)\n", n_in, out_size, ws_size, (size_t)WS_END); grid = -1; return; }
        int dev = 0, cus = 0, per_cu = 0;
        if (hipGetDevice(&dev) != hipSuccess || hipDeviceGetAttribute(&cus, hipDeviceAttributeMultiprocessorCount, dev) != hipSuccess) { grid = -1; return; }
        if (hipFuncSetAttribute((const void*)yoco_fwd, hipFuncAttributeMaxDynamicSharedMemorySize, LDS_BYTES) != hipSuccess) { fprintf(stderr, "kernel_launch: hipFuncSetAttribute failed\n"); grid = -1; return; }
        if (hipOccupancyMaxActiveBlocksPerMultiprocessor(&per_cu, (const void*)yoco_fwd, NWAVES * 64, LDS_BYTES) != hipSuccess || per_cu < 1) fprintf(stderr, "kernel_launch: occupancy query reports %d\n", per_cu);
        (void)hipGetLastError();
        grid = cus;
    }
    if (grid < 0) return;
    if (hipMemsetAsync((char*)d_ws + WS_CTL, 0, CTL_ZERO_BYTES, stream) != hipSuccess) return;
    Args a{};
    for (int i = 0; i < 28; ++i) a.in[i] = d_in[i];
    a.out = (float*)d_out; a.ws = (unsigned char*)d_ws;
#if MK_PER_PHASE
    for (int p = 0; p < N_PHASES; ++p) { a.ph_lo = p; a.ph_hi = p + 1; hipLaunchKernelGGL(yoco_fwd, dim3(grid), dim3(NWAVES * 64), LDS_BYTES, stream, a); }
#else
    a.ph_lo = 0; a.ph_hi = N_PHASES;
    hipLaunchKernelGGL(yoco_fwd, dim3(grid), dim3(NWAVES * 64), LDS_BYTES, stream, a);
#endif
    const hipError_t le = hipPeekAtLastError();
    if (le != hipSuccess) fprintf(stderr, "kernel_launch: launch failed: %s\n", hipGetErrorName(le));
}
```

```cpp
#include <hip/hip_runtime.h>
#include <cstdio>
#include <cstdint>
namespace pg8 {
#define PG8_LAS __attribute__((address_space(3)))
typedef unsigned short bf16_t;
typedef short bf16x8 __attribute__((ext_vector_type(8)));
typedef float f32x4 __attribute__((ext_vector_type(4)));
typedef unsigned u32x4 __attribute__((ext_vector_type(4)));
constexpr int BM = 256, BK = 64, HALF = 128, HTB = HALF * BK * 2  , STAGE_BYTES = 8 * HTB, NXCD = 8, WGM = 8;

__host__ __device__ __forceinline__ int lds_byte(int r, int c) { const int st = (r >> 4) * 2 + (c >> 5), rr = r & 15, cc = c & 31, ob = rr * 64 + cc * 2; return st * 1024 + (ob ^ (((ob >> 9) & 1) << 5)); }
__host__ __device__ __forceinline__ void stage_rc(int b, int& R, int& C) { const int st = b / 1024, sb = b % 1024, swz = sb ^ (((sb >> 9) & 1) << 5); R = (st >> 1) * 16 + swz / 64; C = (st & 1) * 32 + (swz % 64) / 2; }
__host__ __device__ __forceinline__ int perm32(int rho) { const int n = rho >> 4, i = rho & 15; return 8 * (i >> 2) + 4 * n + (i & 3); }

struct Unit { int pm, pn, kofs; };
struct Gemm { const bf16_t* A; const bf16_t* Bt; int M, N, K, Kext; };

__device__ __forceinline__ void tile_map(int L, int nM, int nN, int& pm, int& pn) {
    const int nwg = nM * nN; int wgid = L;
    { const int q = nwg / NXCD, r = nwg % NXCD, xcd = wgid % NXCD, off = wgid / NXCD; wgid = (xcd < r ? xcd * (q + 1) : r * (q + 1) + (xcd - r) * q) + off; }
    const int nig = WGM * nN, gid = wgid / nig, fm = gid * WGM, gsz = (nM - fm) < WGM ? (nM - fm) : WGM;
    pm = fm + ((wgid % nig) % gsz); pn = (wgid % nig) / gsz;
}
struct StaticOrder {
    int nM, nN, nwg, G, c;
    __device__ void init(int M, int N, int G_, int c_) { nM = M / BM; nN = N / BM; nwg = nM * nN; G = G_; c = c_; }
    __device__ bool next(int i, Unit& u) const { const long L = (long)i * G + c; if (L >= nwg) return false; tile_map((int)L, nM, nN, u.pm, u.pn); u.kofs = 0; return true; }
    __device__ __forceinline__ void a_ready(const Unit&) const {}
    __device__ __forceinline__ void done(const Unit&) const {}
};
struct DualOrder {
    int nM, nN1, nN2, n1, ntot, pm_off, pn_off, G, c;
    __device__ void init(int nM_, int nN1_, int nN2_, int pm_off_, int pn_off_, int G_, int c_) { nM = nM_; nN1 = nN1_; nN2 = nN2_; n1 = nM * nN1; ntot = n1 + nM * nN2; pm_off = pm_off_; pn_off = pn_off_; G = G_; c = c_; }
    __device__ bool next(int i, Unit& u) const { const long L = (long)i * G + c; if (L >= ntot) return false;
        if (L < n1) tile_map((int)L, nM, nN1, u.pm, u.pn); else { tile_map((int)L - n1, nM, nN2, u.pm, u.pn); u.pm += pm_off; u.pn += pn_off; } u.kofs = 0; return true; }
    __device__ __forceinline__ void a_ready(const Unit&) const {}
    __device__ __forceinline__ void done(const Unit&) const {}
};
struct MoeOrder {
    int toff[9]; int nN, T, total, G, c, ksplit, klen;
    __device__ bool next(int i, Unit& u) const {
        long v;
        if ((G & 7) == 0) { const int x = c & 7, j = c >> 3, nper = G >> 3; const long s0 = ((long)x * total) >> 3, s1 = ((long)(x + 1) * total) >> 3; v = s0 + (long)i * nper + j; if (v >= s1) return false; }
        else { v = (long)i * G + c; if (v >= total) return false; }
        const int per = nN * ksplit;
        int e = 0, te = 0, te1 = toff[1];
#pragma unroll
        for (int k = 1; k < 8; ++k) { const bool ge = v >= (long)toff[k] * per; e = ge ? k : e; te = ge ? toff[k] : te; te1 = ge ? toff[k + 1] : te1; }
        const int r = (int)(v - (long)te * per), ne = te1 - te, q = r / ne, kh = q % ksplit;
        u.pm = te + r % ne; u.pn = e * nN + q / ksplit; u.kofs = kh * klen; return true; }
    __device__ __forceinline__ void a_ready(const Unit&) const {}
    __device__ __forceinline__ void done(const Unit&) const {}
};

__device__ __forceinline__ unsigned cvt_pk_bf16(float lo, float hi) { unsigned r; asm volatile("v_cvt_pk_bf16_f32 %0, %1, %2" : "=v"(r) : "v"(lo), "v"(hi)); return r; }

struct EpiBf16Sel {
    static constexpr bool PERM = true, AFTER_DRAIN = false;
    bf16_t* O0; int ld0; bf16_t* O1; int ld1; int pm_split, pn_split;
    __device__ __forceinline__ void operator()(const f32x4 (&acc)[2][2][4][2], const Unit& u, int wr, int wc, int fr, int fq) const {
        bf16_t* base = O0; int ldc = ld0, pm = u.pm, pn = u.pn;
        if (pn >= pn_split) { base = O1; ldc = ld1; pm -= pm_split; pn -= pn_split; }
        const int row0 = pm * BM + wr * 64 + fr, col0 = pn * BM + wc * 32 + 8 * fq;
#pragma unroll
        for (int ai = 0; ai < 2; ++ai)
#pragma unroll
            for (int m = 0; m < 4; ++m) { bf16_t* rowp = base + (size_t)(row0 + ai * HALF + m * 16) * ldc + col0;
#pragma unroll
                for (int bj = 0; bj < 2; ++bj) { const f32x4 v0 = acc[ai][bj][m][0], v1 = acc[ai][bj][m][1];
                    u32x4 w; w.x = cvt_pk_bf16(v0[0], v0[1]); w.y = cvt_pk_bf16(v0[2], v0[3]); w.z = cvt_pk_bf16(v1[0], v1[1]); w.w = cvt_pk_bf16(v1[2], v1[3]);
                    *(u32x4*)(rowp + bj * HALF) = w; } }
    }
};
struct EpiResGate {
    static constexpr bool PERM = false, AFTER_DRAIN = false;
    const float* base; float* out; const float* gate; int gstride;
    __device__ __forceinline__ void operator()(const f32x4 (&acc)[2][2][4][2], const Unit& u, int wr, int wc, int fr, int fq) const {
        const int row0 = u.pm * BM + wr * 64 + fr, col0 = u.pn * BM + wc * 32 + 4 * fq;
        const float* gp = gate + (size_t)(u.pm >> 3) * gstride + col0;
        f32x4 gv[2][2];
#pragma unroll
        for (int bj = 0; bj < 2; ++bj)
#pragma unroll
            for (int n = 0; n < 2; ++n) gv[bj][n] = *(const f32x4*)(gp + bj * HALF + n * 16);
#pragma unroll
        for (int ai = 0; ai < 2; ++ai)
#pragma unroll
            for (int m = 0; m < 4; ++m) { const size_t off = (size_t)(row0 + ai * HALF + m * 16) * 2048 + col0;
#pragma unroll
                for (int bj = 0; bj < 2; ++bj)
#pragma unroll
                    for (int n = 0; n < 2; ++n) { const f32x4 bs = *(const f32x4*)(base + off + bj * HALF + n * 16); *(f32x4*)(out + off + bj * HALF + n * 16) = bs + gv[bj][n] * acc[ai][bj][m][n]; }
                asm volatile("" ::: "memory"); }
    }
};
struct EpiSwiGLU {
    static constexpr bool PERM = true, AFTER_DRAIN = false;
    bf16_t* O; int ldc; int nN;
    __device__ __forceinline__ void operator()(const f32x4 (&acc)[2][2][4][2], const Unit& u, int wr, int wc, int fr, int fq) const {
        const int row0 = u.pm * BM + wr * 64 + fr, col0 = (u.pn % nN) * HALF + wc * 32 + 8 * fq;
#pragma unroll
        for (int ai = 0; ai < 2; ++ai)
#pragma unroll
            for (int m = 0; m < 4; ++m) { bf16_t* rowp = O + (size_t)(row0 + ai * HALF + m * 16) * ldc + col0;
                float r[8];
#pragma unroll
                for (int n = 0; n < 2; ++n)
#pragma unroll
                    for (int j = 0; j < 4; ++j) { const float g = acc[ai][0][m][n][j], up = acc[ai][1][m][n][j];
                        r[4 * n + j] = g * up * __builtin_amdgcn_rcpf(1.0f + __builtin_amdgcn_exp2f(-1.4426950408889634f * g)); }
                u32x4 w; w.x = cvt_pk_bf16(r[0], r[1]); w.y = cvt_pk_bf16(r[2], r[3]); w.z = cvt_pk_bf16(r[4], r[5]); w.w = cvt_pk_bf16(r[6], r[7]);
                *(u32x4*)rowp = w; }
    }
};
struct EpiRowScale {
    static constexpr bool PERM = false, AFTER_DRAIN = false;
    float* Y; const float* rs; int nN; size_t part_stride;
    __device__ __forceinline__ void operator()(const f32x4 (&acc)[2][2][4][2], const Unit& u, int wr, int wc, int fr, int fq) const {
        const int row0 = u.pm * BM + wr * 64 + fr, col0 = (u.pn % nN) * BM + wc * 32 + 4 * fq;
        float* Y = this->Y + (u.kofs ? part_stride : 0);
#pragma unroll
        for (int ai = 0; ai < 2; ++ai)
#pragma unroll
            for (int m = 0; m < 4; ++m) { const int row = row0 + ai * HALF + m * 16; const float s = rs[row]; float* rowp = Y + (size_t)row * 2048 + col0;
#pragma unroll
                for (int bj = 0; bj < 2; ++bj)
#pragma unroll
                    for (int n = 0; n < 2; ++n) *(f32x4*)(rowp + bj * HALF + n * 16) = acc[ai][bj][m][n] * s; }
    }
};

template <class Epi, class Sched, bool ALIGN_EPI = false, bool SP2 = false>
__device__ __forceinline__ void gemm_phase(PG8_LAS unsigned char* lds, const Gemm g, const Sched& S, const Epi& E) {
    const int tid = threadIdx.x, wid = __builtin_amdgcn_readfirstlane(tid >> 6), lane = tid & 63, wr = wid >> 2, wc = wid & 3, fr = lane & 15, fq = lane >> 4;
    const int K = g.K, nt = g.Kext / BK;
    unsigned voffA[2], voffB[2];
#pragma unroll
    for (int i = 0; i < 2; ++i) { int R, C; stage_rc(tid * 16 + i * 8192, R, C); const int Rb = Epi::PERM ? ((R & ~31) + perm32(R & 31)) : R;
        voffA[i] = (unsigned)(R * K + C) * 2u; voffB[i] = (unsigned)(Rb * K + C) * 2u; }
    const size_t kstep = (size_t)(BK * 2);
    const size_t hstep = (size_t)HALF * K * 2;
    const size_t tstep = 2 * hstep;
    const unsigned ldsw = (unsigned)wid * 1024u;
    const int aoff = lds_byte(wr * 64 + fr, fq * 8), boff = lds_byte(wc * 32 + fr, fq * 8);
#define PG8_SA(b, h) (((b) * 2 + (h)) * HTB)
#define PG8_SB(b, h) ((4 + (b) * 2 + (h)) * HTB)
#define PG8_STAGE(bufoff, gbase, voff) do { _Pragma("unroll") for (int _i = 0; _i < 2; ++_i) \
        __builtin_amdgcn_global_load_lds((const unsigned*)((const char*)(gbase) + (voff)[_i]), (PG8_LAS unsigned*)(lds + (bufoff) + ldsw + _i * 8192), 16, 0, 0); } while (0)
#define PG8_LDA(dst, b, h) do { _Pragma("unroll") for (int m = 0; m < 4; ++m) _Pragma("unroll") for (int k = 0; k < 2; ++k) dst[m][k] = *(const PG8_LAS bf16x8*)(lds + PG8_SA(b, h) + aoff + m * 2048 + k * 1024); } while (0)
#define PG8_LDB(dst, b, h) do { _Pragma("unroll") for (int n = 0; n < 2; ++n) _Pragma("unroll") for (int k = 0; k < 2; ++k) dst[n][k] = *(const PG8_LAS bf16x8*)(lds + PG8_SB(b, h) + boff + n * 2048 + k * 1024); } while (0)
#define PG8_MMA(ai, bj, At, Bt) do { __builtin_amdgcn_s_setprio(1); _Pragma("unroll") for (int m = 0; m < 4; ++m) _Pragma("unroll") for (int n = 0; n < 2; ++n) _Pragma("unroll") for (int k = 0; k < 2; ++k) \
        acc[ai][bj][m][n] = __builtin_amdgcn_mfma_f32_16x16x32_bf16(Bt[n][k], At[m][k], acc[ai][bj][m][n], 0, 0, 0); __builtin_amdgcn_s_setprio(0); } while (0)
#define PG8_WAIT_V(n) asm volatile("s_waitcnt vmcnt(" #n ")" ::: "memory")
#define PG8_WAIT_L(n) asm volatile("s_waitcnt lgkmcnt(" #n ")" ::: "memory")
#define PG8_BAR __builtin_amdgcn_s_barrier()
#define PG8_SCHED __builtin_amdgcn_sched_barrier(0)
    Unit cur, nxt; int ui = 0;
    if (!S.next(0, cur)) return;
    f32x4 acc[2][2][4][2];
#pragma unroll
    for (int a = 0; a < 2; ++a)
#pragma unroll
        for (int b = 0; b < 2; ++b)
#pragma unroll
            for (int m = 0; m < 4; ++m)
#pragma unroll
                for (int n = 0; n < 2; ++n) acc[a][b][m][n] = (f32x4){0.f, 0.f, 0.f, 0.f};
    bf16x8 At[4][2], B0[2][2], B1[2][2];
    const char* cA = (const char*)g.A + (size_t)cur.pm * tstep + (size_t)cur.kofs * 2; const char* cB = (const char*)g.Bt + (size_t)cur.pn * tstep + (size_t)cur.kofs * 2;
    S.a_ready(cur);
    if constexpr (SP2) {
        PG8_STAGE(PG8_SB(0, 0), cB, voffB); PG8_STAGE(PG8_SB(0, 1), cB + hstep, voffB); PG8_STAGE(PG8_SA(0, 0), cA, voffA); PG8_STAGE(PG8_SA(0, 1), cA + hstep, voffA);
        if (wr == 1) PG8_BAR;
        PG8_WAIT_V(2); PG8_BAR;
        PG8_STAGE(PG8_SB(1, 0), cB + kstep, voffB); PG8_STAGE(PG8_SA(1, 0), cA + kstep, voffA); PG8_STAGE(PG8_SB(1, 1), cB + hstep + kstep, voffB);
        PG8_WAIT_V(6); PG8_BAR;
    } else {
        PG8_STAGE(PG8_SB(0, 0), cB, voffB); PG8_STAGE(PG8_SA(0, 0), cA, voffA); PG8_STAGE(PG8_SB(0, 1), cB + hstep, voffB); PG8_STAGE(PG8_SA(0, 1), cA + hstep, voffA);
        if (wr == 1) PG8_BAR;
        PG8_WAIT_V(4); PG8_BAR;
        PG8_STAGE(PG8_SB(1, 0), cB + kstep, voffB); PG8_STAGE(PG8_SA(1, 0), cA + kstep, voffA); PG8_STAGE(PG8_SB(1, 1), cB + hstep + kstep, voffB);
        PG8_WAIT_V(6); PG8_BAR;
    }
    for (;;) {
        const bool has_next = S.next(ui + 1, nxt);
        const char* nA = has_next ? (const char*)g.A + (size_t)nxt.pm * tstep + (size_t)nxt.kofs * 2 : cA; const char* nB = has_next ? (const char*)g.Bt + (size_t)nxt.pn * tstep + (size_t)nxt.kofs * 2 : cB;
        for (int t = 0; t < nt; t += 2) {
            const bool last = (t == nt - 2);
            const char* a1 = cA + (size_t)(t + 1) * kstep;
            const char* a2 = last ? nA : cA + (size_t)(t + 2) * kstep; const char* b2 = last ? nB : cB + (size_t)(t + 2) * kstep;
            const char* a3 = a2 + kstep; const char* b3 = b2 + kstep;
            if (last && has_next) S.a_ready(nxt);
            if constexpr (SP2) {
            PG8_LDB(B0, 0, 0); PG8_LDB(B1, 0, 1); PG8_SCHED; PG8_LDA(At, 0, 0); PG8_STAGE(PG8_SA(1, 1), a1 + hstep, voffA);
            PG8_WAIT_V(8); PG8_WAIT_L(0); PG8_BAR; PG8_MMA(0, 0, At, B0); PG8_MMA(0, 1, At, B1); PG8_BAR; PG8_SCHED;
            PG8_LDA(At, 0, 1); PG8_STAGE(PG8_SB(0, 0), b2, voffB); PG8_STAGE(PG8_SB(0, 1), b2 + hstep, voffB); PG8_STAGE(PG8_SA(0, 0), a2, voffA);
            PG8_WAIT_V(8); PG8_WAIT_L(0); PG8_BAR; PG8_MMA(1, 0, At, B0); PG8_MMA(1, 1, At, B1); PG8_BAR; PG8_SCHED;
            PG8_LDB(B0, 1, 0); PG8_LDB(B1, 1, 1); PG8_SCHED; PG8_LDA(At, 1, 0); PG8_STAGE(PG8_SA(0, 1), a2 + hstep, voffA);
            PG8_WAIT_V(8); PG8_WAIT_L(0); PG8_BAR; PG8_MMA(0, 0, At, B0); PG8_MMA(0, 1, At, B1); PG8_BAR; PG8_SCHED;
            PG8_LDA(At, 1, 1); PG8_STAGE(PG8_SB(1, 0), b3, voffB); PG8_STAGE(PG8_SB(1, 1), b3 + hstep, voffB); PG8_STAGE(PG8_SA(1, 0), a3, voffA);
            PG8_WAIT_V(8); PG8_WAIT_L(0); PG8_BAR; PG8_MMA(1, 0, At, B0); PG8_MMA(1, 1, At, B1); PG8_BAR; PG8_SCHED;
            } else {
            PG8_LDB(B0, 0, 0); PG8_SCHED; PG8_LDA(At, 0, 0); PG8_STAGE(PG8_SA(1, 1), a1 + hstep, voffA);
            PG8_WAIT_L(8); PG8_BAR; PG8_WAIT_L(0); PG8_MMA(0, 0, At, B0); PG8_BAR; PG8_SCHED;
            PG8_LDB(B1, 0, 1); PG8_STAGE(PG8_SB(0, 0), b2, voffB);
            PG8_BAR; PG8_WAIT_L(0); PG8_MMA(0, 1, At, B1); PG8_BAR;
            PG8_LDA(At, 0, 1); PG8_STAGE(PG8_SA(0, 0), a2, voffA);
            PG8_BAR; PG8_WAIT_L(0); PG8_MMA(1, 0, At, B0); PG8_BAR; PG8_SCHED;
            PG8_STAGE(PG8_SB(0, 1), b2 + hstep, voffB);
            PG8_WAIT_V(6); PG8_BAR; PG8_MMA(1, 1, At, B1); PG8_BAR;
            PG8_LDB(B0, 1, 0); PG8_SCHED; PG8_LDA(At, 1, 0); PG8_STAGE(PG8_SA(0, 1), a2 + hstep, voffA);
            PG8_WAIT_L(8); PG8_BAR; PG8_WAIT_L(0); PG8_MMA(0, 0, At, B0); PG8_BAR; PG8_SCHED;
            PG8_LDB(B1, 1, 1); PG8_STAGE(PG8_SB(1, 0), b3, voffB);
            PG8_BAR; PG8_WAIT_L(0); PG8_MMA(0, 1, At, B1); PG8_BAR;
            PG8_LDA(At, 1, 1); PG8_STAGE(PG8_SA(1, 0), a3, voffA);
            PG8_BAR; PG8_WAIT_L(0); PG8_MMA(1, 0, At, B0); PG8_BAR; PG8_SCHED;
            PG8_STAGE(PG8_SB(1, 1), b3 + hstep, voffB);
            PG8_WAIT_V(6); PG8_BAR; PG8_MMA(1, 1, At, B1); PG8_BAR;
            }
        }
        if constexpr (ALIGN_EPI) { if (wr == 0) PG8_BAR; }
        if constexpr (!Epi::AFTER_DRAIN) { E(acc, cur, wr, wc, fr, fq); S.done(cur); }
        if (!has_next) break;
#pragma unroll
        for (int a = 0; a < 2; ++a)
#pragma unroll
            for (int b = 0; b < 2; ++b)
#pragma unroll
                for (int m = 0; m < 4; ++m)
#pragma unroll
                    for (int n = 0; n < 2; ++n) acc[a][b][m][n] = (f32x4){0.f, 0.f, 0.f, 0.f};
        cur = nxt; cA = nA; cB = nB; ++ui;
        if constexpr (ALIGN_EPI) { if (wr == 1) PG8_BAR; }
    }
    PG8_WAIT_V(0);
    if constexpr (!ALIGN_EPI) { if (wr == 0) PG8_BAR; }
    PG8_BAR;
    if constexpr (Epi::AFTER_DRAIN) { E.fused(acc, cur, wr, wc, fr, fq, lds, wid, lane); S.done(cur); }
#undef PG8_SA
#undef PG8_SB
#undef PG8_STAGE
#undef PG8_LDA
#undef PG8_LDB
#undef PG8_MMA
#undef PG8_WAIT_V
#undef PG8_WAIT_L
#undef PG8_BAR
#undef PG8_SCHED
}
}

constexpr int NB = 4, SEQ = 2048, DM = 2048, MTOK = NB * SEQ;
constexpr int A_IN = 4176, A_INP = 4352;
constexpr int C_Q = 0, C_K = 2048, C_V = 2560, C_QI = 3072, C_KI = 4096, C_WI = 4160;
constexpr int DFF = 5632, DFFE = 7168, NEXP = 8;
constexpr int NMOD = 28672;
constexpr float EPS = 1e-6f, LOG2E = 1.4426950408889634f;
constexpr int MROWS = 2 * MTOK + NEXP * 256;

constexpr size_t MiB = 1u << 20;
constexpr size_t WS_CTL = 0, CTL_ZERO_BYTES = 1 * MiB;
constexpr size_t WS_MOD = 1 * MiB, WS_BT = WS_MOD + 512 * 1024, WS_ROUTE = WS_MOD + 768 * 1024;
constexpr size_t WS_WIN = 2 * MiB, WS_WAOUT = 19 * MiB, WS_WF13 = 27 * MiB, WS_WF2 = 71 * MiB, WS_WKVQ = 93 * MiB, WS_WBOUT = 129 * MiB, WS_WM13 = 133 * MiB, WS_WM2 = 581 * MiB;
constexpr size_t WS_HA = 805 * MiB, WS_AR = 869 * MiB;
constexpr size_t WS_P0 = WS_AR, WS_QN = WS_AR + 68 * MiB, WS_KN = WS_AR + 100 * MiB, WS_VT = WS_AR + 108 * MiB, WS_MASK = WS_AR + 116 * MiB, WS_O = WS_AR + 118 * MiB, WS_U = WS_AR + 150 * MiB;
constexpr size_t WS_KV = WS_AR, WS_Q1 = WS_AR + 96 * MiB, WS_K1N = WS_AR + 144 * MiB, WS_Q1N = WS_AR + 192 * MiB, WS_VT1 = WS_AR + 240 * MiB, WS_OG = WS_AR + 288 * MiB, WS_LSE = WS_AR + 336 * MiB, WS_O1 = WS_AR + 338 * MiB;
constexpr size_t WS_AS = WS_AR, WS_UM = WS_AR + 72 * MiB, WS_Y = WS_AR + 324 * MiB, WS_Y2 = WS_AR + 468 * MiB, WS_RG = WS_AR + 612 * MiB, WS_TR = WS_AR + 613 * MiB;
constexpr size_t WS_END = WS_AR + 614 * MiB;
static_assert((size_t)A_INP * DM * 2 <= 17 * MiB && (size_t)MROWS * DFFE * 2 <= 252 * MiB && (size_t)MROWS * DM * 4 <= 144 * MiB && (size_t)MROWS * DM * 2 <= 72 * MiB, "ws map");
constexpr int CW_TMO = 0, CW_CODE = 1, CW_BAR = 4096, CW_CNT = 8192, CW_CUR = 16384, CW_DONE = 12288;

constexpr int RING_OFF = 0, RING_BYTES = 131072;
constexpr int LDSCTL_OFF = RING_BYTES, MISC_OFF = LDSCTL_OFF + 320;
constexpr int LDS_BYTES = 147456;
constexpr int NWAVES = 8;

#define GAS __attribute__((address_space(1)))
#define LAS __attribute__((address_space(3)))
typedef unsigned short bf16;
typedef unsigned v4u __attribute__((ext_vector_type(4)));
typedef unsigned v2u __attribute__((ext_vector_type(2)));
typedef float f32x4 __attribute__((ext_vector_type(4)));
typedef float f32x2 __attribute__((ext_vector_type(2)));
typedef float f32x16 __attribute__((ext_vector_type(16)));
typedef int i32x4 __attribute__((ext_vector_type(4)));
typedef short bf16x8 __attribute__((ext_vector_type(8)));
typedef GAS unsigned gu32;
#define RLX_AGENT __ATOMIC_RELAXED, __HIP_MEMORY_SCOPE_AGENT
#define MFMA32(a, b, c) __builtin_amdgcn_mfma_f32_32x32x16_bf16((a), (b), (c), 0, 0, 0)
__device__ __forceinline__ unsigned f2bf(float f) { unsigned u = __builtin_bit_cast(unsigned, f); return (u + 0x7fffu + ((u >> 16) & 1u)) >> 16; }
__device__ __forceinline__ unsigned pk2(float lo, float hi) { return f2bf(lo) | (f2bf(hi) << 16); }
__device__ __forceinline__ float bflo(unsigned w) { return __builtin_bit_cast(float, w << 16); }
__device__ __forceinline__ float bfhi(unsigned w) { return __builtin_bit_cast(float, w & 0xffff0000u); }
typedef float f32x2_t __attribute__((ext_vector_type(2)));
typedef __bf16 bf16x2_t __attribute__((ext_vector_type(2)));
__device__ __forceinline__ unsigned cvtpk(float lo, float hi) { f32x2_t v = {lo, hi}; bf16x2_t b = __builtin_convertvector(v, bf16x2_t); return __builtin_bit_cast(unsigned, b); }
__device__ __forceinline__ bf16x8 pack8(float a0, float a1, float a2, float a3, float a4, float a5, float a6, float a7) {
    v4u p; p.x = cvtpk(a0, a1); p.y = cvtpk(a2, a3); p.z = cvtpk(a4, a5); p.w = cvtpk(a6, a7); return __builtin_bit_cast(bf16x8, p); }
#define XB_TMO      128
#define XB_XCNT(j)  (256  + 64 * (j))
#define XB_XSUB(j)  (1280 + 64 * (j))
#define XB_XGEN(j)  (2304 + 64 * (j))
#define XB_TOP      3328
#define XB_TOPGEN   3392
#define XCD_BAR_WORDS 3456
#define XB_SPIN_CAP (1u << 18)

__device__ __forceinline__ unsigned xb_ld(unsigned* p)              { return __hip_atomic_load(p, __ATOMIC_RELAXED, __HIP_MEMORY_SCOPE_AGENT); }
__device__ __forceinline__ unsigned xb_add(unsigned* p, unsigned v) { return __hip_atomic_fetch_add(p, v, __ATOMIC_RELAXED, __HIP_MEMORY_SCOPE_AGENT); }
__device__ __forceinline__ unsigned xb_xcc_id() { return (unsigned)__builtin_amdgcn_s_getreg((3 << 11) | 20) & 0xFu; }
#define XB_SPIN(cond, bar) do { unsigned _sp = 0; while (cond) { __builtin_amdgcn_s_sleep(1); \
    if ((++_sp & 255u) == 0u) { if (xb_ld(&(bar)[XB_TMO])) break; if (_sp > XB_SPIN_CAP) { atomicAdd(&(bar)[XB_TMO], 1u); break; } } } } while (0)

struct XcdBarrier {
    unsigned* bar; unsigned x;
    volatile LAS unsigned* st;
};

__device__ __forceinline__ XcdBarrier xcd_barrier_post(unsigned* bar, volatile LAS unsigned* st) {
    XcdBarrier b; b.bar = bar; b.x = xb_xcc_id(); b.st = st;
    if (threadIdx.x == 0) (void)xb_add(&bar[XB_XCNT(b.x)], 1u);
    return b;
}
__device__ __forceinline__ void xcd_barrier_complete(unsigned* bar, unsigned x, unsigned& nloc, unsigned& nx) {
    const unsigned G = gridDim.x * gridDim.y * gridDim.z;
    unsigned sum, cnt, mine, sp = 0u;
    for (;;) {
        sum = 0u; cnt = 0u; mine = 0u;
#pragma unroll
        for (unsigned j = 0; j < 16; ++j) { const unsigned c = xb_ld(&bar[XB_XCNT(j)]); sum += c; cnt += (c > 0u) ? 1u : 0u; mine = (j == x) ? c : mine; }
        if (sum == G) break;
        __builtin_amdgcn_s_sleep(1);
        if ((++sp & 255u) == 0u) { if (xb_ld(&bar[XB_TMO])) break; if (sp > XB_SPIN_CAP) { atomicAdd(&bar[XB_TMO], 1u); break; } }
    }
    nloc = mine > 0u ? mine : 1u; nx = cnt > 0u ? cnt : 1u;
}

__device__ __forceinline__ void xcd_barrier(const XcdBarrier& b) {
    asm volatile("s_waitcnt vmcnt(0)" ::: "memory");
    __syncthreads();
    if (threadIdx.x == 0) {
        unsigned* bar = b.bar;
        __builtin_amdgcn_s_waitcnt(0);
        unsigned nloc = b.st[0], nx = b.st[1];
        if (nloc == 0u) { xcd_barrier_complete(bar, b.x, nloc, nx); b.st[0] = nloc; b.st[1] = nx; }
        const unsigned old = xb_add(&bar[XB_XSUB(b.x)], 1u);
        const unsigned gen = old / nloc;
        if (old + 1u == (gen + 1u) * nloc) {
            __builtin_amdgcn_fence(__ATOMIC_RELEASE, "agent");
            asm volatile("s_waitcnt vmcnt(0)" ::: "memory");
            const unsigned og = xb_add(&bar[XB_TOP], 1u);
            const unsigned tg = og / nx;
            if (og + 1u == (tg + 1u) * nx) xb_add(&bar[XB_TOPGEN], 1u);
            else XB_SPIN(xb_ld(&bar[XB_TOPGEN]) == tg, bar);
            __builtin_amdgcn_fence(__ATOMIC_ACQUIRE, "agent");
            xb_add(&bar[XB_XGEN(b.x)], 1u);
            asm volatile("s_waitcnt vmcnt(0)" ::: "memory");
        } else {
            XB_SPIN(xb_ld(&bar[XB_XGEN(b.x)]) == gen, bar);
            __builtin_amdgcn_fence(__ATOMIC_ACQUIRE, "agent");
            asm volatile("s_waitcnt vmcnt(0)" ::: "memory");
        }
    }
    __syncthreads();
}

struct Args { const void* in[28]; float* out; unsigned char* ws; int ph_lo, ph_hi; };
struct Frame {
    LAS unsigned char* lds; volatile LAS unsigned* MISC; gu32* ctl; unsigned char* ws;
    int tid, lane, wave, G, bid;
};
#define LDS_WAIT() asm volatile("s_waitcnt lgkmcnt(0)" ::: "memory")
__device__ __forceinline__ float wave_sum(float v) {
#pragma unroll
    for (int o = 1; o < 64; o <<= 1) v += __shfl_xor(v, o);
    return v;
}

__device__ __forceinline__ int t5_bucket(int n) {
    if (n < 16) return n;
    const float v = logf((float)n / 16.0f) / 4.852030263919617f * 16.0f;
    const int l = 16 + (int)v; return l < 31 ? l : 31;
}
__device__ __forceinline__ void cvt_tile(const float* __restrict__ src, int N, int k0, int n0, int nvalid, bf16* __restrict__ dst, size_t drow0, int Kd, int lane) {
    const int cl = lane & 15, kg = lane >> 4;
    f32x4 v[16];
    const float* sp = src + (size_t)(k0 + 16 * kg) * N + n0 + 4 * cl;
    const bool ok = 4 * cl < nvalid;
#pragma unroll
    for (int i = 0; i < 16; ++i) v[i] = ok ? *(const f32x4*)(sp + (size_t)i * N) : (f32x4){0.f, 0.f, 0.f, 0.f};
    bf16* dp = dst + (drow0 + 4 * cl) * (size_t)Kd + k0 + 16 * kg;
#pragma unroll
    for (int e = 0; e < 4; ++e) {
        v4u a, b;
        a.x = pk2(v[0][e], v[1][e]); a.y = pk2(v[2][e], v[3][e]); a.z = pk2(v[4][e], v[5][e]); a.w = pk2(v[6][e], v[7][e]);
        b.x = pk2(v[8][e], v[9][e]); b.y = pk2(v[10][e], v[11][e]); b.z = pk2(v[12][e], v[13][e]); b.w = pk2(v[14][e], v[15][e]);
        *(v4u*)(dp + (size_t)e * Kd) = a; *(v4u*)(dp + (size_t)e * Kd + 8) = b;
    }
}
__device__ __forceinline__ void p0_prologue(Frame& F, const Args& A) {
    const float* c_in = (const float*)A.in[1];
    const float* rel_bias = (const float*)A.in[3];
    float* MOD = (float*)(F.ws + WS_MOD); float* BT = (float*)(F.ws + WS_BT);
    LAS float* cs = (LAS float*)F.lds; LAS float* red = (LAS float*)(F.lds + 32768);
    for (int i = F.tid; i < NB * DM; i += NWAVES * 64) { const float v = c_in[i]; cs[i] = v / (1.0f + __expf(-v)); }
    __syncthreads();
    for (int item = F.bid; item < NMOD / 128; item += F.G) {
        const int j0 = item * 128; const float* W; const float* bias; int N, jl;
        if (j0 < 12288) { W = (const float*)A.in[4]; N = 12288; jl = j0; bias = (const float*)A.in[5]; }
        else if (j0 < 24576) { W = (const float*)A.in[4] + (size_t)DM * 12288; N = 12288; jl = j0 - 12288; bias = (const float*)A.in[5] + 12288; }
        else { W = (const float*)A.in[12]; N = 4096; jl = j0 - 24576; bias = (const float*)A.in[13]; }
        const float* wp = W + (size_t)(256 * F.wave) * N + jl + 2 * F.lane;
        float a[4][2];
#pragma unroll
        for (int b = 0; b < 4; ++b) { a[b][0] = 0.f; a[b][1] = 0.f; }
        for (int k = 0; k < 256; k += 8) {
            f32x2 w[8];
#pragma unroll
            for (int i = 0; i < 8; ++i) w[i] = *(const f32x2*)(wp + (size_t)(k + i) * N);
#pragma unroll
            for (int i = 0; i < 8; ++i)
#pragma unroll
                for (int b = 0; b < 4; ++b) { const float cv = cs[b * DM + 256 * F.wave + k + i]; a[b][0] += cv * w[i].x; a[b][1] += cv * w[i].y; }
        }
#pragma unroll
        for (int b = 0; b < 4; ++b) { red[(F.wave * 4 + b) * 128 + 2 * F.lane] = a[b][0]; red[(F.wave * 4 + b) * 128 + 2 * F.lane + 1] = a[b][1]; }
        __syncthreads();
        { const int b = F.tid >> 7, col = F.tid & 127; float s = bias[jl + col];
#pragma unroll
          for (int w = 0; w < 8; ++w) s += red[(w * 4 + b) * 128 + col];
          MOD[(size_t)b * NMOD + j0 + col] = s; }
        __syncthreads();
    }
    for (int idx = F.bid * (NWAVES * 64) + F.tid; idx < 16 * 2048; idx += F.G * NWAVES * 64) { const int h = idx >> 11, n = idx & 2047; BT[idx] = rel_bias[t5_bucket(n) * 16 + h] * LOG2E; }
    const int gw = F.bid * NWAVES + F.wave, NGW = F.G * NWAVES;
    constexpr int T_IN = 32 * 68, T_AOUT = 32 * 32, T_F1 = 32 * 88, T_F2 = 88 * 32, T_KV = 32 * 96, T_BQ = 32 * 48, T_BOUT = 16 * 32;
    constexpr int NITEMS = T_IN + T_AOUT + 2 * T_F1 + T_F2 + T_KV + T_BQ + T_BOUT;
    for (int it = gw; it < NITEMS; it += NGW) {
        int r = it;
        if (r < T_IN) { const int kb = r / 68, nb = r % 68; cvt_tile((const float*)A.in[8], A_IN, 64 * kb, 64 * nb, A_IN - 64 * nb, (bf16*)(F.ws + WS_WIN), (size_t)64 * nb, DM, F.lane); continue; } r -= T_IN;
        if (r < T_AOUT) { const int kb = r / 32, nb = r % 32; cvt_tile((const float*)A.in[9], DM, 64 * kb, 64 * nb, 64, (bf16*)(F.ws + WS_WAOUT), (size_t)64 * nb, DM, F.lane); continue; } r -= T_AOUT;
        if (r < T_F1) { const int kb = r / 88, nb = r % 88, n0 = 64 * nb; cvt_tile((const float*)A.in[20], DFF, 64 * kb, n0, 64, (bf16*)(F.ws + WS_WF13), (size_t)((n0 >> 7) * 256 + (n0 & 127)), DM, F.lane); continue; } r -= T_F1;
        if (r < T_F1) { const int kb = r / 88, nb = r % 88, n0 = 64 * nb; cvt_tile((const float*)A.in[21], DFF, 64 * kb, n0, 64, (bf16*)(F.ws + WS_WF13), (size_t)((n0 >> 7) * 256 + 128 + (n0 & 127)), DM, F.lane); continue; } r -= T_F1;
        if (r < T_F2) { const int kb = r / 32, nb = r % 32; cvt_tile((const float*)A.in[22], DM, 64 * kb, 64 * nb, 64, (bf16*)(F.ws + WS_WF2), (size_t)64 * nb, DFF, F.lane); continue; } r -= T_F2;
        if (r < T_KV) { const int kb = r / 96, nb = r % 96; cvt_tile((const float*)A.in[15], 6144, 64 * kb, 64 * nb, 64, (bf16*)(F.ws + WS_WKVQ), (size_t)64 * nb, DM, F.lane); continue; } r -= T_KV;
        if (r < T_BQ) { const int kb = r / 48, nb = r % 48; cvt_tile((const float*)A.in[17], 3072, 64 * kb, 64 * nb, 64, (bf16*)(F.ws + WS_WKVQ), (size_t)(6144 + 64 * nb), DM, F.lane); continue; } r -= T_BQ;
        { const int kb = r / 32, nb = r % 32; cvt_tile((const float*)A.in[18], DM, 64 * kb, 64 * nb, 64, (bf16*)(F.ws + WS_WBOUT), (size_t)64 * nb, 1024, F.lane); }
    }
}
constexpr int CV_TME = 3584, CV_TM = 8 * CV_TME, NT_MOE = 3 * CV_TM;
__device__ __forceinline__ void moe_tile_addr(Frame& F, const Args& A, int t, const float*& sp, int& N, bf16*& dp, int& Kd) {
    const int cl = F.lane & 15, kg = F.lane >> 4; int r = t;
    if (r < 2 * CV_TM) { const int up = r >= CV_TM ? 1 : 0; r -= up * CV_TM; const int e = r / CV_TME, rr = r % CV_TME, kb = rr / 112, nb = rr % 112, n0 = 64 * nb;
        N = DFFE; Kd = DM; sp = (const float*)A.in[25 + up] + (size_t)e * DM * DFFE + (size_t)(64 * kb + 16 * kg) * DFFE + n0 + 4 * cl;
        dp = (bf16*)(F.ws + WS_WM13) + ((size_t)e * 14336 + (n0 >> 7) * 256 + 128 * up + (n0 & 127) + 4 * cl) * DM + 64 * kb + 16 * kg; }
    else { r -= 2 * CV_TM; const int e = r / CV_TME, rr = r % CV_TME, kb = rr / 32, nb = rr % 32;
        N = DM; Kd = DFFE; sp = (const float*)A.in[27] + (size_t)e * DFFE * DM + (size_t)(64 * kb + 16 * kg) * DM + 64 * nb + 4 * cl;
        dp = (bf16*)(F.ws + WS_WM2) + ((size_t)e * 2048 + 64 * nb + 4 * cl) * DFFE + 64 * kb + 16 * kg; }
}
__device__ __forceinline__ void cvt_load(f32x4 (&v)[16], const float* __restrict__ sp, int N) {
#pragma unroll
    for (int i = 0; i < 16; ++i) v[i] = *(const f32x4*)(sp + (size_t)i * N);
}
__device__ __forceinline__ void cvt_store(const f32x4 (&v)[16], bf16* __restrict__ dp, int Kd) {
#pragma unroll
    for (int e = 0; e < 4; ++e) {
        v4u a, b;
        a.x = pk2(v[0][e], v[1][e]); a.y = pk2(v[2][e], v[3][e]); a.z = pk2(v[4][e], v[5][e]); a.w = pk2(v[6][e], v[7][e]);
        b.x = pk2(v[8][e], v[9][e]); b.y = pk2(v[10][e], v[11][e]); b.z = pk2(v[12][e], v[13][e]); b.w = pk2(v[14][e], v[15][e]);
        *(v4u*)(dp + (size_t)e * Kd) = a; *(v4u*)(dp + (size_t)e * Kd + 8) = b;
    }
}
__device__ __forceinline__ bool conv_stop(Frame& F, int k, int nmain) {
    if (F.wave == 0) { const unsigned v = (unsigned)__builtin_amdgcn_readfirstlane((int)__hip_atomic_load((unsigned*)(F.ctl + CW_DONE + 64 * k), RLX_AGENT)); if (v >= (unsigned)nmain && F.lane == 0) F.MISC[16] = (unsigned)(k + 1); }
    return F.MISC[16] == (unsigned)(k + 1);
}
__device__ __forceinline__ int conv_loop(Frame& F, const Args& A, int k, int nmain, int cur) {
    const int CV_STRIPES = F.G * NWAVES;
    f32x4 va[16], vb[16]; const float* sp; bf16* dpa; bf16* dpb; int N, Kda, Kdb;
    bool stop = conv_stop(F, k, nmain);
    if (stop || cur >= NT_MOE) return cur;
    moe_tile_addr(F, A, cur, sp, N, dpa, Kda); cvt_load(va, sp, N); cur += CV_STRIPES;
    for (;;) {
        stop = conv_stop(F, k, nmain);
        const bool haveB = !stop && cur < NT_MOE;
        if (haveB) { moe_tile_addr(F, A, cur, sp, N, dpb, Kdb); cvt_load(vb, sp, N); cur += CV_STRIPES; }
        cvt_store(va, dpa, Kda);
        if (!haveB) break;
        stop = conv_stop(F, k, nmain);
        const bool haveA = !stop && cur < NT_MOE;
        if (haveA) { moe_tile_addr(F, A, cur, sp, N, dpa, Kda); cvt_load(va, sp, N); cur += CV_STRIPES; }
        cvt_store(vb, dpb, Kdb);
        if (!haveA) break;
    }
    return cur;
}
__device__ __forceinline__ void conv_drain(Frame& F, const Args& A) {
    LAS int* curL = (LAS int*)F.lds;
    const int gw = F.bid * NWAVES + F.wave, NGW = F.G * NWAVES;
    __syncthreads();
    for (int j = F.tid; j < NGW; j += NWAVES * 64) curL[j] = (int)__hip_atomic_load((unsigned*)(F.ctl + CW_CUR + j), RLX_AGENT);
    __syncthreads();
    const int rows = (NT_MOE + NGW - 1) / NGW;
    for (int i = 0; i < rows; ++i) {
        const int j = (gw + 97 * i) % NGW, t = i * NGW + j;
        if (t >= NT_MOE || t < curL[j]) continue;
        const float* sp; bf16* dp; int N, Kd; f32x4 v[16];
        moe_tile_addr(F, A, t, sp, N, dp, Kd); cvt_load(v, sp, N); cvt_store(v, dp, Kd);
    }
    __syncthreads();
}
__device__ __forceinline__ void phase_done(Frame& F, int k) { __syncthreads(); if (F.tid == 0) __hip_atomic_fetch_add((unsigned*)(F.ctl + CW_DONE + 64 * k), 1u, RLX_AGENT); }

__device__ __forceinline__ float row_rstd(const f32x4 (&v)[8]) {
    float ss = 0.f;
#pragma unroll
    for (int j = 0; j < 8; ++j) ss += (v[j].x * v[j].x + v[j].y * v[j].y) + (v[j].z * v[j].z + v[j].w * v[j].w);
    return 1.0f / sqrtf(wave_sum(ss) * (1.0f / DM) + EPS);
}
__device__ __forceinline__ void modulate_store(const f32x4 (&v)[8], float rstd, const float* g, const float* sh, const float* sc, bf16* orow, int lane) {
#pragma unroll
    for (int j = 0; j < 8; ++j) { const int col = 4 * lane + 256 * j;
        const f32x4 gg = *(const f32x4*)(g + col), s1 = *(const f32x4*)(sc + col), s0 = *(const f32x4*)(sh + col);
        const f32x4 y = v[j] * rstd * gg * (s1 + 1.0f) + s0;
        v2u w; w.x = pk2(y.x, y.y); w.y = pk2(y.z, y.w); *(v2u*)(orow + col) = w; }
}
__device__ __forceinline__ void normmod_phase(Frame& F, const float* X, const float* g, const float* modsh, const float* modsc, bf16* out) {
    const int gw = F.bid * NWAVES + F.wave, NGW = F.G * NWAVES;
    for (int row = gw; row < MTOK; row += NGW) { const int b = row >> 11;
        f32x4 v[8]; const float* xr = X + (size_t)row * DM + 4 * F.lane;
#pragma unroll
        for (int j = 0; j < 8; ++j) v[j] = *(const f32x4*)(xr + 256 * j);
        const float rstd = row_rstd(v);
        modulate_store(v, rstd, g, modsh + (size_t)b * NMOD, modsc + (size_t)b * NMOD, out + (size_t)row * DM, F.lane); }
}

constexpr float NEG_S = -3.0e38f;
__device__ __forceinline__ void p3_qknorm(Frame& F, const Args& A) {
    const bf16* P0 = (const bf16*)(F.ws + WS_P0); bf16* QN = (bf16*)(F.ws + WS_QN); bf16* KN = (bf16*)(F.ws + WS_KN);
    const float* gq = (const float*)A.in[10]; const float* gk = (const float*)A.in[11];
    const int gw = F.bid * NWAVES + F.wave, NGW = F.G * NWAVES, li = F.lane & 15, g4 = F.lane >> 4;
    const float QS = 0.08838834764831845f * LOG2E;
    float gqv[8], gkv[8];
#pragma unroll
    for (int e = 0; e < 8; ++e) { gqv[e] = gq[8 * li + e] * QS; gkv[e] = gk[8 * li + e]; }
    for (int tok = gw; tok < MTOK; tok += NGW) {
        const bf16* pr = P0 + (size_t)tok * A_INP;
#pragma unroll
        for (int i = 0; i < 5; ++i) { const int head = 4 * i + g4;
            const v4u w = *(const v4u*)(pr + head * 128 + 8 * li);
            float x[8] = {bflo(w.x), bfhi(w.x), bflo(w.y), bfhi(w.y), bflo(w.z), bfhi(w.z), bflo(w.w), bfhi(w.w)};
            float ss = 0.f;
#pragma unroll
            for (int e = 0; e < 8; ++e) ss += x[e] * x[e];
            ss += __shfl_xor(ss, 8); ss += __shfl_xor(ss, 4); ss += __shfl_xor(ss, 2); ss += __shfl_xor(ss, 1);
            const float rstd = 1.0f / sqrtf(ss * (1.0f / 128.0f) + EPS);
            v4u o;
            if (i < 4) { o.x = pk2(x[0] * rstd * gqv[0], x[1] * rstd * gqv[1]); o.y = pk2(x[2] * rstd * gqv[2], x[3] * rstd * gqv[3]); o.z = pk2(x[4] * rstd * gqv[4], x[5] * rstd * gqv[5]); o.w = pk2(x[6] * rstd * gqv[6], x[7] * rstd * gqv[7]);
                *(v4u*)(QN + (size_t)tok * DM + head * 128 + 8 * li) = o; }
            else { o.x = pk2(x[0] * rstd * gkv[0], x[1] * rstd * gkv[1]); o.y = pk2(x[2] * rstd * gkv[2], x[3] * rstd * gkv[3]); o.z = pk2(x[4] * rstd * gkv[4], x[5] * rstd * gkv[5]); o.w = pk2(x[6] * rstd * gkv[6], x[7] * rstd * gkv[7]);
                *(v4u*)(KN + (size_t)tok * 512 + (head - 16) * 128 + 8 * li) = o; }
        }
    }
}
__device__ __forceinline__ void p3_vtrans(Frame& F) {
    const bf16* P0 = (const bf16*)(F.ws + WS_P0); bf16* VT = (bf16*)(F.ws + WS_VT);
    LAS unsigned* tile = (LAS unsigned*)F.lds;
    for (int item = F.bid; item < MTOK / 64; item += F.G) { const int tok0 = item * 64, b = tok0 >> 11, t0 = tok0 & 2047;
        __syncthreads();
#pragma unroll
        for (int p = 0; p < 8; ++p) { const int row = p * 8 + (F.tid >> 6), cw = (F.tid & 63) * 4;
            const v4u w = *(const v4u*)(P0 + (size_t)(tok0 + row) * A_INP + C_V + 2 * cw);
            tile[row * 257 + cw] = w.x; tile[row * 257 + cw + 1] = w.y; tile[row * 257 + cw + 2] = w.z; tile[row * 257 + cw + 3] = w.w; }
        __syncthreads();
#pragma unroll
        for (int p = 0; p < 8; ++p) { const int task = p * 512 + F.tid, tg = task & 7, col = task >> 3;
            const LAS unsigned short* tp = (const LAS unsigned short*)tile + col;
            unsigned short h[8];
#pragma unroll
            for (int i = 0; i < 8; ++i) h[i] = tp[(size_t)(tg * 8 + i) * 514];
            v4u o; o.x = h[0] | ((unsigned)h[1] << 16); o.y = h[2] | ((unsigned)h[3] << 16); o.z = h[4] | ((unsigned)h[5] << 16); o.w = h[6] | ((unsigned)h[7] << 16);
            *(v4u*)(VT + ((size_t)(b * 512 + col)) * SEQ + t0 + tg * 8) = o; }
    }
    __syncthreads();
}
__device__ __forceinline__ void p3_indexer_pair(Frame& F, int pair) {
    const bf16* P0 = (const bf16*)(F.ws + WS_P0); unsigned* MASK = (unsigned*)(F.ws + WS_MASK);
    const int b = pair >> 10, t0 = (pair & 1023) * 2, lane = F.lane, c = lane & 31, hh = lane >> 5;
    const bf16* Pb = P0 + (size_t)b * SEQ * A_INP;
    const int qsel = (c >> 2) & 1, ahead = (c & 3) + 4 * (c >> 3);
    const bf16* ap = Pb + (size_t)(t0 + qsel) * A_INP + C_QI + ahead * 64 + 8 * hh;
    bf16x8 af[4];
#pragma unroll
    for (int ks = 0; ks < 4; ++ks) af[ks] = *(const bf16x8*)(ap + 16 * ks);
    const bf16* wp = Pb + (size_t)(t0 + hh) * A_INP + C_WI;
    const v4u w0 = *(const v4u*)wp, w1 = *(const v4u*)(wp + 8);
    const float WS_ = 0.25f * 0.125f;
    const float wv[16] = {bflo(w0.x) * WS_, bfhi(w0.x) * WS_, bflo(w0.y) * WS_, bfhi(w0.y) * WS_, bflo(w0.z) * WS_, bfhi(w0.z) * WS_, bflo(w0.w) * WS_, bfhi(w0.w) * WS_,
                          bflo(w1.x) * WS_, bfhi(w1.x) * WS_, bflo(w1.y) * WS_, bfhi(w1.y) * WS_, bflo(w1.z) * WS_, bfhi(w1.z) * WS_, bflo(w1.w) * WS_, bfhi(w1.w) * WS_};
    const int tq = t0 + hh, ktmax = (t0 + 1) >> 5;
    LAS float* scL = (LAS float*)(F.lds + F.wave * 16384) + lane;
    for (int kg = 0; 4 * kg <= ktmax; ++kg) {
        bf16x8 bfr[4][4];
        const bf16* bp = Pb + (size_t)(128 * kg + c) * A_INP + C_KI + 8 * hh;
#pragma unroll
        for (int u = 0; u < 4; ++u)
#pragma unroll
            for (int ks = 0; ks < 4; ++ks) bfr[u][ks] = *(const bf16x8*)(bp + (size_t)(32 * u) * A_INP + 16 * ks);
#pragma unroll
        for (int u = 0; u < 4; ++u) { f32x16 d;
#pragma unroll
            for (int t = 0; t < 16; ++t) d[t] = 0.f;
#pragma unroll
            for (int ks = 0; ks < 4; ++ks) d = MFMA32(af[ks], bfr[u][ks], d);
            float s = 0.f;
#pragma unroll
            for (int t = 0; t < 16; ++t) s += fmaxf(d[t], 0.f) * wv[t];
            scL[(4 * kg + u) * 64] = (32 * (4 * kg + u) + c <= tq) ? s : NEG_S; }
    }
    LDS_WAIT();
    float sc[64];
#pragma unroll
    for (int k = 0; k < 64; ++k) { const float v = scL[k * 64]; sc[k] = (k <= ktmax) ? v : NEG_S; }
    LDS_WAIT();
    float mx = NEG_S, mn = 3.0e38f;
#pragma unroll
    for (int k = 0; k < 64; ++k) { mx = fmaxf(mx, sc[k]); mn = (sc[k] > -1.0e38f) ? fminf(mn, sc[k]) : mn; }
#pragma unroll
    for (int o = 16; o >= 1; o >>= 1) { mx = fmaxf(mx, __shfl_xor(mx, o)); mn = fminf(mn, __shfl_xor(mn, o)); }
    bool done = (tq + 1 <= 256); float lo = mn, hi = mx, thr = done ? -1.0e38f : mn;
    for (int it = 0; it < 48; ++it) {
        if (__all(done)) break;
        const float mid = 0.5f * (lo + hi);
        int cnt = 0;
#pragma unroll
        for (int k = 0; k < 64; ++k) cnt += (sc[k] >= mid) ? 1 : 0;
#pragma unroll
        for (int o = 16; o >= 1; o >>= 1) cnt += __shfl_xor(cnt, o);
        if (!done) {
            if (!(mid > lo) || !(mid < hi)) { done = true; thr = lo; }
            else if (cnt >= 256) { lo = mid; thr = mid; done = (cnt == 256); }
            else hi = mid;
        }
    }
    unsigned wA = 0u, wB = 0u;
#pragma unroll
    for (int k = 0; k < 64; ++k) { const unsigned long long bal = __ballot(sc[k] >= thr); if (lane == k) { wA = (unsigned)bal; wB = (unsigned)(bal >> 32); } }
    MASK[((size_t)b * SEQ + t0) * 64 + lane] = wA; MASK[((size_t)b * SEQ + t0 + 1) * 64 + lane] = wB;
}

__device__ __forceinline__ int kperm(int r) { return (r & ~12) | ((r & 4) << 1) | ((r & 8) >> 1); }
constexpr int P4_TAB = 0, P4_POS = 32768, P4_MASK = 40960, P4_MPITCH = 65, P4_K = 57600, P4_V = P4_K + 16384, P4_END = P4_V + 16384;
static_assert(P4_MASK + 64 * P4_MPITCH * 4 <= P4_K && P4_END <= RING_BYTES, "P4 LDS map");
__device__ __forceinline__ void p4_attn_item(Frame& F, const Args& A, int item) {
    const bf16* QN = (const bf16*)(F.ws + WS_QN); const bf16* KN = (const bf16*)(F.ws + WS_KN); const bf16* VT = (const bf16*)(F.ws + WS_VT);
    const unsigned* MASK = (const unsigned*)(F.ws + WS_MASK); const float* BT = (const float*)(F.ws + WS_BT); bf16* OB = (bf16*)(F.ws + WS_O);
    const int* pos = (const int*)A.in[2];
    const int qt = item >> 4, bk = item & 15, b = bk >> 2, kvh = bk & 3;
    LAS float* tab = (LAS float*)(F.lds + P4_TAB); LAS int* posL = (LAS int*)(F.lds + P4_POS); LAS unsigned* maskL = (LAS unsigned*)(F.lds + P4_MASK);
    const int w = F.wave, hd = w & 3, head = kvh * 4 + hd, qw0 = qt * 64 + 32 * (w >> 2), lane = F.lane, c = lane & 31, hh = lane >> 5;
    const size_t tokq = (size_t)b * SEQ + qw0 + c;
    __syncthreads();
    for (int i = F.tid; i < 4 * 2048; i += NWAVES * 64) tab[i] = BT[kvh * 4 * 2048 + i];
    for (int i = F.tid; i < SEQ; i += NWAVES * 64) posL[i] = pos[b * SEQ + i];
    for (int i = F.tid; i < 64 * 64; i += NWAVES * 64) maskL[(i >> 6) * P4_MPITCH + (i & 63)] = MASK[((size_t)b * SEQ + qt * 64 + (i >> 6)) * 64 + (i & 63)];
    const bf16* qp = QN + tokq * DM + head * 128 + 8 * hh;
    bf16x8 qf[8];
#pragma unroll
    for (int ks = 0; ks < 8; ++ks) qf[ks] = *(const bf16x8*)(qp + 16 * ks);
    __syncthreads();
    const int krow = 4 * w + (lane >> 4), kch = (lane & 15) ^ (krow & 15);
    const bf16* kg = KN + ((size_t)b * SEQ + krow) * 512 + kvh * 128 + 8 * kch;
    const int vd = 16 * w + (lane >> 2), vch = (lane & 3) ^ ((vd >> 2) & 3);
    const bf16* vg = VT + ((size_t)(b * 4 + kvh) * 128 + vd) * SEQ + 8 * vch;
    LAS unsigned char* kdst = F.lds + P4_K + 1024 * w; LAS unsigned char* vdst = F.lds + P4_V + 1024 * w;
#define P4_DMA(kt_) do { const int sl_ = ((kt_) & 1) * 8192; \
        __builtin_amdgcn_global_load_lds((const unsigned*)(kg + (size_t)(kt_) * 32 * 512), (LAS unsigned*)(kdst + sl_), 16, 0, 0); \
        __builtin_amdgcn_global_load_lds((const unsigned*)(vg + (kt_) * 32), (LAS unsigned*)(vdst + sl_), 16, 0, 0); } while (0)
    const int pq = posL[qw0 + c];
    const LAS float* tb = tab + hd * 2048;
    const LAS unsigned* mrow = maskL + (32 * (w >> 2) + c) * P4_MPITCH;
    f32x16 O[4];
#pragma unroll
    for (int db = 0; db < 4; ++db)
#pragma unroll
        for (int t = 0; t < 16; ++t) O[db][t] = 0.f;
    float m = -1.0e29f, l = 0.f;
    const int ktmax = (qw0 + 31) >> 5, nkt = 2 * qt + 2;
    const int prow = kperm(c);
    const LAS unsigned char* kfrag = F.lds + P4_K + prow * 256;
    const LAS unsigned char* vfrag = F.lds + P4_V + c * 64;
    P4_DMA(0);
    asm volatile("s_waitcnt vmcnt(0)" ::: "memory"); __builtin_amdgcn_s_barrier(); asm volatile("" ::: "memory");
    for (int kt = 0; kt < nkt; ++kt) {
        const int sl = (kt & 1) * 8192;
        if (kt + 1 < nkt) P4_DMA(kt + 1);
        if (kt <= ktmax) {
            const int key0 = kt * 32;
            f32x16 S;
#pragma unroll
            for (int t = 0; t < 16; ++t) S[t] = 0.f;
#pragma unroll
            for (int ks = 0; ks < 8; ++ks) { const bf16x8 kf = *(const LAS bf16x8*)(kfrag + sl + (((2 * ks + hh) ^ (prow & 15)) << 4)); S = MFMA32(kf, qf[ks], S); }
            const unsigned mw = mrow[kt] >> (8 * hh);
            const i32x4 p0 = *(const LAS i32x4*)(posL + key0 + 8 * hh), p1 = *(const LAS i32x4*)(posL + key0 + 8 * hh + 4), p2 = *(const LAS i32x4*)(posL + key0 + 16 + 8 * hh), p3 = *(const LAS i32x4*)(posL + key0 + 16 + 8 * hh + 4);
            const int pk[16] = {p0.x, p0.y, p0.z, p0.w, p1.x, p1.y, p1.z, p1.w, p2.x, p2.y, p2.z, p2.w, p3.x, p3.y, p3.z, p3.w};
            float s[16]; float mx = -1.0e29f;
#pragma unroll
            for (int t = 0; t < 16; ++t) { const int bit = (t & 7) + 16 * (t >> 3);
                int idx = pq - pk[t]; idx = idx < 0 ? 0 : (idx > 2047 ? 2047 : idx);
                const float v = S[t] + tb[idx];
                s[t] = ((mw >> bit) & 1u) ? v : -1.0e30f; mx = fmaxf(mx, s[t]); }
            mx = fmaxf(mx, __shfl_xor(mx, 32));
            const float mnew = fmaxf(m, mx);
            float p[16]; float ls = 0.f;
#pragma unroll
            for (int t = 0; t < 16; ++t) { p[t] = __builtin_amdgcn_exp2f(s[t] - mnew); ls += p[t]; }
            if (!__all(mnew == m)) {
                const float alpha = __builtin_amdgcn_exp2f(m - mnew); l *= alpha;
#pragma unroll
                for (int db = 0; db < 4; ++db)
#pragma unroll
                    for (int t = 0; t < 16; ++t) O[db][t] *= alpha;
            }
            l += ls; m = mnew;
            const bf16x8 pf0 = pack8(p[0], p[1], p[2], p[3], p[4], p[5], p[6], p[7]), pf1 = pack8(p[8], p[9], p[10], p[11], p[12], p[13], p[14], p[15]);
            const int vsw = (c >> 2) & 3;
#pragma unroll
            for (int db = 0; db < 4; ++db) {
                const bf16x8 v0 = *(const LAS bf16x8*)(vfrag + sl + 32 * 64 * db + (((0 + hh) ^ vsw) << 4)), v1 = *(const LAS bf16x8*)(vfrag + sl + 32 * 64 * db + (((2 + hh) ^ vsw) << 4));
                O[db] = MFMA32(v0, pf0, O[db]); O[db] = MFMA32(v1, pf1, O[db]); }
        }
        asm volatile("s_waitcnt vmcnt(0) lgkmcnt(0)" ::: "memory"); __builtin_amdgcn_s_barrier(); asm volatile("" ::: "memory");
    }
#undef P4_DMA
    l += __shfl_xor(l, 32);
    const float inv = 1.0f / l;
    bf16* op = OB + tokq * DM + head * 128 + 4 * hh;
#pragma unroll
    for (int db = 0; db < 4; ++db)
#pragma unroll
        for (int g = 0; g < 4; ++g) { v2u w2; w2.x = pk2(O[db][4 * g] * inv, O[db][4 * g + 1] * inv); w2.y = pk2(O[db][4 * g + 2] * inv, O[db][4 * g + 3] * inv); *(v2u*)(op + 32 * db + 8 * g) = w2; }
}

__device__ __forceinline__ void p11_qknorm(Frame& F, const Args& A) {
    const bf16* KV = (const bf16*)(F.ws + WS_KV); const bf16* Q1 = (const bf16*)(F.ws + WS_Q1); bf16* K1N = (bf16*)(F.ws + WS_K1N); bf16* Q1N = (bf16*)(F.ws + WS_Q1N);
    const float* gk = (const float*)A.in[16]; const float* gq = (const float*)A.in[19];
    const int gw = F.bid * NWAVES + F.wave, NGW = F.G * NWAVES, li = F.lane & 7, g8 = F.lane >> 3;
    const float QS = 0.125f * LOG2E;
    float gqv[8], gkv[8];
#pragma unroll
    for (int e = 0; e < 8; ++e) { gqv[e] = gq[8 * li + e] * QS; gkv[e] = gk[8 * li + e]; }
    for (int tok = gw; tok < MTOK; tok += NGW) {
#pragma unroll
        for (int i = 0; i < 12; ++i) { const int head = 8 * (i % 6) + g8; const bool isq = i < 6;
            const bf16* src = isq ? Q1 + (size_t)tok * 3072 : KV + (size_t)tok * 6144;
            const v4u w = *(const v4u*)(src + head * 64 + 8 * li);
            float x[8] = {bflo(w.x), bfhi(w.x), bflo(w.y), bfhi(w.y), bflo(w.z), bfhi(w.z), bflo(w.w), bfhi(w.w)};
            float ss = 0.f;
#pragma unroll
            for (int e = 0; e < 8; ++e) ss += x[e] * x[e];
            ss += __shfl_xor(ss, 4); ss += __shfl_xor(ss, 2); ss += __shfl_xor(ss, 1);
            const float rstd = 1.0f / sqrtf(ss * (1.0f / 64.0f) + EPS);
            v4u o;
            if (isq) { o.x = pk2(x[0] * rstd * gqv[0], x[1] * rstd * gqv[1]); o.y = pk2(x[2] * rstd * gqv[2], x[3] * rstd * gqv[3]); o.z = pk2(x[4] * rstd * gqv[4], x[5] * rstd * gqv[5]); o.w = pk2(x[6] * rstd * gqv[6], x[7] * rstd * gqv[7]);
                *(v4u*)(Q1N + (size_t)tok * 3072 + head * 64 + 8 * li) = o; }
            else { o.x = pk2(x[0] * rstd * gkv[0], x[1] * rstd * gkv[1]); o.y = pk2(x[2] * rstd * gkv[2], x[3] * rstd * gkv[3]); o.z = pk2(x[4] * rstd * gkv[4], x[5] * rstd * gkv[5]); o.w = pk2(x[6] * rstd * gkv[6], x[7] * rstd * gkv[7]);
                *(v4u*)(K1N + (size_t)tok * 3072 + head * 64 + 8 * li) = o; }
        }
    }
}
__device__ __forceinline__ void p11_vtrans(Frame& F) {
    const bf16* KV = (const bf16*)(F.ws + WS_KV); bf16* VT1 = (bf16*)(F.ws + WS_VT1);
    LAS unsigned* tile = (LAS unsigned*)F.lds;
    for (int item = F.bid; item < NB * 3 * 16 * 4; item += F.G) {
        const int cg = item & 3, ch = (item >> 2) & 15, bg = item >> 6, g = bg % 3, b = bg / 3, t0 = ch * 128, lr = 2 * g, r = 1 << lr, nsub = SEQ >> lr;
        __syncthreads();
#pragma unroll
        for (int p = 0; p < 8; ++p) { const int row = p * 16 + (F.tid >> 5), cw = (F.tid & 31) * 4;
            const v4u w = *(const v4u*)(KV + (size_t)(b * SEQ + t0 + row) * 6144 + 3072 + g * 1024 + cg * 256 + 2 * cw);
            tile[row * 129 + cw] = w.x; tile[row * 129 + cw + 1] = w.y; tile[row * 129 + cw + 2] = w.z; tile[row * 129 + cw + 3] = w.w; }
        __syncthreads();
#pragma unroll
        for (int p = 0; p < 8; ++p) { const int task = p * 512 + F.tid, q = task & 15, col = task >> 4;
            const int rho = q & (r - 1), run = q >> lr;
            const LAS unsigned short* tp = (const LAS unsigned short*)tile + col;
            unsigned short h[8];
#pragma unroll
            for (int i = 0; i < 8; ++i) h[i] = tp[(size_t)(((8 * run + i) << lr) + rho) * 258];
            v4u o; o.x = h[0] | ((unsigned)h[1] << 16); o.y = h[2] | ((unsigned)h[3] << 16); o.z = h[4] | ((unsigned)h[5] << 16); o.w = h[6] | ((unsigned)h[7] << 16);
            *(v4u*)(VT1 + ((size_t)((b * 3 + g) * 1024 + cg * 256 + col)) * SEQ + rho * nsub + (t0 >> lr) + 8 * run) = o; }
    }
    __syncthreads();
}
__device__ __forceinline__ void p12_attn_item(Frame& F, const Args& A, int item) {
    const bf16* Q1N = (const bf16*)(F.ws + WS_Q1N); const bf16* K1N = (const bf16*)(F.ws + WS_K1N); const bf16* VT1 = (const bf16*)(F.ws + WS_VT1);
    const float* BT = (const float*)(F.ws + WS_BT); bf16* OG = (bf16*)(F.ws + WS_OG); float* LSE = (float*)(F.ws + WS_LSE);
    const int* pos = (const int*)A.in[2];
    const int jb = item & 7, head = (item >> 3) & 15, bg = item >> 7, g = bg % 3, b = bg / 3, lr = 2 * g, nsub = SEQ >> lr, tps = nsub >> 5;
    LAS float* tab = (LAS float*)F.lds; LAS int* posL = (LAS int*)(F.lds + 8192);
    __syncthreads();
    for (int i = F.tid; i < 2048; i += NWAVES * 64) { tab[i] = BT[head * 2048 + i]; posL[i] = pos[b * SEQ + i]; }
    __syncthreads();
    const int j = 8 * jb + F.wave, rho = j / tps, n0 = 32 * (j % tps), lane = F.lane, c = lane & 31, hh = lane >> 5;
    const int tq = ((n0 + c) << lr) + rho;
    const size_t tokq = (size_t)b * SEQ + tq;
    const bf16* qp = Q1N + tokq * 3072 + g * 1024 + head * 64 + 8 * hh;
    bf16x8 qf[4];
#pragma unroll
    for (int ks = 0; ks < 4; ++ks) qf[ks] = *(const bf16x8*)(qp + 16 * ks);
    const int pq = posL[tq];
    f32x16 O[2];
#pragma unroll
    for (int db = 0; db < 2; ++db)
#pragma unroll
        for (int t = 0; t < 16; ++t) O[db][t] = 0.f;
    float m = -1.0e30f, l = 0.f;
    const bf16* kcol = K1N + (size_t)b * SEQ * 3072 + g * 1024 + head * 64 + 8 * hh;
    const bf16* vbase = VT1 + ((size_t)((b * 3 + g) * 1024 + head * 64 + c)) * SEQ + rho * nsub + 8 * hh;
    const int pc = kperm(c);
    for (int kb = n0 - 128; kb <= n0; kb += 32) {
        if (kb < 0) continue;
        const bf16* kp = kcol + (size_t)(((kb + pc) << lr) + rho) * 3072;
        bf16x8 kf[4];
#pragma unroll
        for (int ks = 0; ks < 4; ++ks) kf[ks] = *(const bf16x8*)(kp + 16 * ks);
        f32x16 S;
#pragma unroll
        for (int t = 0; t < 16; ++t) S[t] = 0.f;
#pragma unroll
        for (int ks = 0; ks < 4; ++ks) S = MFMA32(kf[ks], qf[ks], S);
        float s[16]; float mx = -1.0e30f;
        const int nq = n0 + c;
#pragma unroll
        for (int t = 0; t < 16; ++t) { const int nk = kb + (t & 7) + 8 * hh + 16 * (t >> 3);
            int idx = pq - posL[(nk << lr) + rho]; idx = idx < 0 ? 0 : (idx > 2047 ? 2047 : idx);
            const float v = S[t] + tab[idx];
            s[t] = (nk <= nq && nk >= nq - 128) ? v : -1.0e30f; mx = fmaxf(mx, s[t]); }
        mx = fmaxf(mx, __shfl_xor(mx, 32));
        const float mnew = fmaxf(m, mx), alpha = __builtin_amdgcn_exp2f(m - mnew);
        float p[16]; float ls = 0.f;
#pragma unroll
        for (int t = 0; t < 16; ++t) { p[t] = (s[t] > -1.0e29f) ? __builtin_amdgcn_exp2f(s[t] - mnew) : 0.f; ls += p[t]; }
        l = l * alpha + ls; m = mnew;
#pragma unroll
        for (int db = 0; db < 2; ++db)
#pragma unroll
            for (int t = 0; t < 16; ++t) O[db][t] *= alpha;
        const bf16x8 pf0 = pack8(p[0], p[1], p[2], p[3], p[4], p[5], p[6], p[7]), pf1 = pack8(p[8], p[9], p[10], p[11], p[12], p[13], p[14], p[15]);
#pragma unroll
        for (int db = 0; db < 2; ++db) {
            const bf16x8 v0 = *(const bf16x8*)(vbase + (size_t)(32 * db) * SEQ + kb), v1 = *(const bf16x8*)(vbase + (size_t)(32 * db) * SEQ + kb + 16);
            O[db] = MFMA32(v0, pf0, O[db]); O[db] = MFMA32(v1, pf1, O[db]); }
    }
    l += __shfl_xor(l, 32);
    const float inv = 1.0f / l;
    bf16* op = OG + tokq * 3072 + g * 1024 + head * 64 + 4 * hh;
#pragma unroll
    for (int db = 0; db < 2; ++db)
#pragma unroll
        for (int gg = 0; gg < 4; ++gg) { v2u w2; w2.x = pk2(O[db][4 * gg] * inv, O[db][4 * gg + 1] * inv); w2.y = pk2(O[db][4 * gg + 2] * inv, O[db][4 * gg + 3] * inv); *(v2u*)(op + 32 * db + 8 * gg) = w2; }
    if (hh == 0) LSE[tokq * 48 + g * 16 + head] = m + __builtin_amdgcn_logf(l);
}
__device__ __forceinline__ void p13_merge(Frame& F) {
    const bf16* OG = (const bf16*)(F.ws + WS_OG); const float* LSE = (const float*)(F.ws + WS_LSE); bf16* O1 = (bf16*)(F.ws + WS_O1);
    const int gt = F.bid * (NWAVES * 64) + F.tid, NT = F.G * NWAVES * 64;
    for (int i = gt; i < MTOK * 128; i += NT) { const int tok = i >> 7, c8 = i & 127, head = c8 >> 3;
        const float l0 = LSE[(size_t)tok * 48 + head], l1 = LSE[(size_t)tok * 48 + 16 + head], l2 = LSE[(size_t)tok * 48 + 32 + head];
        const float mm = fmaxf(l0, fmaxf(l1, l2)); float w0 = __builtin_amdgcn_exp2f(l0 - mm), w1 = __builtin_amdgcn_exp2f(l1 - mm), w2 = __builtin_amdgcn_exp2f(l2 - mm);
        const float inv = 1.0f / (w0 + w1 + w2); w0 *= inv; w1 *= inv; w2 *= inv;
        const v4u a = *(const v4u*)(OG + (size_t)tok * 3072 + c8 * 8), bb = *(const v4u*)(OG + (size_t)tok * 3072 + 1024 + c8 * 8), cc = *(const v4u*)(OG + (size_t)tok * 3072 + 2048 + c8 * 8);
        v4u o;
        o.x = pk2(w0 * bflo(a.x) + w1 * bflo(bb.x) + w2 * bflo(cc.x), w0 * bfhi(a.x) + w1 * bfhi(bb.x) + w2 * bfhi(cc.x));
        o.y = pk2(w0 * bflo(a.y) + w1 * bflo(bb.y) + w2 * bflo(cc.y), w0 * bfhi(a.y) + w1 * bfhi(bb.y) + w2 * bfhi(cc.y));
        o.z = pk2(w0 * bflo(a.z) + w1 * bflo(bb.z) + w2 * bflo(cc.z), w0 * bfhi(a.z) + w1 * bfhi(bb.z) + w2 * bfhi(cc.z));
        o.w = pk2(w0 * bflo(a.w) + w1 * bflo(bb.w) + w2 * bflo(cc.w), w0 * bfhi(a.w) + w1 * bfhi(bb.w) + w2 * bfhi(cc.w));
        *(v4u*)(O1 + (size_t)tok * 1024 + c8 * 8) = o; }
}

__device__ __forceinline__ void p15_norm_route(Frame& F, const Args& A) {
    const float* X = A.out; const float* MOD = (const float*)(F.ws + WS_MOD); bf16* HA = (bf16*)(F.ws + WS_HA);
    const float* g = (const float*)A.in[7] + DM; const float* router = (const float*)A.in[23]; const float* rb = (const float*)A.in[24];
    int* r_exp = (int*)(F.ws + WS_ROUTE); int* r_pos = r_exp + 2 * MTOK; float* r_gate = (float*)(r_pos + 2 * MTOK);
    LAS float* RT = (LAS float*)F.lds;
    __syncthreads();
    for (int i = F.tid; i < DM * NEXP; i += NWAVES * 64) RT[(i & 7) * DM + (i >> 3)] = router[i];
    __syncthreads();
    const int gw = F.bid * NWAVES + F.wave, NGW = F.G * NWAVES;
    for (int row = gw; row < MTOK; row += NGW) { const int b = row >> 11;
        f32x4 v[8]; const float* xr = X + (size_t)row * DM + 4 * F.lane;
#pragma unroll
        for (int j = 0; j < 8; ++j) v[j] = *(const f32x4*)(xr + 256 * j);
        const float rstd = row_rstd(v);
        const float* sh = MOD + (size_t)b * NMOD + 12288 + 6144; const float* sc = MOD + (size_t)b * NMOD + 12288 + 8192;
        float lg[8];
#pragma unroll
        for (int e = 0; e < 8; ++e) lg[e] = 0.f;
        bf16* orow = HA + (size_t)row * DM;
#pragma unroll
        for (int j = 0; j < 8; ++j) { const int col = 4 * F.lane + 256 * j;
            const f32x4 gg = *(const f32x4*)(g + col), s1 = *(const f32x4*)(sc + col), s0 = *(const f32x4*)(sh + col);
            const f32x4 y = v[j] * rstd * gg * (s1 + 1.0f) + s0;
            v2u w; w.x = pk2(y.x, y.y); w.y = pk2(y.z, y.w); *(v2u*)(orow + col) = w;
#pragma unroll
            for (int e = 0; e < 8; ++e) { const f32x4 rr = *(const LAS f32x4*)(RT + e * DM + col); lg[e] += (y.x * rr.x + y.y * rr.y) + (y.z * rr.z + y.w * rr.w); }
            asm volatile("" ::: "memory"); }
#pragma unroll
        for (int e = 0; e < 8; ++e) lg[e] = wave_sum(lg[e]) + rb[e];
        int e0 = 0; float v0 = lg[0];
#pragma unroll
        for (int e = 1; e < 8; ++e) if (lg[e] > v0) { v0 = lg[e]; e0 = e; }
        int e1 = -1; float v1 = -3.0e38f;
#pragma unroll
        for (int e = 0; e < 8; ++e) if (e != e0 && lg[e] > v1) { v1 = lg[e]; e1 = e; }
        const float g1 = 1.0f / (1.0f + __expf(v0 - v1)), g0 = 1.0f - g1;
        if (F.lane == 0) {
            const unsigned p0 = __hip_atomic_fetch_add((unsigned*)(F.ctl + CW_CNT + 64 * e0), 1u, RLX_AGENT);
            const unsigned p1 = __hip_atomic_fetch_add((unsigned*)(F.ctl + CW_CNT + 64 * e1), 1u, RLX_AGENT);
            r_exp[2 * row] = e0; r_exp[2 * row + 1] = e1; r_pos[2 * row] = (int)p0; r_pos[2 * row + 1] = (int)p1; r_gate[2 * row] = g0; r_gate[2 * row + 1] = g1;
        }
    }
}
__device__ __forceinline__ void moe_offsets(Frame& F, int (&off)[9]) {
    off[0] = 0;
#pragma unroll
    for (int e = 0; e < 8; ++e) { const unsigned cnt = __hip_atomic_load((unsigned*)(F.ctl + CW_CNT + 64 * e), RLX_AGENT); off[e + 1] = off[e] + (int)((cnt + 255u) & ~255u); }
}
__device__ __forceinline__ void p16_gather(Frame& F) {
    const bf16* HA = (const bf16*)(F.ws + WS_HA); bf16* AS = (bf16*)(F.ws + WS_AS); float* RG = (float*)(F.ws + WS_RG); int* TR = (int*)(F.ws + WS_TR);
    const int* r_exp = (const int*)(F.ws + WS_ROUTE); const int* r_pos = r_exp + 2 * MTOK; const float* r_gate = (const float*)(r_pos + 2 * MTOK);
    int off[9]; moe_offsets(F, off);
    const int gw = F.bid * NWAVES + F.wave, NGW = F.G * NWAVES;
    for (int idx = gw; idx < 2 * MTOK; idx += NGW) {
        const int e = r_exp[idx], p = r_pos[idx]; int base = 0;
#pragma unroll
        for (int k = 1; k < 8; ++k) base = (e >= k) ? off[k] : base;
        const int row = base + p, tok = idx >> 1;
        const v4u* src = (const v4u*)(HA + (size_t)tok * DM) + F.lane; v4u* dst = (v4u*)(AS + (size_t)row * DM) + F.lane;
        const v4u a = src[0], b2 = src[64], c2 = src[128], d2 = src[192];
        dst[0] = a; dst[64] = b2; dst[128] = c2; dst[192] = d2;
        if (F.lane == 0) { RG[row] = r_gate[idx]; TR[idx] = row; }
    }
}
__device__ __forceinline__ void p19_final(Frame& F, const Args& A) {
    float* X = A.out; const float* MOD = (const float*)(F.ws + WS_MOD); const float* Y = (const float*)(F.ws + WS_Y); const int* TR = (const int*)(F.ws + WS_TR);
    const int gw = F.bid * NWAVES + F.wave, NGW = F.G * NWAVES;
    for (int row = gw; row < MTOK; row += NGW) { const int b = row >> 11; const int r0 = TR[2 * row], r1 = TR[2 * row + 1];
        const float* gt = MOD + (size_t)b * NMOD + 12288 + 10240;
        float* xr = X + (size_t)row * DM + 4 * F.lane; const float* y0 = Y + (size_t)r0 * DM + 4 * F.lane; const float* y1 = Y + (size_t)r1 * DM + 4 * F.lane;
        constexpr size_t PS = (WS_Y2 - WS_Y) / 4;
#pragma unroll
        for (int j = 0; j < 8; ++j) { const f32x4 xv = *(const f32x4*)(xr + 256 * j), a = *(const f32x4*)(y0 + 256 * j), c2 = *(const f32x4*)(y1 + 256 * j), a2 = *(const f32x4*)(y0 + PS + 256 * j), c3 = *(const f32x4*)(y1 + PS + 256 * j),
                gg = *(const f32x4*)(gt + 4 * F.lane + 256 * j);
            *(f32x4*)(xr + 256 * j) = xv + gg * ((a + a2) + (c2 + c3)); }
    }
}

constexpr int N_PHASES = 20;
__global__ void __launch_bounds__(NWAVES * 64, 2) yoco_fwd(Args args) {
    extern __shared__ __attribute__((aligned(16))) unsigned char lds[];
    Frame F;
    F.lds = (LAS unsigned char*)lds; F.MISC = (volatile LAS unsigned*)(F.lds + MISC_OFF);
    F.tid = threadIdx.x; F.lane = F.tid & 63; F.wave = __builtin_amdgcn_readfirstlane(F.tid >> 6); F.G = gridDim.x; F.bid = blockIdx.x;
    F.ws = args.ws; F.ctl = (gu32*)(args.ws + WS_CTL);
    for (int u = F.tid; u < (LDS_BYTES - LDSCTL_OFF) / 4; u += NWAVES * 64) ((LAS unsigned*)(F.lds + LDSCTL_OFF))[u] = 0u;
    __syncthreads();
    const int lo = args.ph_lo, hi = args.ph_hi;
    const bool one_launch = (hi - lo) > 1;
    XcdBarrier bar; bar.bar = (unsigned*)(F.ctl + CW_BAR); bar.x = 0; bar.st = nullptr;
    if (one_launch) bar = xcd_barrier_post((unsigned*)(F.ctl + CW_BAR), F.MISC + 8);
    int cv_cur = F.bid * NWAVES + F.wave;
#define IN(k) (lo <= (k) && (k) < hi)
#define SEAM(k) do { if (IN(k) && IN((k) + 1)) xcd_barrier(bar); } while (0)
#define TAIL_FILL(k, nunits) do { if (one_launch) { const int nu_ = (nunits), rounds_ = (nu_ + F.G - 1) / F.G, nlast_ = nu_ - (rounds_ - 1) * F.G; \
        if (nlast_ < F.G) { if (F.bid >= nlast_) cv_cur = conv_loop(F, args, (k), nlast_, cv_cur); else phase_done(F, (k)); } } } while (0)
#define CONV_BEGIN(k) if (IN(k)) {
#define CONV_END(k)   }
    const float* const MODc = (const float*)(F.ws + WS_MOD);
    bf16* const HA = (bf16*)(F.ws + WS_HA);

    if (IN(0)) { p0_prologue(F, args); } SEAM(0);
    CONV_BEGIN(1) normmod_phase(F, (const float*)args.in[0], (const float*)args.in[6], MODc + 0, MODc + 2048, HA); CONV_END(1) SEAM(1);
    CONV_BEGIN(2) pg8::Gemm g{HA, (const bf16*)(F.ws + WS_WIN), MTOK, A_INP, DM, DM}; pg8::StaticOrder S; S.init(MTOK, A_INP, F.G, F.bid);
        pg8::EpiBf16Sel E{(bf16*)(F.ws + WS_P0), A_INP, nullptr, 0, 0, 1 << 30};
        pg8::gemm_phase<pg8::EpiBf16Sel, pg8::StaticOrder, true, true>(F.lds + RING_OFF, g, S, E); TAIL_FILL(2, S.nwg); CONV_END(2) SEAM(2);
    CONV_BEGIN(3) p3_qknorm(F, args); p3_vtrans(F);
        { const int gw = F.bid * NWAVES + F.wave, NGW = F.G * NWAVES;
          for (int q = gw; q < MTOK / 4; q += NGW) {
            const int s0 = q, s1 = MTOK / 2 - 1 - q;
            p3_indexer_pair(F, (s0 & 3) * 1024 + (s0 >> 2)); p3_indexer_pair(F, (s1 & 3) * 1024 + (s1 >> 2)); } } CONV_END(3) SEAM(3);
    CONV_BEGIN(4) for (int r = 0, base = 0; base < 512; ++r, base += F.G) { const int i = base + ((r & 1) ? F.G - 1 - F.bid : F.bid); if (i < 512) p4_attn_item(F, args, ((31 - (i >> 4)) << 4) | (i & 15)); } __syncthreads(); CONV_END(4) SEAM(4);
    if (IN(5)) { pg8::Gemm g{(const bf16*)(F.ws + WS_O), (const bf16*)(F.ws + WS_WAOUT), MTOK, DM, DM, DM}; pg8::StaticOrder S; S.init(MTOK, DM, F.G, F.bid);
        pg8::EpiResGate E{(const float*)args.in[0], args.out, MODc + 4096, NMOD};
        pg8::gemm_phase<pg8::EpiResGate, pg8::StaticOrder, false, true>(F.lds + RING_OFF, g, S, E); } SEAM(5);
    CONV_BEGIN(6) normmod_phase(F, args.out, (const float*)args.in[7], MODc + 6144, MODc + 8192, HA); CONV_END(6) SEAM(6);
    CONV_BEGIN(7) pg8::Gemm g{HA, (const bf16*)(F.ws + WS_WF13), MTOK, 2 * DFF, DM, DM}; pg8::StaticOrder S; S.init(MTOK, 2 * DFF, F.G, F.bid);
        pg8::EpiSwiGLU E{(bf16*)(F.ws + WS_U), DFF, 2 * DFF / 256};
        pg8::gemm_phase<pg8::EpiSwiGLU, pg8::StaticOrder, true, true>(F.lds + RING_OFF, g, S, E); TAIL_FILL(7, S.nwg); CONV_END(7) SEAM(7);
    if (IN(8)) { pg8::Gemm g{(const bf16*)(F.ws + WS_U), (const bf16*)(F.ws + WS_WF2), MTOK, DM, DFF, DFF}; pg8::StaticOrder S; S.init(MTOK, DM, F.G, F.bid);
        pg8::EpiResGate E{args.out, args.out, MODc + 10240, NMOD};
        pg8::gemm_phase<pg8::EpiResGate, pg8::StaticOrder, false, true>(F.lds + RING_OFF, g, S, E); } SEAM(8);
    CONV_BEGIN(9) const float* X = args.out; const float* gk = (const float*)args.in[14]; const float* ga = (const float*)args.in[6] + DM;
        const int gw = F.bid * NWAVES + F.wave, NGW = F.G * NWAVES;
        for (int row = gw; row < MTOK; row += NGW) { const int b = row >> 11;
            f32x4 v[8]; const float* xr = X + (size_t)row * DM + 4 * F.lane;
#pragma unroll
            for (int j = 0; j < 8; ++j) v[j] = *(const f32x4*)(xr + 256 * j);
            const float rstd = row_rstd(v);
            modulate_store(v, rstd, gk, MODc + (size_t)b * NMOD + 24576, MODc + (size_t)b * NMOD + 24576 + 2048, HA + (size_t)row * DM, F.lane);
            modulate_store(v, rstd, ga, MODc + (size_t)b * NMOD + 12288, MODc + (size_t)b * NMOD + 12288 + 2048, HA + (size_t)(MTOK + row) * DM, F.lane); } CONV_END(9) SEAM(9);
    CONV_BEGIN(10) pg8::Gemm g{HA, (const bf16*)(F.ws + WS_WKVQ), 2 * MTOK, 9216, DM, DM}; pg8::DualOrder S; S.init(MTOK / 256, 24, 12, MTOK / 256, 24, F.G, F.bid);
        pg8::EpiBf16Sel E{(bf16*)(F.ws + WS_KV), 6144, (bf16*)(F.ws + WS_Q1), 3072, MTOK / 256, 24};
        pg8::gemm_phase<pg8::EpiBf16Sel, pg8::DualOrder, true, true>(F.lds + RING_OFF, g, S, E); TAIL_FILL(10, S.ntot); CONV_END(10) SEAM(10);
    CONV_BEGIN(11) p11_qknorm(F, args); p11_vtrans(F); CONV_END(11) SEAM(11);
    CONV_BEGIN(12) for (int item = F.bid; item < NB * 3 * 16 * 8; item += F.G) p12_attn_item(F, args, item); __syncthreads(); CONV_END(12) SEAM(12);
    CONV_BEGIN(13) p13_merge(F); CONV_END(13) SEAM(13);
    if (IN(14)) { pg8::Gemm g{(const bf16*)(F.ws + WS_O1), (const bf16*)(F.ws + WS_WBOUT), MTOK, DM, 1024, 1024}; pg8::StaticOrder S; S.init(MTOK, DM, F.G, F.bid);
        pg8::EpiResGate E{args.out, args.out, MODc + 12288 + 4096, NMOD};
        pg8::gemm_phase<pg8::EpiResGate, pg8::StaticOrder, false, true>(F.lds + RING_OFF, g, S, E); } SEAM(14);
    CONV_BEGIN(15) p15_norm_route(F, args); CONV_END(15)
    if (IN(15) && F.lane == 0) __hip_atomic_store((unsigned*)(F.ctl + CW_CUR + F.bid * NWAVES + F.wave), (unsigned)cv_cur, RLX_AGENT);
    SEAM(15);
    if (IN(16)) { p16_gather(F); conv_drain(F, args); } SEAM(16);
    if (IN(17)) { int off[9]; moe_offsets(F, off); pg8::MoeOrder S;
#pragma unroll
        for (int e = 0; e < 9; ++e) S.toff[e] = off[e] >> 8;
        S.nN = 2 * DFFE / 256; S.T = S.toff[8]; S.total = S.T * S.nN; S.G = F.G; S.c = F.bid; S.ksplit = 1; S.klen = DM;
        pg8::Gemm g{(const bf16*)(F.ws + WS_AS), (const bf16*)(F.ws + WS_WM13), MROWS, 2 * DFFE, DM, DM};
        pg8::EpiSwiGLU E{(bf16*)(F.ws + WS_UM), DFFE, 2 * DFFE / 256};
        pg8::gemm_phase<pg8::EpiSwiGLU, pg8::MoeOrder, true, true>(F.lds + RING_OFF, g, S, E); } SEAM(17);
    if (IN(18)) { int off[9]; moe_offsets(F, off); pg8::MoeOrder S;
#pragma unroll
        for (int e = 0; e < 9; ++e) S.toff[e] = off[e] >> 8;
        S.nN = DM / 256; S.T = S.toff[8]; S.total = S.T * S.nN * 2; S.G = F.G; S.c = F.bid; S.ksplit = 2; S.klen = DFFE / 2;
        pg8::Gemm g{(const bf16*)(F.ws + WS_UM), (const bf16*)(F.ws + WS_WM2), MROWS, DM, DFFE, DFFE / 2};
        pg8::EpiRowScale E{(float*)(F.ws + WS_Y), (const float*)(F.ws + WS_RG), DM / 256, (size_t)(WS_Y2 - WS_Y) / 4};
        pg8::gemm_phase<pg8::EpiRowScale, pg8::MoeOrder, true, true>(F.lds + RING_OFF, g, S, E); } SEAM(18);
    if (IN(19)) { p19_final(F, args); }
#undef IN
#undef SEAM
#undef CONV_BEGIN
#undef CONV_END
#undef TAIL_FILL
}

#ifndef MK_PER_PHASE
#define MK_PER_PHASE 0
#endif
extern "C" void kernel_launch(void* const* d_in, const int* in_sizes, int n_in, void* d_out, int out_size, void* d_ws, size_t ws_size, hipStream_t stream) {
    static int grid = 0;
    if (grid == 0) {
        if (n_in != 28 || out_size != MTOK * DM || ws_size < WS_END) { fprintf(stderr, "kernel_launch: unexpected shapes (n_in %d, out %d, ws %zu < %zu)\n", n_in, out_size, ws_size, (size_t)WS_END); grid = -1; return; }
        int dev = 0, cus = 0, per_cu = 0;
        if (hipGetDevice(&dev) != hipSuccess || hipDeviceGetAttribute(&cus, hipDeviceAttributeMultiprocessorCount, dev) != hipSuccess) { grid = -1; return; }
        if (hipFuncSetAttribute((const void*)yoco_fwd, hipFuncAttributeMaxDynamicSharedMemorySize, LDS_BYTES) != hipSuccess) { fprintf(stderr, "kernel_launch: hipFuncSetAttribute failed\n"); grid = -1; return; }
        if (hipOccupancyMaxActiveBlocksPerMultiprocessor(&per_cu, (const void*)yoco_fwd, NWAVES * 64, LDS_BYTES) != hipSuccess || per_cu < 1) fprintf(stderr, "kernel_launch: occupancy query reports %d\n", per_cu);
        (void)hipGetLastError();
        grid = cus;
    }
    if (grid < 0) return;
    if (hipMemsetAsync((char*)d_ws + WS_CTL, 0, CTL_ZERO_BYTES, stream) != hipSuccess) return;
    Args a{};
    for (int i = 0; i < 28; ++i) a.in[i] = d_in[i];
    a.out = (float*)d_out; a.ws = (unsigned char*)d_ws;
#if MK_PER_PHASE
    for (int p = 0; p < N_PHASES; ++p) { a.ph_lo = p; a.ph_hi = p + 1; hipLaunchKernelGGL(yoco_fwd, dim3(grid), dim3(NWAVES * 64), LDS_BYTES, stream, a); }
#else
    a.ph_lo = 0; a.ph_hi = N_PHASES;
    hipLaunchKernelGGL(yoco_fwd, dim3(grid), dim3(NWAVES * 64), LDS_BYTES, stream, a);
#endif
    const hipError_t le = hipPeekAtLastError();
    if (le != hipSuccess) fprintf(stderr, "kernel_launch: launch failed: %s\n", hipGetErrorName(le));
}
```

```cpp
#include <hip/hip_runtime.h>
#include <cstdio>
#include <cstdint>
namespace pg8 {
#define PG8_LAS __attribute__((address_space(3)))
typedef unsigned short bf16_t;
typedef short bf16x8 __attribute__((ext_vector_type(8)));
typedef float f32x4 __attribute__((ext_vector_type(4)));
typedef unsigned u32x4 __attribute__((ext_vector_type(4)));
constexpr int BM = 256, BK = 64, HALF = 128, HTB = HALF * BK * 2  , STAGE_BYTES = 8 * HTB, NXCD = 8, WGM = 8;

__host__ __device__ __forceinline__ int lds_byte(int r, int c) { const int st = (r >> 4) * 2 + (c >> 5), rr = r & 15, cc = c & 31, ob = rr * 64 + cc * 2; return st * 1024 + (ob ^ (((ob >> 9) & 1) << 5)); }
__host__ __device__ __forceinline__ void stage_rc(int b, int& R, int& C) { const int st = b / 1024, sb = b % 1024, swz = sb ^ (((sb >> 9) & 1) << 5); R = (st >> 1) * 16 + swz / 64; C = (st & 1) * 32 + (swz % 64) / 2; }
__host__ __device__ __forceinline__ int perm32(int rho) { const int n = rho >> 4, i = rho & 15; return 8 * (i >> 2) + 4 * n + (i & 3); }

struct Unit { int pm, pn, kofs; };
struct Gemm { const bf16_t* A; const bf16_t* Bt; int M, N, K, Kext; };

__device__ __forceinline__ void tile_map(int L, int nM, int nN, int& pm, int& pn) {
    const int nwg = nM * nN; int wgid = L;
    { const int q = nwg / NXCD, r = nwg % NXCD, xcd = wgid % NXCD, off = wgid / NXCD; wgid = (xcd < r ? xcd * (q + 1) : r * (q + 1) + (xcd - r) * q) + off; }
    const int nig = WGM * nN, gid = wgid / nig, fm = gid * WGM, gsz = (nM - fm) < WGM ? (nM - fm) : WGM;
    pm = fm + ((wgid % nig) % gsz); pn = (wgid % nig) / gsz;
}
struct StaticOrder {
    int nM, nN, nwg, G, c;
    __device__ void init(int M, int N, int G_, int c_) { nM = M / BM; nN = N / BM; nwg = nM * nN; G = G_; c = c_; }
    __device__ bool next(int i, Unit& u) const { const long L = (long)i * G + c; if (L >= nwg) return false; tile_map((int)L, nM, nN, u.pm, u.pn); u.kofs = 0; return true; }
    __device__ __forceinline__ void a_ready(const Unit&) const {}
    __device__ __forceinline__ void done(const Unit&) const {}
};
struct DualOrder {
    int nM, nN1, nN2, n1, ntot, pm_off, pn_off, G, c;
    __device__ void init(int nM_, int nN1_, int nN2_, int pm_off_, int pn_off_, int G_, int c_) { nM = nM_; nN1 = nN1_; nN2 = nN2_; n1 = nM * nN1; ntot = n1 + nM * nN2; pm_off = pm_off_; pn_off = pn_off_; G = G_; c = c_; }
    __device__ bool next(int i, Unit& u) const { const long L = (long)i * G + c; if (L >= ntot) return false;
        if (L < n1) tile_map((int)L, nM, nN1, u.pm, u.pn); else { tile_map((int)L - n1, nM, nN2, u.pm, u.pn); u.pm += pm_off; u.pn += pn_off; } u.kofs = 0; return true; }
    __device__ __forceinline__ void a_ready(const Unit&) const {}
    __device__ __forceinline__ void done(const Unit&) const {}
};
struct MoeOrder {
    int toff[9]; int nN, T, total, G, c, ksplit, klen;
    __device__ bool next(int i, Unit& u) const {
        long v;
        if ((G & 7) == 0) { const int x = c & 7, j = c >> 3, nper = G >> 3; const long s0 = ((long)x * total) >> 3, s1 = ((long)(x + 1) * total) >> 3; v = s0 + (long)i * nper + j; if (v >= s1) return false; }
        else { v = (long)i * G + c; if (v >= total) return false; }
        const int per = nN * ksplit;
        int e = 0, te = 0, te1 = toff[1];
#pragma unroll
        for (int k = 1; k < 8; ++k) { const bool ge = v >= (long)toff[k] * per; e = ge ? k : e; te = ge ? toff[k] : te; te1 = ge ? toff[k + 1] : te1; }
        const int r = (int)(v - (long)te * per), ne = te1 - te, q = r / ne, kh = q % ksplit;
        u.pm = te + r % ne; u.pn = e * nN + q / ksplit; u.kofs = kh * klen; return true; }
    __device__ __forceinline__ void a_ready(const Unit&) const {}
    __device__ __forceinline__ void done(const Unit&) const {}
};

__device__ __forceinline__ unsigned cvt_pk_bf16(float lo, float hi) { unsigned r; asm volatile("v_cvt_pk_bf16_f32 %0, %1, %2" : "=v"(r) : "v"(lo), "v"(hi)); return r; }

struct EpiBf16Sel {
    static constexpr bool PERM = true, AFTER_DRAIN = false;
    bf16_t* O0; int ld0; bf16_t* O1; int ld1; int pm_split, pn_split;
    __device__ __forceinline__ void operator()(const f32x4 (&acc)[2][2][4][2], const Unit& u, int wr, int wc, int fr, int fq) const {
        bf16_t* base = O0; int ldc = ld0, pm = u.pm, pn = u.pn;
        if (pn >= pn_split) { base = O1; ldc = ld1; pm -= pm_split; pn -= pn_split; }
        const int row0 = pm * BM + wr * 64 + fr, col0 = pn * BM + wc * 32 + 8 * fq;
#pragma unroll
        for (int ai = 0; ai < 2; ++ai)
#pragma unroll
            for (int m = 0; m < 4; ++m) { bf16_t* rowp = base + (size_t)(row0 + ai * HALF + m * 16) * ldc + col0;
#pragma unroll
                for (int bj = 0; bj < 2; ++bj) { const f32x4 v0 = acc[ai][bj][m][0], v1 = acc[ai][bj][m][1];
                    u32x4 w; w.x = cvt_pk_bf16(v0[0], v0[1]); w.y = cvt_pk_bf16(v0[2], v0[3]); w.z = cvt_pk_bf16(v1[0], v1[1]); w.w = cvt_pk_bf16(v1[2], v1[3]);
                    *(u32x4*)(rowp + bj * HALF) = w; } }
    }
};
struct EpiResGate {
    static constexpr bool PERM = false, AFTER_DRAIN = false;
    const float* base; float* out; const float* gate; int gstride;
    __device__ __forceinline__ void operator()(const f32x4 (&acc)[2][2][4][2], const Unit& u, int wr, int wc, int fr, int fq) const {
        const int row0 = u.pm * BM + wr * 64 + fr, col0 = u.pn * BM + wc * 32 + 4 * fq;
        const float* gp = gate + (size_t)(u.pm >> 3) * gstride + col0;
        f32x4 gv[2][2];
#pragma unroll
        for (int bj = 0; bj < 2; ++bj)
#pragma unroll
            for (int n = 0; n < 2; ++n) gv[bj][n] = *(const f32x4*)(gp + bj * HALF + n * 16);
#pragma unroll
        for (int ai = 0; ai < 2; ++ai)
#pragma unroll
            for (int m = 0; m < 4; ++m) { const size_t off = (size_t)(row0 + ai * HALF + m * 16) * 2048 + col0;
#pragma unroll
                for (int bj = 0; bj < 2; ++bj)
#pragma unroll
                    for (int n = 0; n < 2; ++n) { const f32x4 bs = *(const f32x4*)(base + off + bj * HALF + n * 16); *(f32x4*)(out + off + bj * HALF + n * 16) = bs + gv[bj][n] * acc[ai][bj][m][n]; }
                asm volatile("" ::: "memory"); }
    }
};
struct EpiSwiGLU {
    static constexpr bool PERM = true, AFTER_DRAIN = false;
    bf16_t* O; int ldc; int nN;
    __device__ __forceinline__ void operator()(const f32x4 (&acc)[2][2][4][2], const Unit& u, int wr, int wc, int fr, int fq) const {
        const int row0 = u.pm * BM + wr * 64 + fr, col0 = (u.pn % nN) * HALF + wc * 32 + 8 * fq;
#pragma unroll
        for (int ai = 0; ai < 2; ++ai)
#pragma unroll
            for (int m = 0; m < 4; ++m) { bf16_t* rowp = O + (size_t)(row0 + ai * HALF + m * 16) * ldc + col0;
                float r[8];
#pragma unroll
                for (int n = 0; n < 2; ++n)
#pragma unroll
                    for (int j = 0; j < 4; ++j) { const float g = acc[ai][0][m][n][j], up = acc[ai][1][m][n][j];
                        r[4 * n + j] = g * up * __builtin_amdgcn_rcpf(1.0f + __builtin_amdgcn_exp2f(-1.4426950408889634f * g)); }
                u32x4 w; w.x = cvt_pk_bf16(r[0], r[1]); w.y = cvt_pk_bf16(r[2], r[3]); w.z = cvt_pk_bf16(r[4], r[5]); w.w = cvt_pk_bf16(r[6], r[7]);
                *(u32x4*)rowp = w; }
    }
};
struct EpiRowScale {
    static constexpr bool PERM = true, AFTER_DRAIN = false;
    bf16_t* Y; const float* rs; int nN; size_t part_stride;
    __device__ __forceinline__ void operator()(const f32x4 (&acc)[2][2][4][2], const Unit& u, int wr, int wc, int fr, int fq) const {
        const int row0 = u.pm * BM + wr * 64 + fr, col0 = (u.pn % nN) * BM + wc * 32 + 8 * fq;
        bf16_t* Yp = Y + (u.kofs ? part_stride : 0);
#pragma unroll
        for (int ai = 0; ai < 2; ++ai)
#pragma unroll
            for (int m = 0; m < 4; ++m) { const int row = row0 + ai * HALF + m * 16; const float s = rs[row]; bf16_t* rowp = Yp + (size_t)row * 2048 + col0;
#pragma unroll
                for (int bj = 0; bj < 2; ++bj) { const f32x4 v0 = acc[ai][bj][m][0] * s, v1 = acc[ai][bj][m][1] * s;
                    u32x4 w; w.x = cvt_pk_bf16(v0[0], v0[1]); w.y = cvt_pk_bf16(v0[2], v0[3]); w.z = cvt_pk_bf16(v1[0], v1[1]); w.w = cvt_pk_bf16(v1[2], v1[3]);
                    *(u32x4*)(rowp + bj * HALF) = w; } }
    }
};

template <class Epi, class Sched, bool ALIGN_EPI = false, bool SP2 = false>
__device__ __forceinline__ void gemm_phase(PG8_LAS unsigned char* lds, const Gemm g, const Sched& S, const Epi& E) {
    const int tid = threadIdx.x, wid = __builtin_amdgcn_readfirstlane(tid >> 6), lane = tid & 63, wr = wid >> 2, wc = wid & 3, fr = lane & 15, fq = lane >> 4;
    const int K = g.K, nt = g.Kext / BK;
    unsigned voffA[2], voffB[2];
#pragma unroll
    for (int i = 0; i < 2; ++i) { int R, C; stage_rc(tid * 16 + i * 8192, R, C); const int Rb = Epi::PERM ? ((R & ~31) + perm32(R & 31)) : R;
        voffA[i] = (unsigned)(R * K + C) * 2u; voffB[i] = (unsigned)(Rb * K + C) * 2u; }
    const size_t kstep = (size_t)(BK * 2);
    const size_t hstep = (size_t)HALF * K * 2;
    const size_t tstep = 2 * hstep;
    const unsigned ldsw = (unsigned)wid * 1024u;
    const int aoff = lds_byte(wr * 64 + fr, fq * 8), boff = lds_byte(wc * 32 + fr, fq * 8);
#define PG8_SA(b, h) (((b) * 2 + (h)) * HTB)
#define PG8_SB(b, h) ((4 + (b) * 2 + (h)) * HTB)
#define PG8_STAGE(bufoff, gbase, voff) do { _Pragma("unroll") for (int _i = 0; _i < 2; ++_i) \
        __builtin_amdgcn_global_load_lds((const unsigned*)((const char*)(gbase) + (voff)[_i]), (PG8_LAS unsigned*)(lds + (bufoff) + ldsw + _i * 8192), 16, 0, 0); } while (0)
#define PG8_LDA(dst, b, h) do { _Pragma("unroll") for (int m = 0; m < 4; ++m) _Pragma("unroll") for (int k = 0; k < 2; ++k) dst[m][k] = *(const PG8_LAS bf16x8*)(lds + PG8_SA(b, h) + aoff + m * 2048 + k * 1024); } while (0)
#define PG8_LDB(dst, b, h) do { _Pragma("unroll") for (int n = 0; n < 2; ++n) _Pragma("unroll") for (int k = 0; k < 2; ++k) dst[n][k] = *(const PG8_LAS bf16x8*)(lds + PG8_SB(b, h) + boff + n * 2048 + k * 1024); } while (0)
#define PG8_MMA(ai, bj, At, Bt) do { __builtin_amdgcn_s_setprio(1); _Pragma("unroll") for (int m = 0; m < 4; ++m) _Pragma("unroll") for (int n = 0; n < 2; ++n) _Pragma("unroll") for (int k = 0; k < 2; ++k) \
        acc[ai][bj][m][n] = __builtin_amdgcn_mfma_f32_16x16x32_bf16(Bt[n][k], At[m][k], acc[ai][bj][m][n], 0, 0, 0); __builtin_amdgcn_s_setprio(0); } while (0)
#define PG8_WAIT_V(n) asm volatile("s_waitcnt vmcnt(" #n ")" ::: "memory")
#define PG8_WAIT_L(n) asm volatile("s_waitcnt lgkmcnt(" #n ")" ::: "memory")
#define PG8_BAR __builtin_amdgcn_s_barrier()
#define PG8_SCHED __builtin_amdgcn_sched_barrier(0)
    Unit cur, nxt; int ui = 0;
    if (!S.next(0, cur)) return;
    f32x4 acc[2][2][4][2];
#pragma unroll
    for (int a = 0; a < 2; ++a)
#pragma unroll
        for (int b = 0; b < 2; ++b)
#pragma unroll
            for (int m = 0; m < 4; ++m)
#pragma unroll
                for (int n = 0; n < 2; ++n) acc[a][b][m][n] = (f32x4){0.f, 0.f, 0.f, 0.f};
    bf16x8 At[4][2], B0[2][2], B1[2][2];
    const char* cA = (const char*)g.A + (size_t)cur.pm * tstep + (size_t)cur.kofs * 2; const char* cB = (const char*)g.Bt + (size_t)cur.pn * tstep + (size_t)cur.kofs * 2;
    S.a_ready(cur);
    if constexpr (SP2) {
        PG8_STAGE(PG8_SB(0, 0), cB, voffB); PG8_STAGE(PG8_SB(0, 1), cB + hstep, voffB); PG8_STAGE(PG8_SA(0, 0), cA, voffA); PG8_STAGE(PG8_SA(0, 1), cA + hstep, voffA);
        if (wr == 1) PG8_BAR;
        PG8_WAIT_V(2); PG8_BAR;
        PG8_STAGE(PG8_SB(1, 0), cB + kstep, voffB); PG8_STAGE(PG8_SA(1, 0), cA + kstep, voffA); PG8_STAGE(PG8_SB(1, 1), cB + hstep + kstep, voffB);
        PG8_WAIT_V(6); PG8_BAR;
    } else {
        PG8_STAGE(PG8_SB(0, 0), cB, voffB); PG8_STAGE(PG8_SA(0, 0), cA, voffA); PG8_STAGE(PG8_SB(0, 1), cB + hstep, voffB); PG8_STAGE(PG8_SA(0, 1), cA + hstep, voffA);
        if (wr == 1) PG8_BAR;
        PG8_WAIT_V(4); PG8_BAR;
        PG8_STAGE(PG8_SB(1, 0), cB + kstep, voffB); PG8_STAGE(PG8_SA(1, 0), cA + kstep, voffA); PG8_STAGE(PG8_SB(1, 1), cB + hstep + kstep, voffB);
        PG8_WAIT_V(6); PG8_BAR;
    }
    for (;;) {
        const bool has_next = S.next(ui + 1, nxt);
        const char* nA = has_next ? (const char*)g.A + (size_t)nxt.pm * tstep + (size_t)nxt.kofs * 2 : cA; const char* nB = has_next ? (const char*)g.Bt + (size_t)nxt.pn * tstep + (size_t)nxt.kofs * 2 : cB;
        for (int t = 0; t < nt; t += 2) {
            const bool last = (t == nt - 2);
            const char* a1 = cA + (size_t)(t + 1) * kstep;
            const char* a2 = last ? nA : cA + (size_t)(t + 2) * kstep; const char* b2 = last ? nB : cB + (size_t)(t + 2) * kstep;
            const char* a3 = a2 + kstep; const char* b3 = b2 + kstep;
            if (last && has_next) S.a_ready(nxt);
            if constexpr (SP2) {
            PG8_LDB(B0, 0, 0); PG8_LDB(B1, 0, 1); PG8_SCHED; PG8_LDA(At, 0, 0); PG8_STAGE(PG8_SA(1, 1), a1 + hstep, voffA);
            PG8_WAIT_V(8); PG8_WAIT_L(0); PG8_BAR; PG8_MMA(0, 0, At, B0); PG8_MMA(0, 1, At, B1); PG8_BAR; PG8_SCHED;
            PG8_LDA(At, 0, 1); PG8_STAGE(PG8_SB(0, 0), b2, voffB); PG8_STAGE(PG8_SB(0, 1), b2 + hstep, voffB); PG8_STAGE(PG8_SA(0, 0), a2, voffA);
            PG8_WAIT_V(8); PG8_WAIT_L(0); PG8_BAR; PG8_MMA(1, 0, At, B0); PG8_MMA(1, 1, At, B1); PG8_BAR; PG8_SCHED;
            PG8_LDB(B0, 1, 0); PG8_LDB(B1, 1, 1); PG8_SCHED; PG8_LDA(At, 1, 0); PG8_STAGE(PG8_SA(0, 1), a2 + hstep, voffA);
            PG8_WAIT_V(8); PG8_WAIT_L(0); PG8_BAR; PG8_MMA(0, 0, At, B0); PG8_MMA(0, 1, At, B1); PG8_BAR; PG8_SCHED;
            PG8_LDA(At, 1, 1); PG8_STAGE(PG8_SB(1, 0), b3, voffB); PG8_STAGE(PG8_SB(1, 1), b3 + hstep, voffB); PG8_STAGE(PG8_SA(1, 0), a3, voffA);
            PG8_WAIT_V(8); PG8_WAIT_L(0); PG8_BAR; PG8_MMA(1, 0, At, B0); PG8_MMA(1, 1, At, B1); PG8_BAR; PG8_SCHED;
            } else {
            PG8_LDB(B0, 0, 0); PG8_SCHED; PG8_LDA(At, 0, 0); PG8_STAGE(PG8_SA(1, 1), a1 + hstep, voffA);
            PG8_WAIT_L(8); PG8_BAR; PG8_WAIT_L(0); PG8_MMA(0, 0, At, B0); PG8_BAR; PG8_SCHED;
            PG8_LDB(B1, 0, 1); PG8_STAGE(PG8_SB(0, 0), b2, voffB);
            PG8_BAR; PG8_WAIT_L(0); PG8_MMA(0, 1, At, B1); PG8_BAR;
            PG8_LDA(At, 0, 1); PG8_STAGE(PG8_SA(0, 0), a2, voffA);
            PG8_BAR; PG8_WAIT_L(0); PG8_MMA(1, 0, At, B0); PG8_BAR; PG8_SCHED;
            PG8_STAGE(PG8_SB(0, 1), b2 + hstep, voffB);
            PG8_WAIT_V(6); PG8_BAR; PG8_MMA(1, 1, At, B1); PG8_BAR;
            PG8_LDB(B0, 1, 0); PG8_SCHED; PG8_LDA(At, 1, 0); PG8_STAGE(PG8_SA(0, 1), a2 + hstep, voffA);
            PG8_WAIT_L(8); PG8_BAR; PG8_WAIT_L(0); PG8_MMA(0, 0, At, B0); PG8_BAR; PG8_SCHED;
            PG8_LDB(B1, 1, 1); PG8_STAGE(PG8_SB(1, 0), b3, voffB);
            PG8_BAR; PG8_WAIT_L(0); PG8_MMA(0, 1, At, B1); PG8_BAR;
            PG8_LDA(At, 1, 1); PG8_STAGE(PG8_SA(1, 0), a3, voffA);
            PG8_BAR; PG8_WAIT_L(0); PG8_MMA(1, 0, At, B0); PG8_BAR; PG8_SCHED;
            PG8_STAGE(PG8_SB(1, 1), b3 + hstep, voffB);
            PG8_WAIT_V(6); PG8_BAR; PG8_MMA(1, 1, At, B1); PG8_BAR;
            }
        }
        if constexpr (ALIGN_EPI) { if (wr == 0) PG8_BAR; }
        if constexpr (!Epi::AFTER_DRAIN) { E(acc, cur, wr, wc, fr, fq); S.done(cur); }
        if (!has_next) break;
#pragma unroll
        for (int a = 0; a < 2; ++a)
#pragma unroll
            for (int b = 0; b < 2; ++b)
#pragma unroll
                for (int m = 0; m < 4; ++m)
#pragma unroll
                    for (int n = 0; n < 2; ++n) acc[a][b][m][n] = (f32x4){0.f, 0.f, 0.f, 0.f};
        cur = nxt; cA = nA; cB = nB; ++ui;
        if constexpr (ALIGN_EPI) { if (wr == 1) PG8_BAR; }
    }
    PG8_WAIT_V(0);
    if constexpr (!ALIGN_EPI) { if (wr == 0) PG8_BAR; }
    PG8_BAR;
    if constexpr (Epi::AFTER_DRAIN) { E.fused(acc, cur, wr, wc, fr, fq, lds, wid, lane); S.done(cur); }
#undef PG8_SA
#undef PG8_SB
#undef PG8_STAGE
#undef PG8_LDA
#undef PG8_LDB
#undef PG8_MMA
#undef PG8_WAIT_V
#undef PG8_WAIT_L
#undef PG8_BAR
#undef PG8_SCHED
}
}

constexpr int NB = 4, SEQ = 2048, DM = 2048, MTOK = NB * SEQ;
constexpr int A_IN = 4176, A_INP = 4352;
constexpr int C_Q = 0, C_K = 2048, C_V = 2560, C_QI = 3072, C_KI = 4096, C_WI = 4160;
constexpr int DFF = 5632, DFFE = 7168, NEXP = 8;
constexpr int NMOD = 28672;
constexpr float EPS = 1e-6f, LOG2E = 1.4426950408889634f;
constexpr int MROWS = 2 * MTOK + NEXP * 256;

constexpr size_t MiB = 1u << 20;
constexpr size_t WS_CTL = 0, CTL_ZERO_BYTES = 1 * MiB;
constexpr size_t WS_MOD = 1 * MiB, WS_BT = WS_MOD + 512 * 1024, WS_ROUTE = WS_MOD + 768 * 1024;
constexpr size_t WS_WIN = 2 * MiB, WS_WAOUT = 19 * MiB, WS_WF13 = 27 * MiB, WS_WF2 = 71 * MiB, WS_WKVQ = 93 * MiB, WS_WBOUT = 129 * MiB, WS_WM13 = 133 * MiB, WS_WM2 = 581 * MiB;
constexpr size_t WS_HA = 805 * MiB, WS_AR = 869 * MiB;
constexpr size_t WS_P0 = WS_AR, WS_QN = WS_AR + 68 * MiB, WS_KN = WS_AR + 100 * MiB, WS_VT = WS_AR + 108 * MiB, WS_MASK = WS_AR + 116 * MiB, WS_O = WS_AR + 118 * MiB, WS_U = WS_AR + 150 * MiB;
constexpr size_t WS_KV = WS_AR, WS_Q1 = WS_AR + 96 * MiB, WS_K1N = WS_AR + 144 * MiB, WS_Q1N = WS_AR + 192 * MiB, WS_VT1 = WS_AR + 240 * MiB, WS_OG = WS_AR + 288 * MiB, WS_LSE = WS_AR + 336 * MiB, WS_O1 = WS_AR + 338 * MiB;
constexpr size_t WS_AS = WS_AR, WS_UM = WS_AR + 72 * MiB, WS_Y = WS_AR + 324 * MiB, WS_Y2 = WS_AR + 468 * MiB, WS_RG = WS_AR + 612 * MiB, WS_TR = WS_AR + 613 * MiB;
constexpr size_t WS_END = WS_AR + 614 * MiB;
static_assert((size_t)A_INP * DM * 2 <= 17 * MiB && (size_t)MROWS * DFFE * 2 <= 252 * MiB && (size_t)MROWS * DM * 4 <= 144 * MiB && (size_t)MROWS * DM * 2 <= 72 * MiB, "ws map");
constexpr int CW_TMO = 0, CW_CODE = 1, CW_BAR = 4096, CW_CNT = 8192, CW_CUR = 16384, CW_DONE = 12288;

constexpr int RING_OFF = 0, RING_BYTES = 131072;
constexpr int LDSCTL_OFF = RING_BYTES, MISC_OFF = LDSCTL_OFF + 320;
constexpr int LDS_BYTES = 147456;
constexpr int NWAVES = 8;

#define GAS __attribute__((address_space(1)))
#define LAS __attribute__((address_space(3)))
typedef unsigned short bf16;
typedef unsigned v4u __attribute__((ext_vector_type(4)));
typedef unsigned v2u __attribute__((ext_vector_type(2)));
typedef float f32x4 __attribute__((ext_vector_type(4)));
typedef float f32x2 __attribute__((ext_vector_type(2)));
typedef float f32x16 __attribute__((ext_vector_type(16)));
typedef int i32x4 __attribute__((ext_vector_type(4)));
typedef short bf16x8 __attribute__((ext_vector_type(8)));
typedef GAS unsigned gu32;
#define RLX_AGENT __ATOMIC_RELAXED, __HIP_MEMORY_SCOPE_AGENT
#define MFMA32(a, b, c) __builtin_amdgcn_mfma_f32_32x32x16_bf16((a), (b), (c), 0, 0, 0)
__device__ __forceinline__ unsigned f2bf(float f) { unsigned u = __builtin_bit_cast(unsigned, f); return (u + 0x7fffu + ((u >> 16) & 1u)) >> 16; }
__device__ __forceinline__ unsigned pk2(float lo, float hi) { return f2bf(lo) | (f2bf(hi) << 16); }
__device__ __forceinline__ float bflo(unsigned w) { return __builtin_bit_cast(float, w << 16); }
__device__ __forceinline__ float bfhi(unsigned w) { return __builtin_bit_cast(float, w & 0xffff0000u); }
typedef float f32x2_t __attribute__((ext_vector_type(2)));
typedef __bf16 bf16x2_t __attribute__((ext_vector_type(2)));
__device__ __forceinline__ unsigned cvtpk(float lo, float hi) { f32x2_t v = {lo, hi}; bf16x2_t b = __builtin_convertvector(v, bf16x2_t); return __builtin_bit_cast(unsigned, b); }
__device__ __forceinline__ bf16x8 pack8(float a0, float a1, float a2, float a3, float a4, float a5, float a6, float a7) {
    v4u p; p.x = cvtpk(a0, a1); p.y = cvtpk(a2, a3); p.z = cvtpk(a4, a5); p.w = cvtpk(a6, a7); return __builtin_bit_cast(bf16x8, p); }
#define XB_TMO      128
#define XB_XCNT(j)  (256  + 64 * (j))
#define XB_XSUB(j)  (1280 + 64 * (j))
#define XB_XGEN(j)  (2304 + 64 * (j))
#define XB_TOP      3328
#define XB_TOPGEN   3392
#define XCD_BAR_WORDS 3456
#define XB_SPIN_CAP (1u << 18)

__device__ __forceinline__ unsigned xb_ld(unsigned* p)              { return __hip_atomic_load(p, __ATOMIC_RELAXED, __HIP_MEMORY_SCOPE_AGENT); }
__device__ __forceinline__ unsigned xb_add(unsigned* p, unsigned v) { return __hip_atomic_fetch_add(p, v, __ATOMIC_RELAXED, __HIP_MEMORY_SCOPE_AGENT); }
__device__ __forceinline__ unsigned xb_xcc_id() { return (unsigned)__builtin_amdgcn_s_getreg((3 << 11) | 20) & 0xFu; }
#define XB_SPIN(cond, bar) do { unsigned _sp = 0; while (cond) { __builtin_amdgcn_s_sleep(1); \
    if ((++_sp & 255u) == 0u) { if (xb_ld(&(bar)[XB_TMO])) break; if (_sp > XB_SPIN_CAP) { atomicAdd(&(bar)[XB_TMO], 1u); break; } } } } while (0)

struct XcdBarrier {
    unsigned* bar; unsigned x;
    volatile LAS unsigned* st;
};

__device__ __forceinline__ XcdBarrier xcd_barrier_post(unsigned* bar, volatile LAS unsigned* st) {
    XcdBarrier b; b.bar = bar; b.x = xb_xcc_id(); b.st = st;
    if (threadIdx.x == 0) (void)xb_add(&bar[XB_XCNT(b.x)], 1u);
    return b;
}
__device__ __forceinline__ void xcd_barrier_complete(unsigned* bar, unsigned x, unsigned& nloc, unsigned& nx) {
    const unsigned G = gridDim.x * gridDim.y * gridDim.z;
    unsigned sum, cnt, mine, sp = 0u;
    for (;;) {
        sum = 0u; cnt = 0u; mine = 0u;
#pragma unroll
        for (unsigned j = 0; j < 16; ++j) { const unsigned c = xb_ld(&bar[XB_XCNT(j)]); sum += c; cnt += (c > 0u) ? 1u : 0u; mine = (j == x) ? c : mine; }
        if (sum == G) break;
        __builtin_amdgcn_s_sleep(1);
        if ((++sp & 255u) == 0u) { if (xb_ld(&bar[XB_TMO])) break; if (sp > XB_SPIN_CAP) { atomicAdd(&bar[XB_TMO], 1u); break; } }
    }
    nloc = mine > 0u ? mine : 1u; nx = cnt > 0u ? cnt : 1u;
}

__device__ __forceinline__ void xcd_barrier(const XcdBarrier& b) {
    asm volatile("s_waitcnt vmcnt(0)" ::: "memory");
    __syncthreads();
    if (threadIdx.x == 0) {
        unsigned* bar = b.bar;
        __builtin_amdgcn_s_waitcnt(0);
        unsigned nloc = b.st[0], nx = b.st[1];
        if (nloc == 0u) { xcd_barrier_complete(bar, b.x, nloc, nx); b.st[0] = nloc; b.st[1] = nx; }
        const unsigned old = xb_add(&bar[XB_XSUB(b.x)], 1u);
        const unsigned gen = old / nloc;
        if (old + 1u == (gen + 1u) * nloc) {
            __builtin_amdgcn_fence(__ATOMIC_RELEASE, "agent");
            asm volatile("s_waitcnt vmcnt(0)" ::: "memory");
            const unsigned og = xb_add(&bar[XB_TOP], 1u);
            const unsigned tg = og / nx;
            if (og + 1u == (tg + 1u) * nx) xb_add(&bar[XB_TOPGEN], 1u);
            else XB_SPIN(xb_ld(&bar[XB_TOPGEN]) == tg, bar);
            __builtin_amdgcn_fence(__ATOMIC_ACQUIRE, "agent");
            xb_add(&bar[XB_XGEN(b.x)], 1u);
            asm volatile("s_waitcnt vmcnt(0)" ::: "memory");
        } else {
            XB_SPIN(xb_ld(&bar[XB_XGEN(b.x)]) == gen, bar);
            __builtin_amdgcn_fence(__ATOMIC_ACQUIRE, "agent");
            asm volatile("s_waitcnt vmcnt(0)" ::: "memory");
        }
    }
    __syncthreads();
}

struct Args { const void* in[28]; float* out; unsigned char* ws; int ph_lo, ph_hi; };
struct Frame {
    LAS unsigned char* lds; volatile LAS unsigned* MISC; gu32* ctl; unsigned char* ws;
    int tid, lane, wave, G, bid;
};
#define LDS_WAIT() asm volatile("s_waitcnt lgkmcnt(0)" ::: "memory")
__device__ __forceinline__ float wave_sum(float v) {
#pragma unroll
    for (int o = 1; o < 64; o <<= 1) v += __shfl_xor(v, o);
    return v;
}

__device__ __forceinline__ int t5_bucket(int n) {
    if (n < 16) return n;
    const float v = logf((float)n / 16.0f) / 4.852030263919617f * 16.0f;
    const int l = 16 + (int)v; return l < 31 ? l : 31;
}
__device__ __forceinline__ void cvt_tile(const float* __restrict__ src, int N, int k0, int n0, int nvalid, bf16* __restrict__ dst, size_t drow0, int Kd, int lane) {
    const int cl = lane & 15, kg = lane >> 4;
    f32x4 v[16];
    const float* sp = src + (size_t)(k0 + 16 * kg) * N + n0 + 4 * cl;
    const bool ok = 4 * cl < nvalid;
#pragma unroll
    for (int i = 0; i < 16; ++i) v[i] = ok ? *(const f32x4*)(sp + (size_t)i * N) : (f32x4){0.f, 0.f, 0.f, 0.f};
    bf16* dp = dst + (drow0 + 4 * cl) * (size_t)Kd + k0 + 16 * kg;
#pragma unroll
    for (int e = 0; e < 4; ++e) {
        v4u a, b;
        a.x = pk2(v[0][e], v[1][e]); a.y = pk2(v[2][e], v[3][e]); a.z = pk2(v[4][e], v[5][e]); a.w = pk2(v[6][e], v[7][e]);
        b.x = pk2(v[8][e], v[9][e]); b.y = pk2(v[10][e], v[11][e]); b.z = pk2(v[12][e], v[13][e]); b.w = pk2(v[14][e], v[15][e]);
        *(v4u*)(dp + (size_t)e * Kd) = a; *(v4u*)(dp + (size_t)e * Kd + 8) = b;
    }
}
__device__ __forceinline__ void p0_prologue(Frame& F, const Args& A) {
    const float* c_in = (const float*)A.in[1];
    const float* rel_bias = (const float*)A.in[3];
    float* MOD = (float*)(F.ws + WS_MOD); float* BT = (float*)(F.ws + WS_BT);
    LAS float* cs = (LAS float*)F.lds; LAS float* red = (LAS float*)(F.lds + 32768);
    for (int i = F.tid; i < NB * DM; i += NWAVES * 64) { const float v = c_in[i]; cs[i] = v / (1.0f + __expf(-v)); }
    __syncthreads();
    for (int item = F.bid; item < NMOD / 128; item += F.G) {
        const int j0 = item * 128; const float* W; const float* bias; int N, jl;
        if (j0 < 12288) { W = (const float*)A.in[4]; N = 12288; jl = j0; bias = (const float*)A.in[5]; }
        else if (j0 < 24576) { W = (const float*)A.in[4] + (size_t)DM * 12288; N = 12288; jl = j0 - 12288; bias = (const float*)A.in[5] + 12288; }
        else { W = (const float*)A.in[12]; N = 4096; jl = j0 - 24576; bias = (const float*)A.in[13]; }
        const float* wp = W + (size_t)(256 * F.wave) * N + jl + 2 * F.lane;
        float a[4][2];
#pragma unroll
        for (int b = 0; b < 4; ++b) { a[b][0] = 0.f; a[b][1] = 0.f; }
        for (int k = 0; k < 256; k += 8) {
            f32x2 w[8];
#pragma unroll
            for (int i = 0; i < 8; ++i) w[i] = *(const f32x2*)(wp + (size_t)(k + i) * N);
#pragma unroll
            for (int i = 0; i < 8; ++i)
#pragma unroll
                for (int b = 0; b < 4; ++b) { const float cv = cs[b * DM + 256 * F.wave + k + i]; a[b][0] += cv * w[i].x; a[b][1] += cv * w[i].y; }
        }
#pragma unroll
        for (int b = 0; b < 4; ++b) { red[(F.wave * 4 + b) * 128 + 2 * F.lane] = a[b][0]; red[(F.wave * 4 + b) * 128 + 2 * F.lane + 1] = a[b][1]; }
        __syncthreads();
        { const int b = F.tid >> 7, col = F.tid & 127; float s = bias[jl + col];
#pragma unroll
          for (int w = 0; w < 8; ++w) s += red[(w * 4 + b) * 128 + col];
          MOD[(size_t)b * NMOD + j0 + col] = s; }
        __syncthreads();
    }
    for (int idx = F.bid * (NWAVES * 64) + F.tid; idx < 16 * 2048; idx += F.G * NWAVES * 64) { const int h = idx >> 11, n = idx & 2047; BT[idx] = rel_bias[t5_bucket(n) * 16 + h] * LOG2E; }
    const int gw = F.bid * NWAVES + F.wave, NGW = F.G * NWAVES;
    constexpr int T_IN = 32 * 68, T_AOUT = 32 * 32, T_F1 = 32 * 88, T_F2 = 88 * 32, T_KV = 32 * 96, T_BQ = 32 * 48, T_BOUT = 16 * 32;
    constexpr int NITEMS = T_IN + T_AOUT + 2 * T_F1 + T_F2 + T_KV + T_BQ + T_BOUT;
    for (int it = gw; it < NITEMS; it += NGW) {
        int r = it;
        if (r < T_IN) { const int kb = r / 68, nb = r % 68; cvt_tile((const float*)A.in[8], A_IN, 64 * kb, 64 * nb, A_IN - 64 * nb, (bf16*)(F.ws + WS_WIN), (size_t)64 * nb, DM, F.lane); continue; } r -= T_IN;
        if (r < T_AOUT) { const int kb = r / 32, nb = r % 32; cvt_tile((const float*)A.in[9], DM, 64 * kb, 64 * nb, 64, (bf16*)(F.ws + WS_WAOUT), (size_t)64 * nb, DM, F.lane); continue; } r -= T_AOUT;
        if (r < T_F1) { const int kb = r / 88, nb = r % 88, n0 = 64 * nb; cvt_tile((const float*)A.in[20], DFF, 64 * kb, n0, 64, (bf16*)(F.ws + WS_WF13), (size_t)((n0 >> 7) * 256 + (n0 & 127)), DM, F.lane); continue; } r -= T_F1;
        if (r < T_F1) { const int kb = r / 88, nb = r % 88, n0 = 64 * nb; cvt_tile((const float*)A.in[21], DFF, 64 * kb, n0, 64, (bf16*)(F.ws + WS_WF13), (size_t)((n0 >> 7) * 256 + 128 + (n0 & 127)), DM, F.lane); continue; } r -= T_F1;
        if (r < T_F2) { const int kb = r / 32, nb = r % 32; cvt_tile((const float*)A.in[22], DM, 64 * kb, 64 * nb, 64, (bf16*)(F.ws + WS_WF2), (size_t)64 * nb, DFF, F.lane); continue; } r -= T_F2;
        if (r < T_KV) { const int kb = r / 96, nb = r % 96; cvt_tile((const float*)A.in[15], 6144, 64 * kb, 64 * nb, 64, (bf16*)(F.ws + WS_WKVQ), (size_t)64 * nb, DM, F.lane); continue; } r -= T_KV;
        if (r < T_BQ) { const int kb = r / 48, nb = r % 48; cvt_tile((const float*)A.in[17], 3072, 64 * kb, 64 * nb, 64, (bf16*)(F.ws + WS_WKVQ), (size_t)(6144 + 64 * nb), DM, F.lane); continue; } r -= T_BQ;
        { const int kb = r / 32, nb = r % 32; cvt_tile((const float*)A.in[18], DM, 64 * kb, 64 * nb, 64, (bf16*)(F.ws + WS_WBOUT), (size_t)64 * nb, 1024, F.lane); }
    }
}
constexpr int CV_TME = 3584, CV_TM = 8 * CV_TME, NT_MOE = 3 * CV_TM;
__device__ __forceinline__ void moe_tile_addr(Frame& F, const Args& A, int t, const float*& sp, int& N, bf16*& dp, int& Kd) {
    const int cl = F.lane & 15, kg = F.lane >> 4; int r = t;
    if (r < 2 * CV_TM) { const int up = r >= CV_TM ? 1 : 0; r -= up * CV_TM; const int e = r / CV_TME, rr = r % CV_TME, kb = rr / 112, nb = rr % 112, n0 = 64 * nb;
        N = DFFE; Kd = DM; sp = (const float*)A.in[25 + up] + (size_t)e * DM * DFFE + (size_t)(64 * kb + 16 * kg) * DFFE + n0 + 4 * cl;
        dp = (bf16*)(F.ws + WS_WM13) + ((size_t)e * 14336 + (n0 >> 7) * 256 + 128 * up + (n0 & 127) + 4 * cl) * DM + 64 * kb + 16 * kg; }
    else { r -= 2 * CV_TM; const int e = r / CV_TME, rr = r % CV_TME, kb = rr / 32, nb = rr % 32;
        N = DM; Kd = DFFE; sp = (const float*)A.in[27] + (size_t)e * DFFE * DM + (size_t)(64 * kb + 16 * kg) * DM + 64 * nb + 4 * cl;
        dp = (bf16*)(F.ws + WS_WM2) + ((size_t)e * 2048 + 64 * nb + 4 * cl) * DFFE + 64 * kb + 16 * kg; }
}
__device__ __forceinline__ void cvt_load(f32x4 (&v)[16], const float* __restrict__ sp, int N) {
#pragma unroll
    for (int i = 0; i < 16; ++i) v[i] = *(const f32x4*)(sp + (size_t)i * N);
}
__device__ __forceinline__ void cvt_store(const f32x4 (&v)[16], bf16* __restrict__ dp, int Kd) {
#pragma unroll
    for (int e = 0; e < 4; ++e) {
        v4u a, b;
        a.x = pk2(v[0][e], v[1][e]); a.y = pk2(v[2][e], v[3][e]); a.z = pk2(v[4][e], v[5][e]); a.w = pk2(v[6][e], v[7][e]);
        b.x = pk2(v[8][e], v[9][e]); b.y = pk2(v[10][e], v[11][e]); b.z = pk2(v[12][e], v[13][e]); b.w = pk2(v[14][e], v[15][e]);
        *(v4u*)(dp + (size_t)e * Kd) = a; *(v4u*)(dp + (size_t)e * Kd + 8) = b;
    }
}
__device__ __forceinline__ int conv_fixed(Frame& F, const Args& A, int cur, int ntiles) {
    const int CV_STRIPES = F.G * NWAVES;
    f32x4 va[16], vb[16]; const float* sp; bf16* dpa; bf16* dpb; int N, Kda, Kdb;
    int left = ntiles;
    if (left <= 0 || cur >= NT_MOE) return cur;
    moe_tile_addr(F, A, cur, sp, N, dpa, Kda); cvt_load(va, sp, N); cur += CV_STRIPES; --left;
    for (;;) {
        const bool haveB = left > 0 && cur < NT_MOE;
        if (haveB) { moe_tile_addr(F, A, cur, sp, N, dpb, Kdb); cvt_load(vb, sp, N); cur += CV_STRIPES; --left; }
        cvt_store(va, dpa, Kda);
        if (!haveB) break;
        const bool haveA = left > 0 && cur < NT_MOE;
        if (haveA) { moe_tile_addr(F, A, cur, sp, N, dpa, Kda); cvt_load(va, sp, N); cur += CV_STRIPES; --left; }
        cvt_store(vb, dpb, Kdb);
        if (!haveA) break;
    }
    return cur;
}
__device__ __forceinline__ void conv_drain(Frame& F, const Args& A) {
    LAS int* curL = (LAS int*)F.lds;
    const int gw = F.bid * NWAVES + F.wave, NGW = F.G * NWAVES;
    __syncthreads();
    for (int j = F.tid; j < NGW; j += NWAVES * 64) curL[j] = (int)__hip_atomic_load((unsigned*)(F.ctl + CW_CUR + j), RLX_AGENT);
    __syncthreads();
    const int rows = (NT_MOE + NGW - 1) / NGW;
    for (int i = 0; i < rows; ++i) {
        const int j = (gw + 97 * i) % NGW, t = i * NGW + j;
        if (t >= NT_MOE || t < curL[j]) continue;
        const float* sp; bf16* dp; int N, Kd; f32x4 v[16];
        moe_tile_addr(F, A, t, sp, N, dp, Kd); cvt_load(v, sp, N); cvt_store(v, dp, Kd);
    }
    __syncthreads();
}

__device__ __forceinline__ float row_rstd(const f32x4 (&v)[8]) {
    float ss = 0.f;
#pragma unroll
    for (int j = 0; j < 8; ++j) ss += (v[j].x * v[j].x + v[j].y * v[j].y) + (v[j].z * v[j].z + v[j].w * v[j].w);
    return 1.0f / sqrtf(wave_sum(ss) * (1.0f / DM) + EPS);
}
__device__ __forceinline__ void modulate_store(const f32x4 (&v)[8], float rstd, const float* g, const float* sh, const float* sc, bf16* orow, int lane) {
#pragma unroll
    for (int j = 0; j < 8; ++j) { const int col = 4 * lane + 256 * j;
        const f32x4 gg = *(const f32x4*)(g + col), s1 = *(const f32x4*)(sc + col), s0 = *(const f32x4*)(sh + col);
        const f32x4 y = v[j] * rstd * gg * (s1 + 1.0f) + s0;
        v2u w; w.x = pk2(y.x, y.y); w.y = pk2(y.z, y.w); *(v2u*)(orow + col) = w; }
}
__device__ __forceinline__ void normmod_phase(Frame& F, const float* X, const float* g, const float* modsh, const float* modsc, bf16* out) {
    const int gw = F.bid * NWAVES + F.wave, NGW = F.G * NWAVES;
    for (int row = gw; row < MTOK; row += NGW) { const int b = row >> 11;
        f32x4 v[8]; const float* xr = X + (size_t)row * DM + 4 * F.lane;
#pragma unroll
        for (int j = 0; j < 8; ++j) v[j] = *(const f32x4*)(xr + 256 * j);
        const float rstd = row_rstd(v);
        modulate_store(v, rstd, g, modsh + (size_t)b * NMOD, modsc + (size_t)b * NMOD, out + (size_t)row * DM, F.lane); }
}

constexpr float NEG_S = -3.0e38f;
__device__ __forceinline__ void p3_qknorm(Frame& F, const Args& A) {
    const bf16* P0 = (const bf16*)(F.ws + WS_P0); bf16* QN = (bf16*)(F.ws + WS_QN); bf16* KN = (bf16*)(F.ws + WS_KN);
    const float* gq = (const float*)A.in[10]; const float* gk = (const float*)A.in[11];
    const int gw = F.bid * NWAVES + F.wave, NGW = F.G * NWAVES, li = F.lane & 15, g4 = F.lane >> 4;
    const float QS = 0.08838834764831845f * LOG2E;
    float gqv[8], gkv[8];
#pragma unroll
    for (int e = 0; e < 8; ++e) { gqv[e] = gq[8 * li + e] * QS; gkv[e] = gk[8 * li + e]; }
    for (int tok = gw; tok < MTOK; tok += NGW) {
        const bf16* pr = P0 + (size_t)tok * A_INP;
#pragma unroll
        for (int i = 0; i < 5; ++i) { const int head = 4 * i + g4;
            const v4u w = *(const v4u*)(pr + head * 128 + 8 * li);
            float x[8] = {bflo(w.x), bfhi(w.x), bflo(w.y), bfhi(w.y), bflo(w.z), bfhi(w.z), bflo(w.w), bfhi(w.w)};
            float ss = 0.f;
#pragma unroll
            for (int e = 0; e < 8; ++e) ss += x[e] * x[e];
            ss += __shfl_xor(ss, 8); ss += __shfl_xor(ss, 4); ss += __shfl_xor(ss, 2); ss += __shfl_xor(ss, 1);
            const float rstd = 1.0f / sqrtf(ss * (1.0f / 128.0f) + EPS);
            v4u o;
            if (i < 4) { o.x = pk2(x[0] * rstd * gqv[0], x[1] * rstd * gqv[1]); o.y = pk2(x[2] * rstd * gqv[2], x[3] * rstd * gqv[3]); o.z = pk2(x[4] * rstd * gqv[4], x[5] * rstd * gqv[5]); o.w = pk2(x[6] * rstd * gqv[6], x[7] * rstd * gqv[7]);
                *(v4u*)(QN + (size_t)tok * DM + head * 128 + 8 * li) = o; }
            else { o.x = pk2(x[0] * rstd * gkv[0], x[1] * rstd * gkv[1]); o.y = pk2(x[2] * rstd * gkv[2], x[3] * rstd * gkv[3]); o.z = pk2(x[4] * rstd * gkv[4], x[5] * rstd * gkv[5]); o.w = pk2(x[6] * rstd * gkv[6], x[7] * rstd * gkv[7]);
                *(v4u*)(KN + (size_t)tok * 512 + (head - 16) * 128 + 8 * li) = o; }
        }
    }
}
__device__ __forceinline__ void p3_vtrans(Frame& F) {
    const bf16* P0 = (const bf16*)(F.ws + WS_P0); bf16* VT = (bf16*)(F.ws + WS_VT);
    LAS unsigned* tile = (LAS unsigned*)F.lds;
    for (int item = F.bid; item < MTOK / 64; item += F.G) { const int tok0 = item * 64, b = tok0 >> 11, t0 = tok0 & 2047;
        __syncthreads();
#pragma unroll
        for (int p = 0; p < 8; ++p) { const int row = p * 8 + (F.tid >> 6), cw = (F.tid & 63) * 4;
            const v4u w = *(const v4u*)(P0 + (size_t)(tok0 + row) * A_INP + C_V + 2 * cw);
            tile[row * 257 + cw] = w.x; tile[row * 257 + cw + 1] = w.y; tile[row * 257 + cw + 2] = w.z; tile[row * 257 + cw + 3] = w.w; }
        __syncthreads();
#pragma unroll
        for (int p = 0; p < 8; ++p) { const int task = p * 512 + F.tid, tg = task & 7, col = task >> 3;
            const LAS unsigned short* tp = (const LAS unsigned short*)tile + col;
            unsigned short h[8];
#pragma unroll
            for (int i = 0; i < 8; ++i) h[i] = tp[(size_t)(tg * 8 + i) * 514];
            v4u o; o.x = h[0] | ((unsigned)h[1] << 16); o.y = h[2] | ((unsigned)h[3] << 16); o.z = h[4] | ((unsigned)h[5] << 16); o.w = h[6] | ((unsigned)h[7] << 16);
            *(v4u*)(VT + ((size_t)(b * 512 + col)) * SEQ + t0 + tg * 8) = o; }
    }
    __syncthreads();
}
__device__ __forceinline__ void p3_indexer_pair(Frame& F, int pair) {
    const bf16* P0 = (const bf16*)(F.ws + WS_P0); unsigned* MASK = (unsigned*)(F.ws + WS_MASK);
    const int b = pair >> 10, t0 = (pair & 1023) * 2, lane = F.lane, c = lane & 31, hh = lane >> 5;
    const bf16* Pb = P0 + (size_t)b * SEQ * A_INP;
    const int qsel = (c >> 2) & 1, ahead = (c & 3) + 4 * (c >> 3);
    const bf16* ap = Pb + (size_t)(t0 + qsel) * A_INP + C_QI + ahead * 64 + 8 * hh;
    bf16x8 af[4];
#pragma unroll
    for (int ks = 0; ks < 4; ++ks) af[ks] = *(const bf16x8*)(ap + 16 * ks);
    const bf16* wp = Pb + (size_t)(t0 + hh) * A_INP + C_WI;
    const v4u w0 = *(const v4u*)wp, w1 = *(const v4u*)(wp + 8);
    const float WS_ = 0.25f * 0.125f;
    const float wv[16] = {bflo(w0.x) * WS_, bfhi(w0.x) * WS_, bflo(w0.y) * WS_, bfhi(w0.y) * WS_, bflo(w0.z) * WS_, bfhi(w0.z) * WS_, bflo(w0.w) * WS_, bfhi(w0.w) * WS_,
                          bflo(w1.x) * WS_, bfhi(w1.x) * WS_, bflo(w1.y) * WS_, bfhi(w1.y) * WS_, bflo(w1.z) * WS_, bfhi(w1.z) * WS_, bflo(w1.w) * WS_, bfhi(w1.w) * WS_};
    const int tq = t0 + hh, ktmax = (t0 + 1) >> 5;
    LAS float* scL = (LAS float*)(F.lds + F.wave * 16384) + lane;
#define IDX_LOAD(dst, kg_) do { const bf16* bp_ = Pb + (size_t)(128 * (kg_) + c) * A_INP + C_KI + 8 * hh; \
        _Pragma("unroll") for (int u = 0; u < 4; ++u) _Pragma("unroll") for (int ks = 0; ks < 4; ++ks) dst[u][ks] = *(const bf16x8*)(bp_ + (size_t)(32 * u) * A_INP + 16 * ks); } while (0)
#define IDX_COMP(src, kg_) do { _Pragma("unroll") for (int u = 0; u < 4; ++u) { f32x16 d; \
            _Pragma("unroll") for (int t = 0; t < 16; ++t) d[t] = 0.f; \
            _Pragma("unroll") for (int ks = 0; ks < 4; ++ks) d = MFMA32(af[ks], src[u][ks], d); \
            float s_ = 0.f; \
            _Pragma("unroll") for (int t = 0; t < 16; ++t) s_ += fmaxf(d[t], 0.f) * wv[t]; \
            scL[(4 * (kg_) + u) * 64] = (32 * (4 * (kg_) + u) + c <= tq) ? s_ : NEG_S; } } while (0)
    { const int ng = (ktmax >> 2) + 1;
      bf16x8 bA[4][4], bB[4][4];
      IDX_LOAD(bA, 0);
      for (int kg = 0; kg < ng; kg += 2) {
          if (kg + 1 < ng) IDX_LOAD(bB, kg + 1);
          IDX_COMP(bA, kg);
          if (kg + 1 < ng) { if (kg + 2 < ng) IDX_LOAD(bA, kg + 2); IDX_COMP(bB, kg + 1); }
      } }
#undef IDX_LOAD
#undef IDX_COMP
    LDS_WAIT();
    float sc[64];
#pragma unroll
    for (int k = 0; k < 64; ++k) { const float v = scL[k * 64]; sc[k] = (k <= ktmax) ? v : NEG_S; }
    LDS_WAIT();
    float mx = NEG_S, mn = 3.0e38f;
#pragma unroll
    for (int k = 0; k < 64; ++k) { mx = fmaxf(mx, sc[k]); mn = (sc[k] > -1.0e38f) ? fminf(mn, sc[k]) : mn; }
#pragma unroll
    for (int o = 16; o >= 1; o >>= 1) { mx = fmaxf(mx, __shfl_xor(mx, o)); mn = fminf(mn, __shfl_xor(mn, o)); }
    bool done = (tq + 1 <= 256); float lo = mn, hi = mx, thr = done ? -1.0e38f : mn;
    for (int it = 0; it < 48; ++it) {
        if (__all(done)) break;
        const float mid = 0.5f * (lo + hi);
        int cnt = 0;
#pragma unroll
        for (int k = 0; k < 64; ++k) cnt += (sc[k] >= mid) ? 1 : 0;
#pragma unroll
        for (int o = 16; o >= 1; o >>= 1) cnt += __shfl_xor(cnt, o);
        if (!done) {
            if (!(mid > lo) || !(mid < hi)) { done = true; thr = lo; }
            else if (cnt >= 256) { lo = mid; thr = mid; done = (cnt == 256); }
            else hi = mid;
        }
    }
    unsigned wA = 0u, wB = 0u;
#pragma unroll
    for (int k = 0; k < 64; ++k) { const unsigned long long bal = __ballot(sc[k] >= thr); if (lane == k) { wA = (unsigned)bal; wB = (unsigned)(bal >> 32); } }
    MASK[((size_t)b * SEQ + t0) * 64 + lane] = wA; MASK[((size_t)b * SEQ + t0 + 1) * 64 + lane] = wB;
}

__device__ __forceinline__ int kperm(int r) { return (r & ~12) | ((r & 4) << 1) | ((r & 8) >> 1); }
constexpr int P4_TAB = 0, P4_POS = 32768, P4_MASK = 40960, P4_MPITCH = 65, P4_K = 57600, P4_V = P4_K + 16384, P4_END = P4_V + 16384;
static_assert(P4_MASK + 64 * P4_MPITCH * 4 <= P4_K && P4_END <= RING_BYTES, "P4 LDS map");
__device__ __forceinline__ void p4_attn_item(Frame& F, const Args& A, int item) {
    const bf16* QN = (const bf16*)(F.ws + WS_QN); const bf16* KN = (const bf16*)(F.ws + WS_KN); const bf16* VT = (const bf16*)(F.ws + WS_VT);
    const unsigned* MASK = (const unsigned*)(F.ws + WS_MASK); const float* BT = (const float*)(F.ws + WS_BT); bf16* OB = (bf16*)(F.ws + WS_O);
    const int* pos = (const int*)A.in[2];
    const int qt = item >> 4, bk = item & 15, b = bk >> 2, kvh = bk & 3;
    LAS float* tab = (LAS float*)(F.lds + P4_TAB); LAS int* posL = (LAS int*)(F.lds + P4_POS); LAS unsigned* maskL = (LAS unsigned*)(F.lds + P4_MASK);
    const int w = F.wave, hd = w & 3, head = kvh * 4 + hd, qw0 = qt * 64 + 32 * (w >> 2), lane = F.lane, c = lane & 31, hh = lane >> 5;
    const size_t tokq = (size_t)b * SEQ + qw0 + c;
    __syncthreads();
    for (int i = F.tid; i < 4 * 2048; i += NWAVES * 64) tab[i] = BT[kvh * 4 * 2048 + i];
    for (int i = F.tid; i < SEQ; i += NWAVES * 64) posL[i] = pos[b * SEQ + i];
    for (int i = F.tid; i < 64 * 64; i += NWAVES * 64) maskL[(i >> 6) * P4_MPITCH + (i & 63)] = MASK[((size_t)b * SEQ + qt * 64 + (i >> 6)) * 64 + (i & 63)];
    const bf16* qp = QN + tokq * DM + head * 128 + 8 * hh;
    bf16x8 qf[8];
#pragma unroll
    for (int ks = 0; ks < 8; ++ks) qf[ks] = *(const bf16x8*)(qp + 16 * ks);
    __syncthreads();
    const int krow = 4 * w + (lane >> 4), kch = (lane & 15) ^ (krow & 15);
    const bf16* kg = KN + ((size_t)b * SEQ + krow) * 512 + kvh * 128 + 8 * kch;
    const int vd = 16 * w + (lane >> 2), vch = (lane & 3) ^ ((vd >> 2) & 3);
    const bf16* vg = VT + ((size_t)(b * 4 + kvh) * 128 + vd) * SEQ + 8 * vch;
    LAS unsigned char* kdst = F.lds + P4_K + 1024 * w; LAS unsigned char* vdst = F.lds + P4_V + 1024 * w;
#define P4_DMA(kt_) do { const int sl_ = ((kt_) & 1) * 8192; \
        __builtin_amdgcn_global_load_lds((const unsigned*)(kg + (size_t)(kt_) * 32 * 512), (LAS unsigned*)(kdst + sl_), 16, 0, 0); \
        __builtin_amdgcn_global_load_lds((const unsigned*)(vg + (kt_) * 32), (LAS unsigned*)(vdst + sl_), 16, 0, 0); } while (0)
    const int pq = posL[qw0 + c];
    const LAS float* tb = tab + hd * 2048;
    const LAS unsigned* mrow = maskL + (32 * (w >> 2) + c) * P4_MPITCH;
    f32x16 O[4];
#pragma unroll
    for (int db = 0; db < 4; ++db)
#pragma unroll
        for (int t = 0; t < 16; ++t) O[db][t] = 0.f;
    float m = -1.0e29f, l = 0.f;
    const int ktmax = (qw0 + 31) >> 5, nkt = 2 * qt + 2;
    const int prow = kperm(c);
    const LAS unsigned char* kfrag = F.lds + P4_K + prow * 256;
    const LAS unsigned char* vfrag = F.lds + P4_V + c * 64;
    P4_DMA(0);
    asm volatile("s_waitcnt vmcnt(0)" ::: "memory"); __builtin_amdgcn_s_barrier(); asm volatile("" ::: "memory");
    for (int kt = 0; kt < nkt; ++kt) {
        const int sl = (kt & 1) * 8192;
        if (kt + 1 < nkt) P4_DMA(kt + 1);
        if (kt <= ktmax) {
            const int key0 = kt * 32;
            f32x16 S;
#pragma unroll
            for (int t = 0; t < 16; ++t) S[t] = 0.f;
#pragma unroll
            for (int ks = 0; ks < 8; ++ks) { const bf16x8 kf = *(const LAS bf16x8*)(kfrag + sl + (((2 * ks + hh) ^ (prow & 15)) << 4)); S = MFMA32(kf, qf[ks], S); }
            const unsigned mw = mrow[kt] >> (8 * hh);
            const i32x4 p0 = *(const LAS i32x4*)(posL + key0 + 8 * hh), p1 = *(const LAS i32x4*)(posL + key0 + 8 * hh + 4), p2 = *(const LAS i32x4*)(posL + key0 + 16 + 8 * hh), p3 = *(const LAS i32x4*)(posL + key0 + 16 + 8 * hh + 4);
            const int pk[16] = {p0.x, p0.y, p0.z, p0.w, p1.x, p1.y, p1.z, p1.w, p2.x, p2.y, p2.z, p2.w, p3.x, p3.y, p3.z, p3.w};
            float s[16]; float mx = -1.0e29f;
#pragma unroll
            for (int t = 0; t < 16; ++t) { const int bit = (t & 7) + 16 * (t >> 3);
                int idx = pq - pk[t]; idx = idx < 0 ? 0 : (idx > 2047 ? 2047 : idx);
                const float v = S[t] + tb[idx];
                s[t] = ((mw >> bit) & 1u) ? v : -1.0e30f; mx = fmaxf(mx, s[t]); }
            mx = fmaxf(mx, __shfl_xor(mx, 32));
            const float mnew = fmaxf(m, mx);
            float p[16]; float ls = 0.f;
#pragma unroll
            for (int t = 0; t < 16; ++t) { p[t] = __builtin_amdgcn_exp2f(s[t] - mnew); ls += p[t]; }
            if (!__all(mnew == m)) {
                const float alpha = __builtin_amdgcn_exp2f(m - mnew); l *= alpha;
#pragma unroll
                for (int db = 0; db < 4; ++db)
#pragma unroll
                    for (int t = 0; t < 16; ++t) O[db][t] *= alpha;
            }
            l += ls; m = mnew;
            const bf16x8 pf0 = pack8(p[0], p[1], p[2], p[3], p[4], p[5], p[6], p[7]), pf1 = pack8(p[8], p[9], p[10], p[11], p[12], p[13], p[14], p[15]);
            const int vsw = (c >> 2) & 3;
#pragma unroll
            for (int db = 0; db < 4; ++db) {
                const bf16x8 v0 = *(const LAS bf16x8*)(vfrag + sl + 32 * 64 * db + (((0 + hh) ^ vsw) << 4)), v1 = *(const LAS bf16x8*)(vfrag + sl + 32 * 64 * db + (((2 + hh) ^ vsw) << 4));
                O[db] = MFMA32(v0, pf0, O[db]); O[db] = MFMA32(v1, pf1, O[db]); }
        }
        asm volatile("s_waitcnt vmcnt(0) lgkmcnt(0)" ::: "memory"); __builtin_amdgcn_s_barrier(); asm volatile("" ::: "memory");
    }
#undef P4_DMA
    l += __shfl_xor(l, 32);
    const float inv = 1.0f / l;
    bf16* op = OB + tokq * DM + head * 128 + 4 * hh;
#pragma unroll
    for (int db = 0; db < 4; ++db)
#pragma unroll
        for (int g = 0; g < 4; ++g) { v2u w2; w2.x = pk2(O[db][4 * g] * inv, O[db][4 * g + 1] * inv); w2.y = pk2(O[db][4 * g + 2] * inv, O[db][4 * g + 3] * inv); *(v2u*)(op + 32 * db + 8 * g) = w2; }
}

__device__ __forceinline__ void p11_qknorm(Frame& F, const Args& A) {
    const bf16* KV = (const bf16*)(F.ws + WS_KV); const bf16* Q1 = (const bf16*)(F.ws + WS_Q1); bf16* K1N = (bf16*)(F.ws + WS_K1N); bf16* Q1N = (bf16*)(F.ws + WS_Q1N);
    const float* gk = (const float*)A.in[16]; const float* gq = (const float*)A.in[19];
    const int gw = F.bid * NWAVES + F.wave, NGW = F.G * NWAVES, li = F.lane & 7, g8 = F.lane >> 3;
    const float QS = 0.125f * LOG2E;
    float gqv[8], gkv[8];
#pragma unroll
    for (int e = 0; e < 8; ++e) { gqv[e] = gq[8 * li + e] * QS; gkv[e] = gk[8 * li + e]; }
    for (int tok = gw; tok < MTOK; tok += NGW) {
#pragma unroll
        for (int i = 0; i < 12; ++i) { const int head = 8 * (i % 6) + g8; const bool isq = i < 6;
            const bf16* src = isq ? Q1 + (size_t)tok * 3072 : KV + (size_t)tok * 6144;
            const v4u w = *(const v4u*)(src + head * 64 + 8 * li);
            float x[8] = {bflo(w.x), bfhi(w.x), bflo(w.y), bfhi(w.y), bflo(w.z), bfhi(w.z), bflo(w.w), bfhi(w.w)};
            float ss = 0.f;
#pragma unroll
            for (int e = 0; e < 8; ++e) ss += x[e] * x[e];
            ss += __shfl_xor(ss, 4); ss += __shfl_xor(ss, 2); ss += __shfl_xor(ss, 1);
            const float rstd = 1.0f / sqrtf(ss * (1.0f / 64.0f) + EPS);
            v4u o;
            if (isq) { o.x = pk2(x[0] * rstd * gqv[0], x[1] * rstd * gqv[1]); o.y = pk2(x[2] * rstd * gqv[2], x[3] * rstd * gqv[3]); o.z = pk2(x[4] * rstd * gqv[4], x[5] * rstd * gqv[5]); o.w = pk2(x[6] * rstd * gqv[6], x[7] * rstd * gqv[7]);
                *(v4u*)(Q1N + (size_t)tok * 3072 + head * 64 + 8 * li) = o; }
            else { o.x = pk2(x[0] * rstd * gkv[0], x[1] * rstd * gkv[1]); o.y = pk2(x[2] * rstd * gkv[2], x[3] * rstd * gkv[3]); o.z = pk2(x[4] * rstd * gkv[4], x[5] * rstd * gkv[5]); o.w = pk2(x[6] * rstd * gkv[6], x[7] * rstd * gkv[7]);
                *(v4u*)(K1N + (size_t)tok * 3072 + head * 64 + 8 * li) = o; }
        }
    }
}
__device__ __forceinline__ void p11_vtrans(Frame& F) {
    const bf16* KV = (const bf16*)(F.ws + WS_KV); bf16* VT1 = (bf16*)(F.ws + WS_VT1);
    LAS unsigned* tile = (LAS unsigned*)F.lds;
    for (int item = F.bid; item < NB * 3 * 16 * 4; item += F.G) {
        const int cg = item & 3, ch = (item >> 2) & 15, bg = item >> 6, g = bg % 3, b = bg / 3, t0 = ch * 128, lr = 2 * g, r = 1 << lr, nsub = SEQ >> lr;
        __syncthreads();
#pragma unroll
        for (int p = 0; p < 8; ++p) { const int row = p * 16 + (F.tid >> 5), cw = (F.tid & 31) * 4;
            const v4u w = *(const v4u*)(KV + (size_t)(b * SEQ + t0 + row) * 6144 + 3072 + g * 1024 + cg * 256 + 2 * cw);
            tile[row * 129 + cw] = w.x; tile[row * 129 + cw + 1] = w.y; tile[row * 129 + cw + 2] = w.z; tile[row * 129 + cw + 3] = w.w; }
        __syncthreads();
#pragma unroll
        for (int p = 0; p < 8; ++p) { const int task = p * 512 + F.tid, q = task & 15, col = task >> 4;
            const int rho = q & (r - 1), run = q >> lr;
            const LAS unsigned short* tp = (const LAS unsigned short*)tile + col;
            unsigned short h[8];
#pragma unroll
            for (int i = 0; i < 8; ++i) h[i] = tp[(size_t)(((8 * run + i) << lr) + rho) * 258];
            v4u o; o.x = h[0] | ((unsigned)h[1] << 16); o.y = h[2] | ((unsigned)h[3] << 16); o.z = h[4] | ((unsigned)h[5] << 16); o.w = h[6] | ((unsigned)h[7] << 16);
            *(v4u*)(VT1 + ((size_t)((b * 3 + g) * 1024 + cg * 256 + col)) * SEQ + rho * nsub + (t0 >> lr) + 8 * run) = o; }
    }
    __syncthreads();
}
__device__ __forceinline__ void p12_attn_item(Frame& F, const Args& A, int item) {
    const bf16* Q1N = (const bf16*)(F.ws + WS_Q1N); const bf16* K1N = (const bf16*)(F.ws + WS_K1N); const bf16* VT1 = (const bf16*)(F.ws + WS_VT1);
    const float* BT = (const float*)(F.ws + WS_BT); bf16* OG = (bf16*)(F.ws + WS_OG); float* LSE = (float*)(F.ws + WS_LSE);
    const int* pos = (const int*)A.in[2];
    const int jb = item & 7, head = (item >> 3) & 15, bg = item >> 7, g = bg % 3, b = bg / 3, lr = 2 * g, nsub = SEQ >> lr, tps = nsub >> 5;
    LAS float* tab = (LAS float*)F.lds; LAS int* posL = (LAS int*)(F.lds + 8192);
    __syncthreads();
    for (int i = F.tid; i < 2048; i += NWAVES * 64) { tab[i] = BT[head * 2048 + i]; posL[i] = pos[b * SEQ + i]; }
    __syncthreads();
    const int j = 8 * jb + F.wave, rho = j / tps, n0 = 32 * (j % tps), lane = F.lane, c = lane & 31, hh = lane >> 5;
    const int tq = ((n0 + c) << lr) + rho;
    const size_t tokq = (size_t)b * SEQ + tq;
    const bf16* qp = Q1N + tokq * 3072 + g * 1024 + head * 64 + 8 * hh;
    bf16x8 qf[4];
#pragma unroll
    for (int ks = 0; ks < 4; ++ks) qf[ks] = *(const bf16x8*)(qp + 16 * ks);
    const int pq = posL[tq];
    f32x16 O[2];
#pragma unroll
    for (int db = 0; db < 2; ++db)
#pragma unroll
        for (int t = 0; t < 16; ++t) O[db][t] = 0.f;
    float m = -1.0e29f, l = 0.f;
    const bf16* kcol = K1N + (size_t)b * SEQ * 3072 + g * 1024 + head * 64 + 8 * hh;
    const bf16* vbase = VT1 + ((size_t)((b * 3 + g) * 1024 + head * 64 + c)) * SEQ + rho * nsub + 8 * hh;
    const int pc = kperm(c), nq = n0 + c;
    bf16x8 kf[5][4], vf[5][4];
#pragma unroll
    for (int ti = 0; ti < 5; ++ti) { const int kb = n0 - 128 + 32 * ti, kbc = kb < 0 ? 0 : kb;
        const bf16* kp = kcol + (size_t)(((kbc + pc) << lr) + rho) * 3072;
#pragma unroll
        for (int ks = 0; ks < 4; ++ks) kf[ti][ks] = *(const bf16x8*)(kp + 16 * ks);
#pragma unroll
        for (int db = 0; db < 2; ++db) { vf[ti][2 * db] = *(const bf16x8*)(vbase + (size_t)(32 * db) * SEQ + kbc); vf[ti][2 * db + 1] = *(const bf16x8*)(vbase + (size_t)(32 * db) * SEQ + kbc + 16); } }
#pragma unroll
    for (int ti = 0; ti < 5; ++ti) {
        const int kb = n0 - 128 + 32 * ti;
        if (kb < 0) continue;
        f32x16 S;
#pragma unroll
        for (int t = 0; t < 16; ++t) S[t] = 0.f;
#pragma unroll
        for (int ks = 0; ks < 4; ++ks) S = MFMA32(kf[ti][ks], qf[ks], S);
        float s[16]; float mx = -1.0e29f;
#pragma unroll
        for (int t = 0; t < 16; ++t) { const int nk = kb + (t & 7) + 8 * hh + 16 * (t >> 3);
            int idx = pq - posL[(nk << lr) + rho]; idx = idx < 0 ? 0 : (idx > 2047 ? 2047 : idx);
            const float v = S[t] + tab[idx];
            s[t] = (nk <= nq && nk >= nq - 128) ? v : -1.0e30f; mx = fmaxf(mx, s[t]); }
        mx = fmaxf(mx, __shfl_xor(mx, 32));
        const float mnew = fmaxf(m, mx);
        float p[16]; float ls = 0.f;
#pragma unroll
        for (int t = 0; t < 16; ++t) { p[t] = __builtin_amdgcn_exp2f(s[t] - mnew); ls += p[t]; }
        if (!__all(mnew == m)) { const float alpha = __builtin_amdgcn_exp2f(m - mnew); l *= alpha;
#pragma unroll
            for (int db = 0; db < 2; ++db)
#pragma unroll
                for (int t = 0; t < 16; ++t) O[db][t] *= alpha; }
        l += ls; m = mnew;
        const bf16x8 pf0 = pack8(p[0], p[1], p[2], p[3], p[4], p[5], p[6], p[7]), pf1 = pack8(p[8], p[9], p[10], p[11], p[12], p[13], p[14], p[15]);
#pragma unroll
        for (int db = 0; db < 2; ++db) { O[db] = MFMA32(vf[ti][2 * db], pf0, O[db]); O[db] = MFMA32(vf[ti][2 * db + 1], pf1, O[db]); }
    }
    l += __shfl_xor(l, 32);
    const float inv = 1.0f / l;
    bf16* op = OG + tokq * 3072 + g * 1024 + head * 64 + 4 * hh;
#pragma unroll
    for (int db = 0; db < 2; ++db)
#pragma unroll
        for (int gg = 0; gg < 4; ++gg) { v2u w2; w2.x = pk2(O[db][4 * gg] * inv, O[db][4 * gg + 1] * inv); w2.y = pk2(O[db][4 * gg + 2] * inv, O[db][4 * gg + 3] * inv); *(v2u*)(op + 32 * db + 8 * gg) = w2; }
    if (hh == 0) LSE[tokq * 48 + g * 16 + head] = m + __builtin_amdgcn_logf(l);
}
__device__ __forceinline__ void p13_merge(Frame& F) {
    const bf16* OG = (const bf16*)(F.ws + WS_OG); const float* LSE = (const float*)(F.ws + WS_LSE); bf16* O1 = (bf16*)(F.ws + WS_O1);
    const int gt = F.bid * (NWAVES * 64) + F.tid, NT = F.G * NWAVES * 64;
    for (int i = gt; i < MTOK * 128; i += NT) { const int tok = i >> 7, c8 = i & 127, head = c8 >> 3;
        const float l0 = LSE[(size_t)tok * 48 + head], l1 = LSE[(size_t)tok * 48 + 16 + head], l2 = LSE[(size_t)tok * 48 + 32 + head];
        const float mm = fmaxf(l0, fmaxf(l1, l2)); float w0 = __builtin_amdgcn_exp2f(l0 - mm), w1 = __builtin_amdgcn_exp2f(l1 - mm), w2 = __builtin_amdgcn_exp2f(l2 - mm);
        const float inv = 1.0f / (w0 + w1 + w2); w0 *= inv; w1 *= inv; w2 *= inv;
        const v4u a = *(const v4u*)(OG + (size_t)tok * 3072 + c8 * 8), bb = *(const v4u*)(OG + (size_t)tok * 3072 + 1024 + c8 * 8), cc = *(const v4u*)(OG + (size_t)tok * 3072 + 2048 + c8 * 8);
        v4u o;
        o.x = pk2(w0 * bflo(a.x) + w1 * bflo(bb.x) + w2 * bflo(cc.x), w0 * bfhi(a.x) + w1 * bfhi(bb.x) + w2 * bfhi(cc.x));
        o.y = pk2(w0 * bflo(a.y) + w1 * bflo(bb.y) + w2 * bflo(cc.y), w0 * bfhi(a.y) + w1 * bfhi(bb.y) + w2 * bfhi(cc.y));
        o.z = pk2(w0 * bflo(a.z) + w1 * bflo(bb.z) + w2 * bflo(cc.z), w0 * bfhi(a.z) + w1 * bfhi(bb.z) + w2 * bfhi(cc.z));
        o.w = pk2(w0 * bflo(a.w) + w1 * bflo(bb.w) + w2 * bflo(cc.w), w0 * bfhi(a.w) + w1 * bfhi(bb.w) + w2 * bfhi(cc.w));
        *(v4u*)(O1 + (size_t)tok * 1024 + c8 * 8) = o; }
}

__device__ __forceinline__ void p15_norm_route(Frame& F, const Args& A) {
    const float* X = A.out; const float* MOD = (const float*)(F.ws + WS_MOD); bf16* HA = (bf16*)(F.ws + WS_HA);
    const float* g = (const float*)A.in[7] + DM; const float* router = (const float*)A.in[23]; const float* rb = (const float*)A.in[24];
    int* r_exp = (int*)(F.ws + WS_ROUTE); int* r_pos = r_exp + 2 * MTOK; float* r_gate = (float*)(r_pos + 2 * MTOK);
    LAS float* RT = (LAS float*)F.lds;
    __syncthreads();
    for (int i = F.tid; i < DM * NEXP; i += NWAVES * 64) RT[(i & 7) * DM + (i >> 3)] = router[i];
    __syncthreads();
    const int gw = F.bid * NWAVES + F.wave, NGW = F.G * NWAVES;
    for (int row = gw; row < MTOK; row += NGW) { const int b = row >> 11;
        f32x4 v[8]; const float* xr = X + (size_t)row * DM + 4 * F.lane;
#pragma unroll
        for (int j = 0; j < 8; ++j) v[j] = *(const f32x4*)(xr + 256 * j);
        const float rstd = row_rstd(v);
        const float* sh = MOD + (size_t)b * NMOD + 12288 + 6144; const float* sc = MOD + (size_t)b * NMOD + 12288 + 8192;
        float lg[8];
#pragma unroll
        for (int e = 0; e < 8; ++e) lg[e] = 0.f;
        bf16* orow = HA + (size_t)row * DM;
#pragma unroll
        for (int j = 0; j < 8; ++j) { const int col = 4 * F.lane + 256 * j;
            const f32x4 gg = *(const f32x4*)(g + col), s1 = *(const f32x4*)(sc + col), s0 = *(const f32x4*)(sh + col);
            const f32x4 y = v[j] * rstd * gg * (s1 + 1.0f) + s0;
            v2u w; w.x = pk2(y.x, y.y); w.y = pk2(y.z, y.w); *(v2u*)(orow + col) = w;
#pragma unroll
            for (int e = 0; e < 8; ++e) { const f32x4 rr = *(const LAS f32x4*)(RT + e * DM + col); lg[e] += (y.x * rr.x + y.y * rr.y) + (y.z * rr.z + y.w * rr.w); }
            asm volatile("" ::: "memory"); }
#pragma unroll
        for (int e = 0; e < 8; ++e) lg[e] = wave_sum(lg[e]) + rb[e];
        int e0 = 0; float v0 = lg[0];
#pragma unroll
        for (int e = 1; e < 8; ++e) if (lg[e] > v0) { v0 = lg[e]; e0 = e; }
        int e1 = -1; float v1 = -3.0e38f;
#pragma unroll
        for (int e = 0; e < 8; ++e) if (e != e0 && lg[e] > v1) { v1 = lg[e]; e1 = e; }
        const float g1 = 1.0f / (1.0f + __expf(v0 - v1)), g0 = 1.0f - g1;
        if (F.lane == 0) {
            const unsigned p0 = __hip_atomic_fetch_add((unsigned*)(F.ctl + CW_CNT + 64 * e0), 1u, RLX_AGENT);
            const unsigned p1 = __hip_atomic_fetch_add((unsigned*)(F.ctl + CW_CNT + 64 * e1), 1u, RLX_AGENT);
            r_exp[2 * row] = e0; r_exp[2 * row + 1] = e1; r_pos[2 * row] = (int)p0; r_pos[2 * row + 1] = (int)p1; r_gate[2 * row] = g0; r_gate[2 * row + 1] = g1;
        }
    }
}
__device__ __forceinline__ void moe_offsets(Frame& F, int (&off)[9]) {
    off[0] = 0;
#pragma unroll
    for (int e = 0; e < 8; ++e) { const unsigned cnt = __hip_atomic_load((unsigned*)(F.ctl + CW_CNT + 64 * e), RLX_AGENT); off[e + 1] = off[e] + (int)((cnt + 255u) & ~255u); }
}
__device__ __forceinline__ void p16_gather(Frame& F) {
    const bf16* HA = (const bf16*)(F.ws + WS_HA); bf16* AS = (bf16*)(F.ws + WS_AS); float* RG = (float*)(F.ws + WS_RG); int* TR = (int*)(F.ws + WS_TR);
    const int* r_exp = (const int*)(F.ws + WS_ROUTE); const int* r_pos = r_exp + 2 * MTOK; const float* r_gate = (const float*)(r_pos + 2 * MTOK);
    int off[9]; moe_offsets(F, off);
    const int gw = F.bid * NWAVES + F.wave, NGW = F.G * NWAVES;
    for (int idx = gw; idx < 2 * MTOK; idx += NGW) {
        const int e = r_exp[idx], p = r_pos[idx]; int base = 0;
#pragma unroll
        for (int k = 1; k < 8; ++k) base = (e >= k) ? off[k] : base;
        const int row = base + p, tok = idx >> 1;
        const v4u* src = (const v4u*)(HA + (size_t)tok * DM) + F.lane; v4u* dst = (v4u*)(AS + (size_t)row * DM) + F.lane;
        const v4u a = src[0], b2 = src[64], c2 = src[128], d2 = src[192];
        dst[0] = a; dst[64] = b2; dst[128] = c2; dst[192] = d2;
        if (F.lane == 0) { RG[row] = r_gate[idx]; TR[idx] = row; }
    }
}
__device__ __forceinline__ void p19_final(Frame& F, const Args& A) {
    float* X = A.out; const float* MOD = (const float*)(F.ws + WS_MOD); const bf16* Y = (const bf16*)(F.ws + WS_Y); const int* TR = (const int*)(F.ws + WS_TR);
    constexpr size_t PS = (WS_Y2 - WS_Y) / 2;
    const int gw = F.bid * NWAVES + F.wave, NGW = F.G * NWAVES;
    for (int row = gw; row < MTOK; row += NGW) { const int b = row >> 11; const int r0 = TR[2 * row], r1 = TR[2 * row + 1];
        const float* gt = MOD + (size_t)b * NMOD + 12288 + 10240 + 8 * F.lane;
        float* xr = X + (size_t)row * DM + 8 * F.lane; const bf16* y0 = Y + (size_t)r0 * DM + 8 * F.lane; const bf16* y1 = Y + (size_t)r1 * DM + 8 * F.lane;
#pragma unroll
        for (int j = 0; j < 4; ++j) { const v4u a = *(const v4u*)(y0 + 512 * j), a2 = *(const v4u*)(y0 + PS + 512 * j), c2 = *(const v4u*)(y1 + 512 * j), c3 = *(const v4u*)(y1 + PS + 512 * j);
            const f32x4 x0 = *(const f32x4*)(xr + 512 * j), x1 = *(const f32x4*)(xr + 512 * j + 4), g0 = *(const f32x4*)(gt + 512 * j), g1 = *(const f32x4*)(gt + 512 * j + 4);
            f32x4 s0v, s1v;
            s0v.x = (bflo(a.x) + bflo(a2.x)) + (bflo(c2.x) + bflo(c3.x)); s0v.y = (bfhi(a.x) + bfhi(a2.x)) + (bfhi(c2.x) + bfhi(c3.x));
            s0v.z = (bflo(a.y) + bflo(a2.y)) + (bflo(c2.y) + bflo(c3.y)); s0v.w = (bfhi(a.y) + bfhi(a2.y)) + (bfhi(c2.y) + bfhi(c3.y));
            s1v.x = (bflo(a.z) + bflo(a2.z)) + (bflo(c2.z) + bflo(c3.z)); s1v.y = (bfhi(a.z) + bfhi(a2.z)) + (bfhi(c2.z) + bfhi(c3.z));
            s1v.z = (bflo(a.w) + bflo(a2.w)) + (bflo(c2.w) + bflo(c3.w)); s1v.w = (bfhi(a.w) + bfhi(a2.w)) + (bfhi(c2.w) + bfhi(c3.w));
            *(f32x4*)(xr + 512 * j) = x0 + g0 * s0v; *(f32x4*)(xr + 512 * j + 4) = x1 + g1 * s1v; }
    }
}

constexpr int N_PHASES = 20;
__global__ void __launch_bounds__(NWAVES * 64, 2) yoco_fwd(Args args) {
    extern __shared__ __attribute__((aligned(16))) unsigned char lds[];
    Frame F;
    F.lds = (LAS unsigned char*)lds; F.MISC = (volatile LAS unsigned*)(F.lds + MISC_OFF);
    F.tid = threadIdx.x; F.lane = F.tid & 63; F.wave = __builtin_amdgcn_readfirstlane(F.tid >> 6); F.G = gridDim.x; F.bid = blockIdx.x;
    F.ws = args.ws; F.ctl = (gu32*)(args.ws + WS_CTL);
    for (int u = F.tid; u < (LDS_BYTES - LDSCTL_OFF) / 4; u += NWAVES * 64) ((LAS unsigned*)(F.lds + LDSCTL_OFF))[u] = 0u;
    __syncthreads();
    const int lo = args.ph_lo, hi = args.ph_hi;
    const bool one_launch = (hi - lo) > 1;
    XcdBarrier bar; bar.bar = (unsigned*)(F.ctl + CW_BAR); bar.x = 0; bar.st = nullptr;
    if (one_launch) bar = xcd_barrier_post((unsigned*)(F.ctl + CW_BAR), F.MISC + 8);
    int cv_cur = F.bid * NWAVES + F.wave;
#define IN(k) (lo <= (k) && (k) < hi)
#define SEAM(k) do { if (IN(k) && IN((k) + 1)) xcd_barrier(bar); } while (0)
#define TAIL_FILL(nunits, budget) do { if (one_launch) { const int nu_ = (nunits), rounds_ = (nu_ + F.G - 1) / F.G, nlast_ = nu_ - (rounds_ - 1) * F.G; \
        if (nlast_ < F.G && F.bid >= nlast_) cv_cur = conv_fixed(F, args, cv_cur, (budget)); } } while (0)
#define CONV_BEGIN(k) if (IN(k)) {
#define CONV_END(k)   }
    const float* const MODc = (const float*)(F.ws + WS_MOD);
    bf16* const HA = (bf16*)(F.ws + WS_HA);

    if (IN(0)) { p0_prologue(F, args); } SEAM(0);
    CONV_BEGIN(1) normmod_phase(F, (const float*)args.in[0], (const float*)args.in[6], MODc + 0, MODc + 2048, HA); CONV_END(1) SEAM(1);
    CONV_BEGIN(2) pg8::Gemm g{HA, (const bf16*)(F.ws + WS_WIN), MTOK, A_INP, DM, DM}; pg8::StaticOrder S; S.init(MTOK, A_INP, F.G, F.bid);
        pg8::EpiBf16Sel E{(bf16*)(F.ws + WS_P0), A_INP, nullptr, 0, 0, 1 << 30};
        pg8::gemm_phase<pg8::EpiBf16Sel, pg8::StaticOrder, true, true>(F.lds + RING_OFF, g, S, E); TAIL_FILL(S.nwg, 9); CONV_END(2) SEAM(2);
    CONV_BEGIN(3) p3_qknorm(F, args); p3_vtrans(F);
        { const int gw = F.bid * NWAVES + F.wave, NGW = F.G * NWAVES;
          for (int q = gw; q < MTOK / 4; q += NGW) {
            const int s0 = q, s1 = MTOK / 2 - 1 - q;
            p3_indexer_pair(F, (s0 & 3) * 1024 + (s0 >> 2)); p3_indexer_pair(F, (s1 & 3) * 1024 + (s1 >> 2)); } } CONV_END(3) SEAM(3);
    CONV_BEGIN(4) for (int r = 0, base = 0; base < 512; ++r, base += F.G) { const int i = base + ((r & 1) ? F.G - 1 - F.bid : F.bid); if (i < 512) p4_attn_item(F, args, ((31 - (i >> 4)) << 4) | (i & 15)); } __syncthreads(); CONV_END(4) SEAM(4);
    if (IN(5)) { pg8::Gemm g{(const bf16*)(F.ws + WS_O), (const bf16*)(F.ws + WS_WAOUT), MTOK, DM, DM, DM}; pg8::StaticOrder S; S.init(MTOK, DM, F.G, F.bid);
        pg8::EpiResGate E{(const float*)args.in[0], args.out, MODc + 4096, NMOD};
        pg8::gemm_phase<pg8::EpiResGate, pg8::StaticOrder, false, true>(F.lds + RING_OFF, g, S, E); } SEAM(5);
    CONV_BEGIN(6) normmod_phase(F, args.out, (const float*)args.in[7], MODc + 6144, MODc + 8192, HA); CONV_END(6) SEAM(6);
    CONV_BEGIN(7) pg8::Gemm g{HA, (const bf16*)(F.ws + WS_WF13), MTOK, 2 * DFF, DM, DM}; pg8::StaticOrder S; S.init(MTOK, 2 * DFF, F.G, F.bid);
        pg8::EpiSwiGLU E{(bf16*)(F.ws + WS_U), DFF, 2 * DFF / 256};
        pg8::gemm_phase<pg8::EpiSwiGLU, pg8::StaticOrder, true, true>(F.lds + RING_OFF, g, S, E); TAIL_FILL(S.nwg, 12); CONV_END(7) SEAM(7);
    if (IN(8)) { pg8::Gemm g{(const bf16*)(F.ws + WS_U), (const bf16*)(F.ws + WS_WF2), MTOK, DM, DFF, DFF}; pg8::StaticOrder S; S.init(MTOK, DM, F.G, F.bid);
        pg8::EpiResGate E{args.out, args.out, MODc + 10240, NMOD};
        pg8::gemm_phase<pg8::EpiResGate, pg8::StaticOrder, false, true>(F.lds + RING_OFF, g, S, E); } SEAM(8);
    CONV_BEGIN(9) const float* X = args.out; const float* gk = (const float*)args.in[14]; const float* ga = (const float*)args.in[6] + DM;
        const int gw = F.bid * NWAVES + F.wave, NGW = F.G * NWAVES;
        for (int row = gw; row < MTOK; row += NGW) { const int b = row >> 11;
            f32x4 v[8]; const float* xr = X + (size_t)row * DM + 4 * F.lane;
#pragma unroll
            for (int j = 0; j < 8; ++j) v[j] = *(const f32x4*)(xr + 256 * j);
            const float rstd = row_rstd(v);
            modulate_store(v, rstd, gk, MODc + (size_t)b * NMOD + 24576, MODc + (size_t)b * NMOD + 24576 + 2048, HA + (size_t)row * DM, F.lane);
            modulate_store(v, rstd, ga, MODc + (size_t)b * NMOD + 12288, MODc + (size_t)b * NMOD + 12288 + 2048, HA + (size_t)(MTOK + row) * DM, F.lane); } CONV_END(9) SEAM(9);
    CONV_BEGIN(10) pg8::Gemm g{HA, (const bf16*)(F.ws + WS_WKVQ), 2 * MTOK, 9216, DM, DM}; pg8::DualOrder S; S.init(MTOK / 256, 24, 12, MTOK / 256, 24, F.G, F.bid);
        pg8::EpiBf16Sel E{(bf16*)(F.ws + WS_KV), 6144, (bf16*)(F.ws + WS_Q1), 3072, MTOK / 256, 24};
        pg8::gemm_phase<pg8::EpiBf16Sel, pg8::DualOrder, true, true>(F.lds + RING_OFF, g, S, E); TAIL_FILL(S.ntot, 12); CONV_END(10) SEAM(10);
    CONV_BEGIN(11) p11_qknorm(F, args); p11_vtrans(F); CONV_END(11) SEAM(11);
    CONV_BEGIN(12) for (int item = F.bid; item < NB * 3 * 16 * 8; item += F.G) p12_attn_item(F, args, item); __syncthreads(); CONV_END(12) SEAM(12);
    CONV_BEGIN(13) p13_merge(F); CONV_END(13) SEAM(13);
    if (IN(14)) { pg8::Gemm g{(const bf16*)(F.ws + WS_O1), (const bf16*)(F.ws + WS_WBOUT), MTOK, DM, 1024, 1024}; pg8::StaticOrder S; S.init(MTOK, DM, F.G, F.bid);
        pg8::EpiResGate E{args.out, args.out, MODc + 12288 + 4096, NMOD};
        pg8::gemm_phase<pg8::EpiResGate, pg8::StaticOrder, false, true>(F.lds + RING_OFF, g, S, E); } SEAM(14);
    CONV_BEGIN(15) p15_norm_route(F, args); CONV_END(15)
    if (IN(15) && F.lane == 0) __hip_atomic_store((unsigned*)(F.ctl + CW_CUR + F.bid * NWAVES + F.wave), (unsigned)cv_cur, RLX_AGENT);
    SEAM(15);
    if (IN(16)) { p16_gather(F); conv_drain(F, args); } SEAM(16);
    if (IN(17)) { int off[9]; moe_offsets(F, off); pg8::MoeOrder S;
#pragma unroll
        for (int e = 0; e < 9; ++e) S.toff[e] = off[e] >> 8;
        S.nN = 2 * DFFE / 256; S.T = S.toff[8]; S.total = S.T * S.nN; S.G = F.G; S.c = F.bid; S.ksplit = 1; S.klen = DM;
        pg8::Gemm g{(const bf16*)(F.ws + WS_AS), (const bf16*)(F.ws + WS_WM13), MROWS, 2 * DFFE, DM, DM};
        pg8::EpiSwiGLU E{(bf16*)(F.ws + WS_UM), DFFE, 2 * DFFE / 256};
        pg8::gemm_phase<pg8::EpiSwiGLU, pg8::MoeOrder, true, true>(F.lds + RING_OFF, g, S, E); } SEAM(17);
    if (IN(18)) { int off[9]; moe_offsets(F, off); pg8::MoeOrder S;
#pragma unroll
        for (int e = 0; e < 9; ++e) S.toff[e] = off[e] >> 8;
        S.nN = DM / 256; S.T = S.toff[8]; S.total = S.T * S.nN * 2; S.G = F.G; S.c = F.bid; S.ksplit = 2; S.klen = DFFE / 2;
        pg8::Gemm g{(const bf16*)(F.ws + WS_UM), (const bf16*)(F.ws + WS_WM2), MROWS, DM, DFFE, DFFE / 2};
        pg8::EpiRowScale E{(bf16*)(F.ws + WS_Y), (const float*)(F.ws + WS_RG), DM / 256, (size_t)(WS_Y2 - WS_Y) / 2};
        pg8::gemm_phase<pg8::EpiRowScale, pg8::MoeOrder, true, true>(F.lds + RING_OFF, g, S, E); } SEAM(18);
    if (IN(19)) { p19_final(F, args); }
#undef IN
#undef SEAM
#undef CONV_BEGIN
#undef CONV_END
#undef TAIL_FILL
}

#ifndef MK_PER_PHASE
#define MK_PER_PHASE 0
#endif
extern "C" void kernel_launch(void* const* d_in, const int* in_sizes, int n_in, void* d_out, int out_size, void* d_ws, size_t ws_size, hipStream_t stream) {
    static int grid = 0;
    if (grid == 0) {
        if (n_in != 28 || out_size != MTOK * DM || ws_size < WS_END) { fprintf(stderr, "kernel_launch: unexpected shapes (n_in %d, out %d, ws %zu < %zu)\n", n_in, out_size, ws_size, (size_t)WS_END); grid = -1; return; }
        int dev = 0, cus = 0, per_cu = 0;
        if (hipGetDevice(&dev) != hipSuccess || hipDeviceGetAttribute(&cus, hipDeviceAttributeMultiprocessorCount, dev) != hipSuccess) { grid = -1; return; }
        if (hipFuncSetAttribute((const void*)yoco_fwd, hipFuncAttributeMaxDynamicSharedMemorySize, LDS_BYTES) != hipSuccess) { fprintf(stderr, "kernel_launch: hipFuncSetAttribute failed\n"); grid = -1; return; }
        if (hipOccupancyMaxActiveBlocksPerMultiprocessor(&per_cu, (const void*)yoco_fwd, NWAVES * 64, LDS_BYTES) != hipSuccess || per_cu < 1) fprintf(stderr, "kernel_launch: occupancy query reports %d\n", per_cu);
        (void)hipGetLastError();
        grid = cus;
    }
    if (grid < 0) return;
    if (hipMemsetAsync((char*)d_ws + WS_CTL, 0, CTL_ZERO_BYTES, stream) != hipSuccess) return;
    Args a{};
    for (int i = 0; i < 28; ++i) a.in[i] = d_in[i];
    a.out = (float*)d_out; a.ws = (unsigned char*)d_ws;
#if MK_PER_PHASE
    for (int p = 0; p < N_PHASES; ++p) { a.ph_lo = p; a.ph_hi = p + 1; hipLaunchKernelGGL(yoco_fwd, dim3(grid), dim3(NWAVES * 64), LDS_BYTES, stream, a); }
#else
    a.ph_lo = 0; a.ph_hi = N_PHASES;
    hipLaunchKernelGGL(yoco_fwd, dim3(grid), dim3(NWAVES * 64), LDS_BYTES, stream, a);
#endif
    const hipError_t le = hipPeekAtLastError();
    if (le != hipSuccess) fprintf(stderr, "kernel_launch: launch failed: %s\n", hipGetErrorName(le));
}
```

```cpp
#include <hip/hip_runtime.h>
#include <cstdio>
#include <cstdint>
namespace pg8 {
#define PG8_LAS __attribute__((address_space(3)))
typedef unsigned short bf16_t;
typedef short bf16x8 __attribute__((ext_vector_type(8)));
typedef float f32x4 __attribute__((ext_vector_type(4)));
typedef unsigned u32x4 __attribute__((ext_vector_type(4)));
constexpr int BM = 256, BK = 64, HALF = 128, HTB = HALF * BK * 2  , STAGE_BYTES = 8 * HTB, NXCD = 8, WGM = 8;

__host__ __device__ __forceinline__ int lds_byte(int r, int c) { const int st = (r >> 4) * 2 + (c >> 5), rr = r & 15, cc = c & 31, ob = rr * 64 + cc * 2; return st * 1024 + (ob ^ (((ob >> 9) & 1) << 5)); }
__host__ __device__ __forceinline__ void stage_rc(int b, int& R, int& C) { const int st = b / 1024, sb = b % 1024, swz = sb ^ (((sb >> 9) & 1) << 5); R = (st >> 1) * 16 + swz / 64; C = (st & 1) * 32 + (swz % 64) / 2; }
__host__ __device__ __forceinline__ int perm32(int rho) { const int n = rho >> 4, i = rho & 15; return 8 * (i >> 2) + 4 * n + (i & 3); }

struct Unit { int pm, pn, kofs; };
struct Gemm { const bf16_t* A; const bf16_t* Bt; int M, N, K, Kext; };

__device__ __forceinline__ void tile_map(int L, int nM, int nN, int& pm, int& pn) {
    const int nwg = nM * nN; int wgid = L;
    { const int q = nwg / NXCD, r = nwg % NXCD, xcd = wgid % NXCD, off = wgid / NXCD; wgid = (xcd < r ? xcd * (q + 1) : r * (q + 1) + (xcd - r) * q) + off; }
    const int nig = WGM * nN, gid = wgid / nig, fm = gid * WGM, gsz = (nM - fm) < WGM ? (nM - fm) : WGM;
    pm = fm + ((wgid % nig) % gsz); pn = (wgid % nig) / gsz;
}
struct StaticOrder {
    int nM, nN, nwg, G, c;
    __device__ void init(int M, int N, int G_, int c_) { nM = M / BM; nN = N / BM; nwg = nM * nN; G = G_; c = c_; }
    __device__ bool next(int i, Unit& u) const { const long L = (long)i * G + c; if (L >= nwg) return false; tile_map((int)L, nM, nN, u.pm, u.pn); u.kofs = 0; return true; }
    __device__ __forceinline__ void a_ready(const Unit&) const {}
    __device__ __forceinline__ void done(const Unit&) const {}
};
struct DualOrder {
    int nM, nN1, nN2, n1, ntot, pm_off, pn_off, G, c;
    __device__ void init(int nM_, int nN1_, int nN2_, int pm_off_, int pn_off_, int G_, int c_) { nM = nM_; nN1 = nN1_; nN2 = nN2_; n1 = nM * nN1; ntot = n1 + nM * nN2; pm_off = pm_off_; pn_off = pn_off_; G = G_; c = c_; }
    __device__ bool next(int i, Unit& u) const { const long L = (long)i * G + c; if (L >= ntot) return false;
        if (L < n1) tile_map((int)L, nM, nN1, u.pm, u.pn); else { tile_map((int)L - n1, nM, nN2, u.pm, u.pn); u.pm += pm_off; u.pn += pn_off; } u.kofs = 0; return true; }
    __device__ __forceinline__ void a_ready(const Unit&) const {}
    __device__ __forceinline__ void done(const Unit&) const {}
};
struct MoeOrder {
    int toff[9]; int nN, T, total, G, c, ksplit, klen;
    __device__ bool next(int i, Unit& u) const {
        long v;
        if ((G & 7) == 0) { const int x = c & 7, j = c >> 3, nper = G >> 3; const long s0 = ((long)x * total) >> 3, s1 = ((long)(x + 1) * total) >> 3; v = s0 + (long)i * nper + j; if (v >= s1) return false; }
        else { v = (long)i * G + c; if (v >= total) return false; }
        const int per = nN * ksplit;
        int e = 0, te = 0, te1 = toff[1];
#pragma unroll
        for (int k = 1; k < 8; ++k) { const bool ge = v >= (long)toff[k] * per; e = ge ? k : e; te = ge ? toff[k] : te; te1 = ge ? toff[k + 1] : te1; }
        const int r = (int)(v - (long)te * per), ne = te1 - te, q = r / ne, kh = q % ksplit;
        u.pm = te + r % ne; u.pn = e * nN + q / ksplit; u.kofs = kh * klen; return true; }
    __device__ __forceinline__ void a_ready(const Unit&) const {}
    __device__ __forceinline__ void done(const Unit&) const {}
};

__device__ __forceinline__ unsigned cvt_pk_bf16(float lo, float hi) { unsigned r; asm volatile("v_cvt_pk_bf16_f32 %0, %1, %2" : "=v"(r) : "v"(lo), "v"(hi)); return r; }

struct EpiBf16Sel {
    static constexpr bool PERM = true, AFTER_DRAIN = false;
    bf16_t* O0; int ld0; bf16_t* O1; int ld1; int pm_split, pn_split;
    __device__ __forceinline__ void operator()(const f32x4 (&acc)[2][2][4][2], const Unit& u, int wr, int wc, int fr, int fq) const {
        bf16_t* base = O0; int ldc = ld0, pm = u.pm, pn = u.pn;
        if (pn >= pn_split) { base = O1; ldc = ld1; pm -= pm_split; pn -= pn_split; }
        const int row0 = pm * BM + wr * 64 + fr, col0 = pn * BM + wc * 32 + 8 * fq;
#pragma unroll
        for (int ai = 0; ai < 2; ++ai)
#pragma unroll
            for (int m = 0; m < 4; ++m) { bf16_t* rowp = base + (size_t)(row0 + ai * HALF + m * 16) * ldc + col0;
#pragma unroll
                for (int bj = 0; bj < 2; ++bj) { const f32x4 v0 = acc[ai][bj][m][0], v1 = acc[ai][bj][m][1];
                    u32x4 w; w.x = cvt_pk_bf16(v0[0], v0[1]); w.y = cvt_pk_bf16(v0[2], v0[3]); w.z = cvt_pk_bf16(v1[0], v1[1]); w.w = cvt_pk_bf16(v1[2], v1[3]);
                    *(u32x4*)(rowp + bj * HALF) = w; } }
    }
};
struct EpiResGate {
    static constexpr bool PERM = false, AFTER_DRAIN = false;
    const float* base; float* out; const float* gate; int gstride;
    __device__ __forceinline__ void operator()(const f32x4 (&acc)[2][2][4][2], const Unit& u, int wr, int wc, int fr, int fq) const {
        const int row0 = u.pm * BM + wr * 64 + fr, col0 = u.pn * BM + wc * 32 + 4 * fq;
        const float* gp = gate + (size_t)(u.pm >> 3) * gstride + col0;
        f32x4 gv[2][2];
#pragma unroll
        for (int bj = 0; bj < 2; ++bj)
#pragma unroll
            for (int n = 0; n < 2; ++n) gv[bj][n] = *(const f32x4*)(gp + bj * HALF + n * 16);
#pragma unroll
        for (int ai = 0; ai < 2; ++ai)
#pragma unroll
            for (int m = 0; m < 4; ++m) { const size_t off = (size_t)(row0 + ai * HALF + m * 16) * 2048 + col0;
#pragma unroll
                for (int bj = 0; bj < 2; ++bj)
#pragma unroll
                    for (int n = 0; n < 2; ++n) { const f32x4 bs = *(const f32x4*)(base + off + bj * HALF + n * 16); *(f32x4*)(out + off + bj * HALF + n * 16) = bs + gv[bj][n] * acc[ai][bj][m][n]; }
                asm volatile("" ::: "memory"); }
    }
};
struct EpiSwiGLU {
    static constexpr bool PERM = true, AFTER_DRAIN = false;
    bf16_t* O; int ldc; int nN;
    __device__ __forceinline__ void operator()(const f32x4 (&acc)[2][2][4][2], const Unit& u, int wr, int wc, int fr, int fq) const {
        const int row0 = u.pm * BM + wr * 64 + fr, col0 = (u.pn % nN) * HALF + wc * 32 + 8 * fq;
#pragma unroll
        for (int ai = 0; ai < 2; ++ai)
#pragma unroll
            for (int m = 0; m < 4; ++m) { bf16_t* rowp = O + (size_t)(row0 + ai * HALF + m * 16) * ldc + col0;
                float r[8];
#pragma unroll
                for (int n = 0; n < 2; ++n)
#pragma unroll
                    for (int j = 0; j < 4; ++j) { const float g = acc[ai][0][m][n][j], up = acc[ai][1][m][n][j];
                        r[4 * n + j] = g * up * __builtin_amdgcn_rcpf(1.0f + __builtin_amdgcn_exp2f(-1.4426950408889634f * g)); }
                u32x4 w; w.x = cvt_pk_bf16(r[0], r[1]); w.y = cvt_pk_bf16(r[2], r[3]); w.z = cvt_pk_bf16(r[4], r[5]); w.w = cvt_pk_bf16(r[6], r[7]);
                *(u32x4*)rowp = w; }
    }
};
struct EpiRowScale {
    static constexpr bool PERM = true, AFTER_DRAIN = false;
    bf16_t* Y; const float* rs; int nN; size_t part_stride;
    __device__ __forceinline__ void operator()(const f32x4 (&acc)[2][2][4][2], const Unit& u, int wr, int wc, int fr, int fq) const {
        const int row0 = u.pm * BM + wr * 64 + fr, col0 = (u.pn % nN) * BM + wc * 32 + 8 * fq;
        bf16_t* Yp = Y + (u.kofs ? part_stride : 0);
#pragma unroll
        for (int ai = 0; ai < 2; ++ai)
#pragma unroll
            for (int m = 0; m < 4; ++m) { const int row = row0 + ai * HALF + m * 16; const float s = rs[row]; bf16_t* rowp = Yp + (size_t)row * 2048 + col0;
#pragma unroll
                for (int bj = 0; bj < 2; ++bj) { const f32x4 v0 = acc[ai][bj][m][0] * s, v1 = acc[ai][bj][m][1] * s;
                    u32x4 w; w.x = cvt_pk_bf16(v0[0], v0[1]); w.y = cvt_pk_bf16(v0[2], v0[3]); w.z = cvt_pk_bf16(v1[0], v1[1]); w.w = cvt_pk_bf16(v1[2], v1[3]);
                    *(u32x4*)(rowp + bj * HALF) = w; } }
    }
};

template <class Epi, class Sched, bool ALIGN_EPI = false, bool SP2 = false>
__device__ __forceinline__ void gemm_phase(PG8_LAS unsigned char* lds, const Gemm g, const Sched& S, const Epi& E) {
    const int tid = threadIdx.x, wid = __builtin_amdgcn_readfirstlane(tid >> 6), lane = tid & 63, wr = wid >> 2, wc = wid & 3, fr = lane & 15, fq = lane >> 4;
    const int K = g.K, nt = g.Kext / BK;
    unsigned voffA[2], voffB[2];
#pragma unroll
    for (int i = 0; i < 2; ++i) { int R, C; stage_rc(tid * 16 + i * 8192, R, C); const int Rb = Epi::PERM ? ((R & ~31) + perm32(R & 31)) : R;
        voffA[i] = (unsigned)(R * K + C) * 2u; voffB[i] = (unsigned)(Rb * K + C) * 2u; }
    const size_t kstep = (size_t)(BK * 2);
    const size_t hstep = (size_t)HALF * K * 2;
    const size_t tstep = 2 * hstep;
    const unsigned ldsw = (unsigned)wid * 1024u;
    const int aoff = lds_byte(wr * 64 + fr, fq * 8), boff = lds_byte(wc * 32 + fr, fq * 8);
#define PG8_SA(b, h) (((b) * 2 + (h)) * HTB)
#define PG8_SB(b, h) ((4 + (b) * 2 + (h)) * HTB)
#define PG8_STAGE(bufoff, gbase, voff) do { _Pragma("unroll") for (int _i = 0; _i < 2; ++_i) \
        __builtin_amdgcn_global_load_lds((const unsigned*)((const char*)(gbase) + (voff)[_i]), (PG8_LAS unsigned*)(lds + (bufoff) + ldsw + _i * 8192), 16, 0, 0); } while (0)
#define PG8_LDA(dst, b, h) do { _Pragma("unroll") for (int m = 0; m < 4; ++m) _Pragma("unroll") for (int k = 0; k < 2; ++k) dst[m][k] = *(const PG8_LAS bf16x8*)(lds + PG8_SA(b, h) + aoff + m * 2048 + k * 1024); } while (0)
#define PG8_LDB(dst, b, h) do { _Pragma("unroll") for (int n = 0; n < 2; ++n) _Pragma("unroll") for (int k = 0; k < 2; ++k) dst[n][k] = *(const PG8_LAS bf16x8*)(lds + PG8_SB(b, h) + boff + n * 2048 + k * 1024); } while (0)
#define PG8_MMA(ai, bj, At, Bt) do { __builtin_amdgcn_s_setprio(1); _Pragma("unroll") for (int m = 0; m < 4; ++m) _Pragma("unroll") for (int n = 0; n < 2; ++n) _Pragma("unroll") for (int k = 0; k < 2; ++k) \
        acc[ai][bj][m][n] = __builtin_amdgcn_mfma_f32_16x16x32_bf16(Bt[n][k], At[m][k], acc[ai][bj][m][n], 0, 0, 0); __builtin_amdgcn_s_setprio(0); } while (0)
#define PG8_WAIT_V(n) asm volatile("s_waitcnt vmcnt(" #n ")" ::: "memory")
#define PG8_WAIT_L(n) asm volatile("s_waitcnt lgkmcnt(" #n ")" ::: "memory")
#define PG8_BAR __builtin_amdgcn_s_barrier()
#define PG8_SCHED __builtin_amdgcn_sched_barrier(0)
    Unit cur, nxt; int ui = 0;
    if (!S.next(0, cur)) return;
    f32x4 acc[2][2][4][2];
#pragma unroll
    for (int a = 0; a < 2; ++a)
#pragma unroll
        for (int b = 0; b < 2; ++b)
#pragma unroll
            for (int m = 0; m < 4; ++m)
#pragma unroll
                for (int n = 0; n < 2; ++n) acc[a][b][m][n] = (f32x4){0.f, 0.f, 0.f, 0.f};
    bf16x8 At[4][2], B0[2][2], B1[2][2];
    const char* cA = (const char*)g.A + (size_t)cur.pm * tstep + (size_t)cur.kofs * 2; const char* cB = (const char*)g.Bt + (size_t)cur.pn * tstep + (size_t)cur.kofs * 2;
    S.a_ready(cur);
    if constexpr (SP2) {
        PG8_STAGE(PG8_SB(0, 0), cB, voffB); PG8_STAGE(PG8_SB(0, 1), cB + hstep, voffB); PG8_STAGE(PG8_SA(0, 0), cA, voffA); PG8_STAGE(PG8_SA(0, 1), cA + hstep, voffA);
        if (wr == 1) PG8_BAR;
        PG8_WAIT_V(2); PG8_BAR;
        PG8_STAGE(PG8_SB(1, 0), cB + kstep, voffB); PG8_STAGE(PG8_SA(1, 0), cA + kstep, voffA); PG8_STAGE(PG8_SB(1, 1), cB + hstep + kstep, voffB);
        PG8_WAIT_V(6); PG8_BAR;
    } else {
        PG8_STAGE(PG8_SB(0, 0), cB, voffB); PG8_STAGE(PG8_SA(0, 0), cA, voffA); PG8_STAGE(PG8_SB(0, 1), cB + hstep, voffB); PG8_STAGE(PG8_SA(0, 1), cA + hstep, voffA);
        if (wr == 1) PG8_BAR;
        PG8_WAIT_V(4); PG8_BAR;
        PG8_STAGE(PG8_SB(1, 0), cB + kstep, voffB); PG8_STAGE(PG8_SA(1, 0), cA + kstep, voffA); PG8_STAGE(PG8_SB(1, 1), cB + hstep + kstep, voffB);
        PG8_WAIT_V(6); PG8_BAR;
    }
    for (;;) {
        const bool has_next = S.next(ui + 1, nxt);
        const char* nA = has_next ? (const char*)g.A + (size_t)nxt.pm * tstep + (size_t)nxt.kofs * 2 : cA; const char* nB = has_next ? (const char*)g.Bt + (size_t)nxt.pn * tstep + (size_t)nxt.kofs * 2 : cB;
        for (int t = 0; t < nt; t += 2) {
            const bool last = (t == nt - 2);
            const char* a1 = cA + (size_t)(t + 1) * kstep;
            const char* a2 = last ? nA : cA + (size_t)(t + 2) * kstep; const char* b2 = last ? nB : cB + (size_t)(t + 2) * kstep;
            const char* a3 = a2 + kstep; const char* b3 = b2 + kstep;
            if (last && has_next) S.a_ready(nxt);
            if constexpr (SP2) {
            PG8_LDB(B0, 0, 0); PG8_LDB(B1, 0, 1); PG8_SCHED; PG8_LDA(At, 0, 0); PG8_STAGE(PG8_SA(1, 1), a1 + hstep, voffA);
            PG8_WAIT_V(8); PG8_WAIT_L(0); PG8_BAR; PG8_MMA(0, 0, At, B0); PG8_MMA(0, 1, At, B1); PG8_BAR; PG8_SCHED;
            PG8_LDA(At, 0, 1); PG8_STAGE(PG8_SB(0, 0), b2, voffB); PG8_STAGE(PG8_SB(0, 1), b2 + hstep, voffB); PG8_STAGE(PG8_SA(0, 0), a2, voffA);
            PG8_WAIT_V(8); PG8_WAIT_L(0); PG8_BAR; PG8_MMA(1, 0, At, B0); PG8_MMA(1, 1, At, B1); PG8_BAR; PG8_SCHED;
            PG8_LDB(B0, 1, 0); PG8_LDB(B1, 1, 1); PG8_SCHED; PG8_LDA(At, 1, 0); PG8_STAGE(PG8_SA(0, 1), a2 + hstep, voffA);
            PG8_WAIT_V(8); PG8_WAIT_L(0); PG8_BAR; PG8_MMA(0, 0, At, B0); PG8_MMA(0, 1, At, B1); PG8_BAR; PG8_SCHED;
            PG8_LDA(At, 1, 1); PG8_STAGE(PG8_SB(1, 0), b3, voffB); PG8_STAGE(PG8_SB(1, 1), b3 + hstep, voffB); PG8_STAGE(PG8_SA(1, 0), a3, voffA);
            PG8_WAIT_V(8); PG8_WAIT_L(0); PG8_BAR; PG8_MMA(1, 0, At, B0); PG8_MMA(1, 1, At, B1); PG8_BAR; PG8_SCHED;
            } else {
            PG8_LDB(B0, 0, 0); PG8_SCHED; PG8_LDA(At, 0, 0); PG8_STAGE(PG8_SA(1, 1), a1 + hstep, voffA);
            PG8_WAIT_L(8); PG8_BAR; PG8_WAIT_L(0); PG8_MMA(0, 0, At, B0); PG8_BAR; PG8_SCHED;
            PG8_LDB(B1, 0, 1); PG8_STAGE(PG8_SB(0, 0), b2, voffB);
            PG8_BAR; PG8_WAIT_L(0); PG8_MMA(0, 1, At, B1); PG8_BAR;
            PG8_LDA(At, 0, 1); PG8_STAGE(PG8_SA(0, 0), a2, voffA);
            PG8_BAR; PG8_WAIT_L(0); PG8_MMA(1, 0, At, B0); PG8_BAR; PG8_SCHED;
            PG8_STAGE(PG8_SB(0, 1), b2 + hstep, voffB);
            PG8_WAIT_V(6); PG8_BAR; PG8_MMA(1, 1, At, B1); PG8_BAR;
            PG8_LDB(B0, 1, 0); PG8_SCHED; PG8_LDA(At, 1, 0); PG8_STAGE(PG8_SA(0, 1), a2 + hstep, voffA);
            PG8_WAIT_L(8); PG8_BAR; PG8_WAIT_L(0); PG8_MMA(0, 0, At, B0); PG8_BAR; PG8_SCHED;
            PG8_LDB(B1, 1, 1); PG8_STAGE(PG8_SB(1, 0), b3, voffB);
            PG8_BAR; PG8_WAIT_L(0); PG8_MMA(0, 1, At, B1); PG8_BAR;
            PG8_LDA(At, 1, 1); PG8_STAGE(PG8_SA(1, 0), a3, voffA);
            PG8_BAR; PG8_WAIT_L(0); PG8_MMA(1, 0, At, B0); PG8_BAR; PG8_SCHED;
            PG8_STAGE(PG8_SB(1, 1), b3 + hstep, voffB);
            PG8_WAIT_V(6); PG8_BAR; PG8_MMA(1, 1, At, B1); PG8_BAR;
            }
        }
        if constexpr (ALIGN_EPI) { if (wr == 0) PG8_BAR; }
        if constexpr (!Epi::AFTER_DRAIN) { E(acc, cur, wr, wc, fr, fq); S.done(cur); }
        if (!has_next) break;
#pragma unroll
        for (int a = 0; a < 2; ++a)
#pragma unroll
            for (int b = 0; b < 2; ++b)
#pragma unroll
                for (int m = 0; m < 4; ++m)
#pragma unroll
                    for (int n = 0; n < 2; ++n) acc[a][b][m][n] = (f32x4){0.f, 0.f, 0.f, 0.f};
        cur = nxt; cA = nA; cB = nB; ++ui;
        if constexpr (ALIGN_EPI) { if (wr == 1) PG8_BAR; }
    }
    PG8_WAIT_V(0);
    if constexpr (!ALIGN_EPI) { if (wr == 0) PG8_BAR; }
    PG8_BAR;
    if constexpr (Epi::AFTER_DRAIN) { E.fused(acc, cur, wr, wc, fr, fq, lds, wid, lane); S.done(cur); }
#undef PG8_SA
#undef PG8_SB
#undef PG8_STAGE
#undef PG8_LDA
#undef PG8_LDB
#undef PG8_MMA
#undef PG8_WAIT_V
#undef PG8_WAIT_L
#undef PG8_BAR
#undef PG8_SCHED
}
}

constexpr int NB = 4, SEQ = 2048, DM = 2048, MTOK = NB * SEQ;
constexpr int A_IN = 4176, A_INP = 4352;
constexpr int C_Q = 0, C_K = 2048, C_V = 2560, C_QI = 3072, C_KI = 4096, C_WI = 4160;
constexpr int DFF = 5632, DFFE = 7168, NEXP = 8;
constexpr int NMOD = 28672;
constexpr float EPS = 1e-6f, LOG2E = 1.4426950408889634f;
constexpr int MROWS = 2 * MTOK + NEXP * 256;

constexpr size_t MiB = 1u << 20;
constexpr size_t WS_CTL = 0, CTL_ZERO_BYTES = 1 * MiB;
constexpr size_t WS_MOD = 1 * MiB, WS_BT = WS_MOD + 512 * 1024, WS_ROUTE = WS_MOD + 768 * 1024;
constexpr size_t WS_WIN = 2 * MiB, WS_WAOUT = 19 * MiB, WS_WF13 = 27 * MiB, WS_WF2 = 71 * MiB, WS_WKVQ = 93 * MiB, WS_WBOUT = 129 * MiB, WS_WM13 = 133 * MiB, WS_WM2 = 581 * MiB;
constexpr size_t WS_HA = 805 * MiB, WS_AR = 869 * MiB;
constexpr size_t WS_P0 = WS_AR, WS_QN = WS_AR + 68 * MiB, WS_KN = WS_AR + 100 * MiB, WS_VT = WS_AR + 108 * MiB, WS_MASK = WS_AR + 116 * MiB, WS_O = WS_AR + 118 * MiB, WS_U = WS_AR + 150 * MiB;
constexpr size_t WS_KV = WS_AR, WS_Q1 = WS_AR + 96 * MiB, WS_K1N = WS_AR + 144 * MiB, WS_Q1N = WS_AR + 192 * MiB, WS_VT1 = WS_AR + 240 * MiB, WS_OG = WS_AR + 288 * MiB, WS_LSE = WS_AR + 336 * MiB, WS_O1 = WS_AR + 338 * MiB;
constexpr size_t WS_AS = WS_AR, WS_UM = WS_AR + 72 * MiB, WS_Y = WS_AR + 324 * MiB, WS_Y2 = WS_AR + 468 * MiB, WS_RG = WS_AR + 612 * MiB, WS_TR = WS_AR + 613 * MiB;
constexpr size_t WS_END = WS_AR + 614 * MiB;
static_assert((size_t)A_INP * DM * 2 <= 17 * MiB && (size_t)MROWS * DFFE * 2 <= 252 * MiB && (size_t)MROWS * DM * 4 <= 144 * MiB && (size_t)MROWS * DM * 2 <= 72 * MiB, "ws map");
constexpr int CW_TMO = 0, CW_CODE = 1, CW_BAR = 4096, CW_CNT = 8192, CW_CUR = 16384, CW_DONE = 12288;

constexpr int RING_OFF = 0, RING_BYTES = 131072;
constexpr int LDSCTL_OFF = RING_BYTES, MISC_OFF = LDSCTL_OFF + 320;
constexpr int LDS_BYTES = 147456;
constexpr int NWAVES = 8;

#define GAS __attribute__((address_space(1)))
#define LAS __attribute__((address_space(3)))
typedef unsigned short bf16;
typedef unsigned v4u __attribute__((ext_vector_type(4)));
typedef unsigned v2u __attribute__((ext_vector_type(2)));
typedef float f32x4 __attribute__((ext_vector_type(4)));
typedef float f32x2 __attribute__((ext_vector_type(2)));
typedef float f32x16 __attribute__((ext_vector_type(16)));
typedef int i32x4 __attribute__((ext_vector_type(4)));
typedef short bf16x8 __attribute__((ext_vector_type(8)));
typedef GAS unsigned gu32;
#define RLX_AGENT __ATOMIC_RELAXED, __HIP_MEMORY_SCOPE_AGENT
#define MFMA32(a, b, c) __builtin_amdgcn_mfma_f32_32x32x16_bf16((a), (b), (c), 0, 0, 0)
__device__ __forceinline__ unsigned f2bf(float f) { unsigned u = __builtin_bit_cast(unsigned, f); return (u + 0x7fffu + ((u >> 16) & 1u)) >> 16; }
__device__ __forceinline__ unsigned pk2(float lo, float hi) { return f2bf(lo) | (f2bf(hi) << 16); }
__device__ __forceinline__ float bflo(unsigned w) { return __builtin_bit_cast(float, w << 16); }
__device__ __forceinline__ float bfhi(unsigned w) { return __builtin_bit_cast(float, w & 0xffff0000u); }
typedef float f32x2_t __attribute__((ext_vector_type(2)));
typedef __bf16 bf16x2_t __attribute__((ext_vector_type(2)));
__device__ __forceinline__ unsigned cvtpk(float lo, float hi) { f32x2_t v = {lo, hi}; bf16x2_t b = __builtin_convertvector(v, bf16x2_t); return __builtin_bit_cast(unsigned, b); }
__device__ __forceinline__ bf16x8 pack8(float a0, float a1, float a2, float a3, float a4, float a5, float a6, float a7) {
    v4u p; p.x = cvtpk(a0, a1); p.y = cvtpk(a2, a3); p.z = cvtpk(a4, a5); p.w = cvtpk(a6, a7); return __builtin_bit_cast(bf16x8, p); }
#define XB_TMO      128
#define XB_XCNT(j)  (256  + 64 * (j))
#define XB_XSUB(j)  (1280 + 64 * (j))
#define XB_XGEN(j)  (2304 + 64 * (j))
#define XB_TOP      3328
#define XB_TOPGEN   3392
#define XCD_BAR_WORDS 3456
#define XB_SPIN_CAP (1u << 18)

__device__ __forceinline__ unsigned xb_ld(unsigned* p)              { return __hip_atomic_load(p, __ATOMIC_RELAXED, __HIP_MEMORY_SCOPE_AGENT); }
__device__ __forceinline__ unsigned xb_add(unsigned* p, unsigned v) { return __hip_atomic_fetch_add(p, v, __ATOMIC_RELAXED, __HIP_MEMORY_SCOPE_AGENT); }
__device__ __forceinline__ unsigned xb_xcc_id() { return (unsigned)__builtin_amdgcn_s_getreg((3 << 11) | 20) & 0xFu; }
#define XB_SPIN(cond, bar) do { unsigned _sp = 0; while (cond) { __builtin_amdgcn_s_sleep(1); \
    if ((++_sp & 255u) == 0u) { if (xb_ld(&(bar)[XB_TMO])) break; if (_sp > XB_SPIN_CAP) { atomicAdd(&(bar)[XB_TMO], 1u); break; } } } } while (0)

struct XcdBarrier {
    unsigned* bar; unsigned x;
    volatile LAS unsigned* st;
};

__device__ __forceinline__ XcdBarrier xcd_barrier_post(unsigned* bar, volatile LAS unsigned* st) {
    XcdBarrier b; b.bar = bar; b.x = xb_xcc_id(); b.st = st;
    if (threadIdx.x == 0) (void)xb_add(&bar[XB_XCNT(b.x)], 1u);
    return b;
}
__device__ __forceinline__ void xcd_barrier_complete(unsigned* bar, unsigned x, unsigned& nloc, unsigned& nx) {
    const unsigned G = gridDim.x * gridDim.y * gridDim.z;
    unsigned sum, cnt, mine, sp = 0u;
    for (;;) {
        sum = 0u; cnt = 0u; mine = 0u;
#pragma unroll
        for (unsigned j = 0; j < 16; ++j) { const unsigned c = xb_ld(&bar[XB_XCNT(j)]); sum += c; cnt += (c > 0u) ? 1u : 0u; mine = (j == x) ? c : mine; }
        if (sum == G) break;
        __builtin_amdgcn_s_sleep(1);
        if ((++sp & 255u) == 0u) { if (xb_ld(&bar[XB_TMO])) break; if (sp > XB_SPIN_CAP) { atomicAdd(&bar[XB_TMO], 1u); break; } }
    }
    nloc = mine > 0u ? mine : 1u; nx = cnt > 0u ? cnt : 1u;
}

__device__ __forceinline__ void xcd_barrier(const XcdBarrier& b) {
    asm volatile("s_waitcnt vmcnt(0)" ::: "memory");
    __syncthreads();
    if (threadIdx.x == 0) {
        unsigned* bar = b.bar;
        __builtin_amdgcn_s_waitcnt(0);
        unsigned nloc = b.st[0], nx = b.st[1];
        if (nloc == 0u) { xcd_barrier_complete(bar, b.x, nloc, nx); b.st[0] = nloc; b.st[1] = nx; }
        const unsigned old = xb_add(&bar[XB_XSUB(b.x)], 1u);
        const unsigned gen = old / nloc;
        if (old + 1u == (gen + 1u) * nloc) {
            __builtin_amdgcn_fence(__ATOMIC_RELEASE, "agent");
            asm volatile("s_waitcnt vmcnt(0)" ::: "memory");
            const unsigned og = xb_add(&bar[XB_TOP], 1u);
            const unsigned tg = og / nx;
            if (og + 1u == (tg + 1u) * nx) xb_add(&bar[XB_TOPGEN], 1u);
            else XB_SPIN(xb_ld(&bar[XB_TOPGEN]) == tg, bar);
            __builtin_amdgcn_fence(__ATOMIC_ACQUIRE, "agent");
            xb_add(&bar[XB_XGEN(b.x)], 1u);
            asm volatile("s_waitcnt vmcnt(0)" ::: "memory");
        } else {
            XB_SPIN(xb_ld(&bar[XB_XGEN(b.x)]) == gen, bar);
            __builtin_amdgcn_fence(__ATOMIC_ACQUIRE, "agent");
            asm volatile("s_waitcnt vmcnt(0)" ::: "memory");
        }
    }
    __syncthreads();
}

struct Args { const void* in[28]; float* out; unsigned char* ws; int ph_lo, ph_hi; };
struct Frame {
    LAS unsigned char* lds; volatile LAS unsigned* MISC; gu32* ctl; unsigned char* ws;
    int tid, lane, wave, G, bid;
};
#define LDS_WAIT() asm volatile("s_waitcnt lgkmcnt(0)" ::: "memory")
__device__ __forceinline__ float wave_sum(float v) {
#pragma unroll
    for (int o = 1; o < 64; o <<= 1) v += __shfl_xor(v, o);
    return v;
}

__device__ __forceinline__ int t5_bucket(int n) {
    if (n < 16) return n;
    const float v = logf((float)n / 16.0f) / 4.852030263919617f * 16.0f;
    const int l = 16 + (int)v; return l < 31 ? l : 31;
}
__device__ __forceinline__ void cvt_tile(const float* __restrict__ src, int N, int k0, int n0, int nvalid, bf16* __restrict__ dst, size_t drow0, int Kd, int lane) {
    const int cl = lane & 15, kg = lane >> 4;
    f32x4 v[16];
    const float* sp = src + (size_t)(k0 + 16 * kg) * N + n0 + 4 * cl;
    const bool ok = 4 * cl < nvalid;
#pragma unroll
    for (int i = 0; i < 16; ++i) v[i] = ok ? *(const f32x4*)(sp + (size_t)i * N) : (f32x4){0.f, 0.f, 0.f, 0.f};
    bf16* dp = dst + (drow0 + 4 * cl) * (size_t)Kd + k0 + 16 * kg;
#pragma unroll
    for (int e = 0; e < 4; ++e) {
        v4u a, b;
        a.x = pk2(v[0][e], v[1][e]); a.y = pk2(v[2][e], v[3][e]); a.z = pk2(v[4][e], v[5][e]); a.w = pk2(v[6][e], v[7][e]);
        b.x = pk2(v[8][e], v[9][e]); b.y = pk2(v[10][e], v[11][e]); b.z = pk2(v[12][e], v[13][e]); b.w = pk2(v[14][e], v[15][e]);
        *(v4u*)(dp + (size_t)e * Kd) = a; *(v4u*)(dp + (size_t)e * Kd + 8) = b;
    }
}
__device__ __forceinline__ void p0_prologue(Frame& F, const Args& A) {
    const float* c_in = (const float*)A.in[1];
    const float* rel_bias = (const float*)A.in[3];
    float* MOD = (float*)(F.ws + WS_MOD); float* BT = (float*)(F.ws + WS_BT);
    LAS float* cs = (LAS float*)F.lds; LAS float* red = (LAS float*)(F.lds + 32768);
    for (int i = F.tid; i < NB * DM; i += NWAVES * 64) { const float v = c_in[i]; cs[i] = v / (1.0f + __expf(-v)); }
    __syncthreads();
    for (int item = F.bid; item < NMOD / 128; item += F.G) {
        const int j0 = item * 128; const float* W; const float* bias; int N, jl;
        if (j0 < 12288) { W = (const float*)A.in[4]; N = 12288; jl = j0; bias = (const float*)A.in[5]; }
        else if (j0 < 24576) { W = (const float*)A.in[4] + (size_t)DM * 12288; N = 12288; jl = j0 - 12288; bias = (const float*)A.in[5] + 12288; }
        else { W = (const float*)A.in[12]; N = 4096; jl = j0 - 24576; bias = (const float*)A.in[13]; }
        const float* wp = W + (size_t)(256 * F.wave) * N + jl + 2 * F.lane;
        float a[4][2];
#pragma unroll
        for (int b = 0; b < 4; ++b) { a[b][0] = 0.f; a[b][1] = 0.f; }
        for (int k = 0; k < 256; k += 8) {
            f32x2 w[8];
#pragma unroll
            for (int i = 0; i < 8; ++i) w[i] = *(const f32x2*)(wp + (size_t)(k + i) * N);
#pragma unroll
            for (int i = 0; i < 8; ++i)
#pragma unroll
                for (int b = 0; b < 4; ++b) { const float cv = cs[b * DM + 256 * F.wave + k + i]; a[b][0] += cv * w[i].x; a[b][1] += cv * w[i].y; }
        }
#pragma unroll
        for (int b = 0; b < 4; ++b) { red[(F.wave * 4 + b) * 128 + 2 * F.lane] = a[b][0]; red[(F.wave * 4 + b) * 128 + 2 * F.lane + 1] = a[b][1]; }
        __syncthreads();
        { const int b = F.tid >> 7, col = F.tid & 127; float s = bias[jl + col];
#pragma unroll
          for (int w = 0; w < 8; ++w) s += red[(w * 4 + b) * 128 + col];
          MOD[(size_t)b * NMOD + j0 + col] = s; }
        __syncthreads();
    }
    for (int idx = F.bid * (NWAVES * 64) + F.tid; idx < 16 * 2048; idx += F.G * NWAVES * 64) { const int h = idx >> 11, n = idx & 2047; BT[idx] = rel_bias[t5_bucket(n) * 16 + h] * LOG2E; }
    const int gw = F.bid * NWAVES + F.wave, NGW = F.G * NWAVES;
    constexpr int T_IN = 32 * 68, T_AOUT = 32 * 32, T_F1 = 32 * 88, T_F2 = 88 * 32, T_KV = 32 * 96, T_BQ = 32 * 48, T_BOUT = 16 * 32;
    constexpr int NITEMS = T_IN + T_AOUT + 2 * T_F1 + T_F2 + T_KV + T_BQ + T_BOUT;
    for (int it = gw; it < NITEMS; it += NGW) {
        int r = it;
        if (r < T_IN) { const int kb = r / 68, nb = r % 68; cvt_tile((const float*)A.in[8], A_IN, 64 * kb, 64 * nb, A_IN - 64 * nb, (bf16*)(F.ws + WS_WIN), (size_t)64 * nb, DM, F.lane); continue; } r -= T_IN;
        if (r < T_AOUT) { const int kb = r / 32, nb = r % 32; cvt_tile((const float*)A.in[9], DM, 64 * kb, 64 * nb, 64, (bf16*)(F.ws + WS_WAOUT), (size_t)64 * nb, DM, F.lane); continue; } r -= T_AOUT;
        if (r < T_F1) { const int kb = r / 88, nb = r % 88, n0 = 64 * nb; cvt_tile((const float*)A.in[20], DFF, 64 * kb, n0, 64, (bf16*)(F.ws + WS_WF13), (size_t)((n0 >> 7) * 256 + (n0 & 127)), DM, F.lane); continue; } r -= T_F1;
        if (r < T_F1) { const int kb = r / 88, nb = r % 88, n0 = 64 * nb; cvt_tile((const float*)A.in[21], DFF, 64 * kb, n0, 64, (bf16*)(F.ws + WS_WF13), (size_t)((n0 >> 7) * 256 + 128 + (n0 & 127)), DM, F.lane); continue; } r -= T_F1;
        if (r < T_F2) { const int kb = r / 32, nb = r % 32; cvt_tile((const float*)A.in[22], DM, 64 * kb, 64 * nb, 64, (bf16*)(F.ws + WS_WF2), (size_t)64 * nb, DFF, F.lane); continue; } r -= T_F2;
        if (r < T_KV) { const int kb = r / 96, nb = r % 96; cvt_tile((const float*)A.in[15], 6144, 64 * kb, 64 * nb, 64, (bf16*)(F.ws + WS_WKVQ), (size_t)64 * nb, DM, F.lane); continue; } r -= T_KV;
        if (r < T_BQ) { const int kb = r / 48, nb = r % 48; cvt_tile((const float*)A.in[17], 3072, 64 * kb, 64 * nb, 64, (bf16*)(F.ws + WS_WKVQ), (size_t)(6144 + 64 * nb), DM, F.lane); continue; } r -= T_BQ;
        { const int kb = r / 32, nb = r % 32; cvt_tile((const float*)A.in[18], DM, 64 * kb, 64 * nb, 64, (bf16*)(F.ws + WS_WBOUT), (size_t)64 * nb, 1024, F.lane); }
    }
}
constexpr int CV_TME = 3584, CV_TM = 8 * CV_TME, NT_MOE = 3 * CV_TM;
__device__ __forceinline__ void moe_tile_addr(Frame& F, const Args& A, int t, const float*& sp, int& N, bf16*& dp, int& Kd) {
    const int cl = F.lane & 15, kg = F.lane >> 4; int r = t;
    if (r < 2 * CV_TM) { const int up = r >= CV_TM ? 1 : 0; r -= up * CV_TM; const int e = r / CV_TME, rr = r % CV_TME, kb = rr / 112, nb = rr % 112, n0 = 64 * nb;
        N = DFFE; Kd = DM; sp = (const float*)A.in[25 + up] + (size_t)e * DM * DFFE + (size_t)(64 * kb + 16 * kg) * DFFE + n0 + 4 * cl;
        dp = (bf16*)(F.ws + WS_WM13) + ((size_t)e * 14336 + (n0 >> 7) * 256 + 128 * up + (n0 & 127) + 4 * cl) * DM + 64 * kb + 16 * kg; }
    else { r -= 2 * CV_TM; const int e = r / CV_TME, rr = r % CV_TME, kb = rr / 32, nb = rr % 32;
        N = DM; Kd = DFFE; sp = (const float*)A.in[27] + (size_t)e * DFFE * DM + (size_t)(64 * kb + 16 * kg) * DM + 64 * nb + 4 * cl;
        dp = (bf16*)(F.ws + WS_WM2) + ((size_t)e * 2048 + 64 * nb + 4 * cl) * DFFE + 64 * kb + 16 * kg; }
}
__device__ __forceinline__ void cvt_load(f32x4 (&v)[16], const float* __restrict__ sp, int N) {
#pragma unroll
    for (int i = 0; i < 16; ++i) v[i] = *(const f32x4*)(sp + (size_t)i * N);
}
__device__ __forceinline__ void cvt_store(const f32x4 (&v)[16], bf16* __restrict__ dp, int Kd) {
#pragma unroll
    for (int e = 0; e < 4; ++e) {
        v4u a, b;
        a.x = pk2(v[0][e], v[1][e]); a.y = pk2(v[2][e], v[3][e]); a.z = pk2(v[4][e], v[5][e]); a.w = pk2(v[6][e], v[7][e]);
        b.x = pk2(v[8][e], v[9][e]); b.y = pk2(v[10][e], v[11][e]); b.z = pk2(v[12][e], v[13][e]); b.w = pk2(v[14][e], v[15][e]);
        *(v4u*)(dp + (size_t)e * Kd) = a; *(v4u*)(dp + (size_t)e * Kd + 8) = b;
    }
}
__device__ __forceinline__ int conv_fixed(Frame& F, const Args& A, int cur, int ntiles) {
    const int CV_STRIPES = F.G * NWAVES;
    f32x4 va[16], vb[16]; const float* sp; bf16* dpa; bf16* dpb; int N, Kda, Kdb;
    int left = ntiles;
    if (left <= 0 || cur >= NT_MOE) return cur;
    moe_tile_addr(F, A, cur, sp, N, dpa, Kda); cvt_load(va, sp, N); cur += CV_STRIPES; --left;
    for (;;) {
        const bool haveB = left > 0 && cur < NT_MOE;
        if (haveB) { moe_tile_addr(F, A, cur, sp, N, dpb, Kdb); cvt_load(vb, sp, N); cur += CV_STRIPES; --left; }
        cvt_store(va, dpa, Kda);
        if (!haveB) break;
        const bool haveA = left > 0 && cur < NT_MOE;
        if (haveA) { moe_tile_addr(F, A, cur, sp, N, dpa, Kda); cvt_load(va, sp, N); cur += CV_STRIPES; --left; }
        cvt_store(vb, dpb, Kdb);
        if (!haveA) break;
    }
    return cur;
}
__device__ __forceinline__ void conv_drain(Frame& F, const Args& A) {
    LAS int* curL = (LAS int*)F.lds;
    const int gw = F.bid * NWAVES + F.wave, NGW = F.G * NWAVES;
    __syncthreads();
    for (int j = F.tid; j < NGW; j += NWAVES * 64) curL[j] = (int)__hip_atomic_load((unsigned*)(F.ctl + CW_CUR + j), RLX_AGENT);
    __syncthreads();
    const int rows = (NT_MOE + NGW - 1) / NGW;
    for (int i = 0; i < rows; ++i) {
        const int j = (gw + 97 * i) % NGW, t = i * NGW + j;
        if (t >= NT_MOE || t < curL[j]) continue;
        const float* sp; bf16* dp; int N, Kd; f32x4 v[16];
        moe_tile_addr(F, A, t, sp, N, dp, Kd); cvt_load(v, sp, N); cvt_store(v, dp, Kd);
    }
    __syncthreads();
}

__device__ __forceinline__ float row_rstd(const f32x4 (&v)[8]) {
    float ss = 0.f;
#pragma unroll
    for (int j = 0; j < 8; ++j) ss += (v[j].x * v[j].x + v[j].y * v[j].y) + (v[j].z * v[j].z + v[j].w * v[j].w);
    return 1.0f / sqrtf(wave_sum(ss) * (1.0f / DM) + EPS);
}
__device__ __forceinline__ void modulate_store(const f32x4 (&v)[8], float rstd, const float* g, const float* sh, const float* sc, bf16* orow, int lane) {
#pragma unroll
    for (int j = 0; j < 8; ++j) { const int col = 4 * lane + 256 * j;
        const f32x4 gg = *(const f32x4*)(g + col), s1 = *(const f32x4*)(sc + col), s0 = *(const f32x4*)(sh + col);
        const f32x4 y = v[j] * rstd * gg * (s1 + 1.0f) + s0;
        v2u w; w.x = pk2(y.x, y.y); w.y = pk2(y.z, y.w); *(v2u*)(orow + col) = w; }
}
__device__ __forceinline__ void normmod_phase(Frame& F, const float* X, const float* g, const float* modsh, const float* modsc, bf16* out) {
    const int gw = F.bid * NWAVES + F.wave, NGW = F.G * NWAVES;
    for (int row = gw; row < MTOK; row += NGW) { const int b = row >> 11;
        f32x4 v[8]; const float* xr = X + (size_t)row * DM + 4 * F.lane;
#pragma unroll
        for (int j = 0; j < 8; ++j) v[j] = *(const f32x4*)(xr + 256 * j);
        const float rstd = row_rstd(v);
        modulate_store(v, rstd, g, modsh + (size_t)b * NMOD, modsc + (size_t)b * NMOD, out + (size_t)row * DM, F.lane); }
}

constexpr float NEG_S = -3.0e38f;
__device__ __forceinline__ void p3_qknorm(Frame& F, const Args& A) {
    const bf16* P0 = (const bf16*)(F.ws + WS_P0); bf16* QN = (bf16*)(F.ws + WS_QN); bf16* KN = (bf16*)(F.ws + WS_KN);
    const float* gq = (const float*)A.in[10]; const float* gk = (const float*)A.in[11];
    const int gw = F.bid * NWAVES + F.wave, NGW = F.G * NWAVES, li = F.lane & 15, g4 = F.lane >> 4;
    const float QS = 0.08838834764831845f * LOG2E;
    float gqv[8], gkv[8];
#pragma unroll
    for (int e = 0; e < 8; ++e) { gqv[e] = gq[8 * li + e] * QS; gkv[e] = gk[8 * li + e]; }
    for (int tok = gw; tok < MTOK; tok += NGW) {
        const bf16* pr = P0 + (size_t)tok * A_INP;
#pragma unroll
        for (int i = 0; i < 5; ++i) { const int head = 4 * i + g4;
            const v4u w = *(const v4u*)(pr + head * 128 + 8 * li);
            float x[8] = {bflo(w.x), bfhi(w.x), bflo(w.y), bfhi(w.y), bflo(w.z), bfhi(w.z), bflo(w.w), bfhi(w.w)};
            float ss = 0.f;
#pragma unroll
            for (int e = 0; e < 8; ++e) ss += x[e] * x[e];
            ss += __shfl_xor(ss, 8); ss += __shfl_xor(ss, 4); ss += __shfl_xor(ss, 2); ss += __shfl_xor(ss, 1);
            const float rstd = 1.0f / sqrtf(ss * (1.0f / 128.0f) + EPS);
            v4u o;
            if (i < 4) { o.x = pk2(x[0] * rstd * gqv[0], x[1] * rstd * gqv[1]); o.y = pk2(x[2] * rstd * gqv[2], x[3] * rstd * gqv[3]); o.z = pk2(x[4] * rstd * gqv[4], x[5] * rstd * gqv[5]); o.w = pk2(x[6] * rstd * gqv[6], x[7] * rstd * gqv[7]);
                *(v4u*)(QN + (size_t)tok * DM + head * 128 + 8 * li) = o; }
            else { o.x = pk2(x[0] * rstd * gkv[0], x[1] * rstd * gkv[1]); o.y = pk2(x[2] * rstd * gkv[2], x[3] * rstd * gkv[3]); o.z = pk2(x[4] * rstd * gkv[4], x[5] * rstd * gkv[5]); o.w = pk2(x[6] * rstd * gkv[6], x[7] * rstd * gkv[7]);
                *(v4u*)(KN + (size_t)tok * 512 + (head - 16) * 128 + 8 * li) = o; }
        }
    }
}
__device__ __forceinline__ void p3_vtrans(Frame& F) {
    const bf16* P0 = (const bf16*)(F.ws + WS_P0); bf16* VT = (bf16*)(F.ws + WS_VT);
    LAS unsigned* tile = (LAS unsigned*)F.lds;
    for (int item = F.bid; item < MTOK / 64; item += F.G) { const int tok0 = item * 64, b = tok0 >> 11, t0 = tok0 & 2047;
        __syncthreads();
#pragma unroll
        for (int p = 0; p < 8; ++p) { const int row = p * 8 + (F.tid >> 6), cw = (F.tid & 63) * 4;
            const v4u w = *(const v4u*)(P0 + (size_t)(tok0 + row) * A_INP + C_V + 2 * cw);
            tile[row * 257 + cw] = w.x; tile[row * 257 + cw + 1] = w.y; tile[row * 257 + cw + 2] = w.z; tile[row * 257 + cw + 3] = w.w; }
        __syncthreads();
#pragma unroll
        for (int p = 0; p < 8; ++p) { const int task = p * 512 + F.tid, tg = task & 7, col = task >> 3;
            const LAS unsigned short* tp = (const LAS unsigned short*)tile + col;
            unsigned short h[8];
#pragma unroll
            for (int i = 0; i < 8; ++i) h[i] = tp[(size_t)(tg * 8 + i) * 514];
            v4u o; o.x = h[0] | ((unsigned)h[1] << 16); o.y = h[2] | ((unsigned)h[3] << 16); o.z = h[4] | ((unsigned)h[5] << 16); o.w = h[6] | ((unsigned)h[7] << 16);
            *(v4u*)(VT + ((size_t)(b * 512 + col)) * SEQ + t0 + tg * 8) = o; }
    }
    __syncthreads();
}
__device__ __forceinline__ void p3_indexer_pair(Frame& F, int pair) {
    const bf16* P0 = (const bf16*)(F.ws + WS_P0); unsigned* MASK = (unsigned*)(F.ws + WS_MASK);
    const int b = pair >> 10, t0 = (pair & 1023) * 2, lane = F.lane, c = lane & 31, hh = lane >> 5;
    const bf16* Pb = P0 + (size_t)b * SEQ * A_INP;
    const int qsel = (c >> 2) & 1, ahead = (c & 3) + 4 * (c >> 3);
    const bf16* ap = Pb + (size_t)(t0 + qsel) * A_INP + C_QI + ahead * 64 + 8 * hh;
    bf16x8 af[4];
#pragma unroll
    for (int ks = 0; ks < 4; ++ks) af[ks] = *(const bf16x8*)(ap + 16 * ks);
    const bf16* wp = Pb + (size_t)(t0 + hh) * A_INP + C_WI;
    const v4u w0 = *(const v4u*)wp, w1 = *(const v4u*)(wp + 8);
    const float WS_ = 0.25f * 0.125f;
    const float wv[16] = {bflo(w0.x) * WS_, bfhi(w0.x) * WS_, bflo(w0.y) * WS_, bfhi(w0.y) * WS_, bflo(w0.z) * WS_, bfhi(w0.z) * WS_, bflo(w0.w) * WS_, bfhi(w0.w) * WS_,
                          bflo(w1.x) * WS_, bfhi(w1.x) * WS_, bflo(w1.y) * WS_, bfhi(w1.y) * WS_, bflo(w1.z) * WS_, bfhi(w1.z) * WS_, bflo(w1.w) * WS_, bfhi(w1.w) * WS_};
    const int tq = t0 + hh, ktmax = (t0 + 1) >> 5;
    LAS float* scL = (LAS float*)(F.lds + F.wave * 16384) + lane;
#define IDX_LOAD(dst, kg_) do { const bf16* bp_ = Pb + (size_t)(128 * (kg_) + c) * A_INP + C_KI + 8 * hh; \
        _Pragma("unroll") for (int u = 0; u < 4; ++u) _Pragma("unroll") for (int ks = 0; ks < 4; ++ks) dst[u][ks] = *(const bf16x8*)(bp_ + (size_t)(32 * u) * A_INP + 16 * ks); } while (0)
#define IDX_COMP(src, kg_) do { _Pragma("unroll") for (int u = 0; u < 4; ++u) { f32x16 d; \
            _Pragma("unroll") for (int t = 0; t < 16; ++t) d[t] = 0.f; \
            _Pragma("unroll") for (int ks = 0; ks < 4; ++ks) d = MFMA32(af[ks], src[u][ks], d); \
            float s_ = 0.f; \
            _Pragma("unroll") for (int t = 0; t < 16; ++t) s_ += fmaxf(d[t], 0.f) * wv[t]; \
            scL[(4 * (kg_) + u) * 64] = (32 * (4 * (kg_) + u) + c <= tq) ? s_ : NEG_S; } } while (0)
    { const int ng = (ktmax >> 2) + 1;
      bf16x8 bA[4][4], bB[4][4];
      IDX_LOAD(bA, 0);
      for (int kg = 0; kg < ng; kg += 2) {
          if (kg + 1 < ng) IDX_LOAD(bB, kg + 1);
          IDX_COMP(bA, kg);
          if (kg + 1 < ng) { if (kg + 2 < ng) IDX_LOAD(bA, kg + 2); IDX_COMP(bB, kg + 1); }
      } }
#undef IDX_LOAD
#undef IDX_COMP
    LDS_WAIT();
    float sc[64];
#pragma unroll
    for (int k = 0; k < 64; ++k) { const float v = scL[k * 64]; sc[k] = (k <= ktmax) ? v : NEG_S; }
    LDS_WAIT();
    float mx = NEG_S, mn = 3.0e38f;
#pragma unroll
    for (int k = 0; k < 64; ++k) { mx = fmaxf(mx, sc[k]); mn = (sc[k] > -1.0e38f) ? fminf(mn, sc[k]) : mn; }
#pragma unroll
    for (int o = 16; o >= 1; o >>= 1) { mx = fmaxf(mx, __shfl_xor(mx, o)); mn = fminf(mn, __shfl_xor(mn, o)); }
    bool done = (tq + 1 <= 256); float lo = mn, hi = mx, thr = done ? -1.0e38f : mn;
    for (int it = 0; it < 48; ++it) {
        if (__all(done)) break;
        const float mid = 0.5f * (lo + hi);
        int cnt = 0;
#pragma unroll
        for (int k = 0; k < 64; ++k) cnt += (sc[k] >= mid) ? 1 : 0;
#pragma unroll
        for (int o = 16; o >= 1; o >>= 1) cnt += __shfl_xor(cnt, o);
        if (!done) {
            if (!(mid > lo) || !(mid < hi)) { done = true; thr = lo; }
            else if (cnt >= 256) { lo = mid; thr = mid; done = (cnt == 256); }
            else hi = mid;
        }
    }
    unsigned wA = 0u, wB = 0u;
#pragma unroll
    for (int k = 0; k < 64; ++k) { const unsigned long long bal = __ballot(sc[k] >= thr); if (lane == k) { wA = (unsigned)bal; wB = (unsigned)(bal >> 32); } }
    MASK[((size_t)b * SEQ + t0) * 64 + lane] = wA; MASK[((size_t)b * SEQ + t0 + 1) * 64 + lane] = wB;
}

__device__ __forceinline__ int kperm(int r) { return (r & ~12) | ((r & 4) << 1) | ((r & 8) >> 1); }
constexpr int P4_TAB = 0, P4_POS = 32768, P4_MASK = 40960, P4_MPITCH = 65, P4_NSLOT = 3, P4_K = 57600, P4_V = P4_K + P4_NSLOT * 8192, P4_END = P4_V + P4_NSLOT * 8192;
static_assert(P4_MASK + 64 * P4_MPITCH * 4 <= P4_K && P4_END <= RING_BYTES, "P4 LDS map");
__device__ __forceinline__ void p4_attn_item(Frame& F, const Args& A, int item) {
    const bf16* QN = (const bf16*)(F.ws + WS_QN); const bf16* KN = (const bf16*)(F.ws + WS_KN); const bf16* VT = (const bf16*)(F.ws + WS_VT);
    const unsigned* MASK = (const unsigned*)(F.ws + WS_MASK); const float* BT = (const float*)(F.ws + WS_BT); bf16* OB = (bf16*)(F.ws + WS_O);
    const int* pos = (const int*)A.in[2];
    const int qt = item >> 4, bk = item & 15, b = bk >> 2, kvh = bk & 3;
    LAS float* tab = (LAS float*)(F.lds + P4_TAB); LAS int* posL = (LAS int*)(F.lds + P4_POS); LAS unsigned* maskL = (LAS unsigned*)(F.lds + P4_MASK);
    const int w = F.wave, hd = w & 3, head = kvh * 4 + hd, qw0 = qt * 64 + 32 * (w >> 2), lane = F.lane, c = lane & 31, hh = lane >> 5;
    const size_t tokq = (size_t)b * SEQ + qw0 + c;
    __syncthreads();
    for (int i = F.tid; i < 4 * 2048; i += NWAVES * 64) tab[i] = BT[kvh * 4 * 2048 + i];
    for (int i = F.tid; i < SEQ; i += NWAVES * 64) posL[i] = pos[b * SEQ + i];
    for (int i = F.tid; i < 64 * 64; i += NWAVES * 64) maskL[(i >> 6) * P4_MPITCH + (i & 63)] = MASK[((size_t)b * SEQ + qt * 64 + (i >> 6)) * 64 + (i & 63)];
    const bf16* qp = QN + tokq * DM + head * 128 + 8 * hh;
    bf16x8 qf[8];
#pragma unroll
    for (int ks = 0; ks < 8; ++ks) qf[ks] = *(const bf16x8*)(qp + 16 * ks);
    __syncthreads();
    const int krow = 4 * w + (lane >> 4), kch = (lane & 15) ^ (krow & 15);
    const bf16* kg = KN + ((size_t)b * SEQ + krow) * 512 + kvh * 128 + 8 * kch;
    const int vd = 16 * w + (lane >> 2), vch = (lane & 3) ^ ((vd >> 2) & 3);
    const bf16* vg = VT + ((size_t)(b * 4 + kvh) * 128 + vd) * SEQ + 8 * vch;
    LAS unsigned char* kdst = F.lds + P4_K + 1024 * w; LAS unsigned char* vdst = F.lds + P4_V + 1024 * w;
#define P4_DMA(kt_, slot_) do { const int sl_ = (slot_) * 8192; \
        __builtin_amdgcn_global_load_lds((const unsigned*)(kg + (size_t)(kt_) * 32 * 512), (LAS unsigned*)(kdst + sl_), 16, 0, 0); \
        __builtin_amdgcn_global_load_lds((const unsigned*)(vg + (kt_) * 32), (LAS unsigned*)(vdst + sl_), 16, 0, 0); } while (0)
    const int pq = posL[qw0 + c];
    const LAS float* tb = tab + hd * 2048;
    const LAS unsigned* mrow = maskL + (32 * (w >> 2) + c) * P4_MPITCH;
    f32x16 O[4];
#pragma unroll
    for (int db = 0; db < 4; ++db)
#pragma unroll
        for (int t = 0; t < 16; ++t) O[db][t] = 0.f;
    float m = -1.0e29f, l = 0.f;
    const int ktmax = (qw0 + 31) >> 5, nkt = 2 * qt + 2;
    const int prow = kperm(c);
    const LAS unsigned char* kfrag = F.lds + P4_K + prow * 256;
    const LAS unsigned char* vfrag = F.lds + P4_V + c * 64;
    P4_DMA(0, 0); P4_DMA(1, 1);
    asm volatile("s_waitcnt vmcnt(2)" ::: "memory"); __builtin_amdgcn_s_barrier(); asm volatile("" ::: "memory");
    int cslot = 0, nslot = 2;
    for (int kt = 0; kt < nkt; ++kt) {
        const int sl = cslot * 8192;
        if (kt + 2 < nkt) P4_DMA(kt + 2, nslot);
        if (kt <= ktmax) {
            const int key0 = kt * 32;
            f32x16 S;
#pragma unroll
            for (int t = 0; t < 16; ++t) S[t] = 0.f;
#pragma unroll
            for (int ks = 0; ks < 8; ++ks) { const bf16x8 kf = *(const LAS bf16x8*)(kfrag + sl + (((2 * ks + hh) ^ (prow & 15)) << 4)); S = MFMA32(kf, qf[ks], S); }
            const unsigned mw = mrow[kt] >> (8 * hh);
            const i32x4 p0 = *(const LAS i32x4*)(posL + key0 + 8 * hh), p1 = *(const LAS i32x4*)(posL + key0 + 8 * hh + 4), p2 = *(const LAS i32x4*)(posL + key0 + 16 + 8 * hh), p3 = *(const LAS i32x4*)(posL + key0 + 16 + 8 * hh + 4);
            const int pk[16] = {p0.x, p0.y, p0.z, p0.w, p1.x, p1.y, p1.z, p1.w, p2.x, p2.y, p2.z, p2.w, p3.x, p3.y, p3.z, p3.w};
            float s[16]; float mx = -1.0e29f;
#pragma unroll
            for (int t = 0; t < 16; ++t) { const int bit = (t & 7) + 16 * (t >> 3);
                int idx = pq - pk[t]; idx = idx < 0 ? 0 : (idx > 2047 ? 2047 : idx);
                const float v = S[t] + tb[idx];
                s[t] = ((mw >> bit) & 1u) ? v : -1.0e30f; mx = fmaxf(mx, s[t]); }
            mx = fmaxf(mx, __shfl_xor(mx, 32));
            const float mnew = fmaxf(m, mx);
            float p[16]; float ls = 0.f;
#pragma unroll
            for (int t = 0; t < 16; ++t) { p[t] = __builtin_amdgcn_exp2f(s[t] - mnew); ls += p[t]; }
            if (!__all(mnew == m)) {
                const float alpha = __builtin_amdgcn_exp2f(m - mnew); l *= alpha;
#pragma unroll
                for (int db = 0; db < 4; ++db)
#pragma unroll
                    for (int t = 0; t < 16; ++t) O[db][t] *= alpha;
            }
            l += ls; m = mnew;
            const bf16x8 pf0 = pack8(p[0], p[1], p[2], p[3], p[4], p[5], p[6], p[7]), pf1 = pack8(p[8], p[9], p[10], p[11], p[12], p[13], p[14], p[15]);
            const int vsw = (c >> 2) & 3;
#pragma unroll
            for (int db = 0; db < 4; ++db) {
                const bf16x8 v0 = *(const LAS bf16x8*)(vfrag + sl + 32 * 64 * db + (((0 + hh) ^ vsw) << 4)), v1 = *(const LAS bf16x8*)(vfrag + sl + 32 * 64 * db + (((2 + hh) ^ vsw) << 4));
                O[db] = MFMA32(v0, pf0, O[db]); O[db] = MFMA32(v1, pf1, O[db]); }
        }
        if (kt + 2 < nkt) asm volatile("s_waitcnt vmcnt(2) lgkmcnt(0)" ::: "memory"); else asm volatile("s_waitcnt vmcnt(0) lgkmcnt(0)" ::: "memory");
        __builtin_amdgcn_s_barrier(); asm volatile("" ::: "memory");
        cslot = cslot == 2 ? 0 : cslot + 1; nslot = nslot == 2 ? 0 : nslot + 1;
    }
#undef P4_DMA
    l += __shfl_xor(l, 32);
    const float inv = 1.0f / l;
    bf16* op = OB + tokq * DM + head * 128 + 4 * hh;
#pragma unroll
    for (int db = 0; db < 4; ++db)
#pragma unroll
        for (int g = 0; g < 4; ++g) { v2u w2; w2.x = pk2(O[db][4 * g] * inv, O[db][4 * g + 1] * inv); w2.y = pk2(O[db][4 * g + 2] * inv, O[db][4 * g + 3] * inv); *(v2u*)(op + 32 * db + 8 * g) = w2; }
}

__device__ __forceinline__ void p11_qknorm(Frame& F, const Args& A) {
    const bf16* KV = (const bf16*)(F.ws + WS_KV); const bf16* Q1 = (const bf16*)(F.ws + WS_Q1); bf16* K1N = (bf16*)(F.ws + WS_K1N); bf16* Q1N = (bf16*)(F.ws + WS_Q1N);
    const float* gk = (const float*)A.in[16]; const float* gq = (const float*)A.in[19];
    const int gw = F.bid * NWAVES + F.wave, NGW = F.G * NWAVES, li = F.lane & 7, g8 = F.lane >> 3;
    const float QS = 0.125f * LOG2E;
    float gqv[8], gkv[8];
#pragma unroll
    for (int e = 0; e < 8; ++e) { gqv[e] = gq[8 * li + e] * QS; gkv[e] = gk[8 * li + e]; }
    for (int tok = gw; tok < MTOK; tok += NGW) {
#pragma unroll
        for (int i = 0; i < 12; ++i) { const int head = 8 * (i % 6) + g8; const bool isq = i < 6;
            const bf16* src = isq ? Q1 + (size_t)tok * 3072 : KV + (size_t)tok * 6144;
            const v4u w = *(const v4u*)(src + head * 64 + 8 * li);
            float x[8] = {bflo(w.x), bfhi(w.x), bflo(w.y), bfhi(w.y), bflo(w.z), bfhi(w.z), bflo(w.w), bfhi(w.w)};
            float ss = 0.f;
#pragma unroll
            for (int e = 0; e < 8; ++e) ss += x[e] * x[e];
            ss += __shfl_xor(ss, 4); ss += __shfl_xor(ss, 2); ss += __shfl_xor(ss, 1);
            const float rstd = 1.0f / sqrtf(ss * (1.0f / 64.0f) + EPS);
            v4u o;
            if (isq) { o.x = pk2(x[0] * rstd * gqv[0], x[1] * rstd * gqv[1]); o.y = pk2(x[2] * rstd * gqv[2], x[3] * rstd * gqv[3]); o.z = pk2(x[4] * rstd * gqv[4], x[5] * rstd * gqv[5]); o.w = pk2(x[6] * rstd * gqv[6], x[7] * rstd * gqv[7]);
                *(v4u*)(Q1N + (size_t)tok * 3072 + head * 64 + 8 * li) = o; }
            else { o.x = pk2(x[0] * rstd * gkv[0], x[1] * rstd * gkv[1]); o.y = pk2(x[2] * rstd * gkv[2], x[3] * rstd * gkv[3]); o.z = pk2(x[4] * rstd * gkv[4], x[5] * rstd * gkv[5]); o.w = pk2(x[6] * rstd * gkv[6], x[7] * rstd * gkv[7]);
                *(v4u*)(K1N + (size_t)tok * 3072 + head * 64 + 8 * li) = o; }
        }
    }
}
__device__ __forceinline__ void p11_vtrans(Frame& F) {
    const bf16* KV = (const bf16*)(F.ws + WS_KV); bf16* VT1 = (bf16*)(F.ws + WS_VT1);
    LAS unsigned* tile = (LAS unsigned*)F.lds;
    for (int item = F.bid; item < NB * 3 * 16 * 4; item += F.G) {
        const int cg = item & 3, ch = (item >> 2) & 15, bg = item >> 6, g = bg % 3, b = bg / 3, t0 = ch * 128, lr = 2 * g, r = 1 << lr, nsub = SEQ >> lr;
        __syncthreads();
#pragma unroll
        for (int p = 0; p < 8; ++p) { const int row = p * 16 + (F.tid >> 5), cw = (F.tid & 31) * 4;
            const v4u w = *(const v4u*)(KV + (size_t)(b * SEQ + t0 + row) * 6144 + 3072 + g * 1024 + cg * 256 + 2 * cw);
            tile[row * 129 + cw] = w.x; tile[row * 129 + cw + 1] = w.y; tile[row * 129 + cw + 2] = w.z; tile[row * 129 + cw + 3] = w.w; }
        __syncthreads();
#pragma unroll
        for (int p = 0; p < 8; ++p) { const int task = p * 512 + F.tid, q = task & 15, col = task >> 4;
            const int rho = q & (r - 1), run = q >> lr;
            const LAS unsigned short* tp = (const LAS unsigned short*)tile + col;
            unsigned short h[8];
#pragma unroll
            for (int i = 0; i < 8; ++i) h[i] = tp[(size_t)(((8 * run + i) << lr) + rho) * 258];
            v4u o; o.x = h[0] | ((unsigned)h[1] << 16); o.y = h[2] | ((unsigned)h[3] << 16); o.z = h[4] | ((unsigned)h[5] << 16); o.w = h[6] | ((unsigned)h[7] << 16);
            *(v4u*)(VT1 + ((size_t)((b * 3 + g) * 1024 + cg * 256 + col)) * SEQ + rho * nsub + (t0 >> lr) + 8 * run) = o; }
    }
    __syncthreads();
}
__device__ __forceinline__ void p12_attn_item(Frame& F, const Args& A, int item) {
    const bf16* Q1N = (const bf16*)(F.ws + WS_Q1N); const bf16* K1N = (const bf16*)(F.ws + WS_K1N); const bf16* VT1 = (const bf16*)(F.ws + WS_VT1);
    const float* BT = (const float*)(F.ws + WS_BT); bf16* OG = (bf16*)(F.ws + WS_OG); float* LSE = (float*)(F.ws + WS_LSE);
    const int* pos = (const int*)A.in[2];
    const int jb = item & 7, head = (item >> 3) & 15, bg = item >> 7, g = bg % 3, b = bg / 3, lr = 2 * g, nsub = SEQ >> lr, tps = nsub >> 5;
    LAS float* tab = (LAS float*)F.lds; LAS int* posL = (LAS int*)(F.lds + 8192);
    __syncthreads();
    for (int i = F.tid; i < 2048; i += NWAVES * 64) { tab[i] = BT[head * 2048 + i]; posL[i] = pos[b * SEQ + i]; }
    __syncthreads();
    const int j = 8 * jb + F.wave, rho = j / tps, n0 = 32 * (j % tps), lane = F.lane, c = lane & 31, hh = lane >> 5;
    const int tq = ((n0 + c) << lr) + rho;
    const size_t tokq = (size_t)b * SEQ + tq;
    const bf16* qp = Q1N + tokq * 3072 + g * 1024 + head * 64 + 8 * hh;
    bf16x8 qf[4];
#pragma unroll
    for (int ks = 0; ks < 4; ++ks) qf[ks] = *(const bf16x8*)(qp + 16 * ks);
    const int pq = posL[tq];
    f32x16 O[2];
#pragma unroll
    for (int db = 0; db < 2; ++db)
#pragma unroll
        for (int t = 0; t < 16; ++t) O[db][t] = 0.f;
    float m = -1.0e29f, l = 0.f;
    const bf16* kcol = K1N + (size_t)b * SEQ * 3072 + g * 1024 + head * 64 + 8 * hh;
    const bf16* vbase = VT1 + ((size_t)((b * 3 + g) * 1024 + head * 64 + c)) * SEQ + rho * nsub + 8 * hh;
    const int pc = kperm(c), nq = n0 + c;
    bf16x8 kf[5][4], vf[5][4];
#pragma unroll
    for (int ti = 0; ti < 5; ++ti) { const int kb = n0 - 128 + 32 * ti, kbc = kb < 0 ? 0 : kb;
        const bf16* kp = kcol + (size_t)(((kbc + pc) << lr) + rho) * 3072;
#pragma unroll
        for (int ks = 0; ks < 4; ++ks) kf[ti][ks] = *(const bf16x8*)(kp + 16 * ks);
#pragma unroll
        for (int db = 0; db < 2; ++db) { vf[ti][2 * db] = *(const bf16x8*)(vbase + (size_t)(32 * db) * SEQ + kbc); vf[ti][2 * db + 1] = *(const bf16x8*)(vbase + (size_t)(32 * db) * SEQ + kbc + 16); } }
#pragma unroll
    for (int ti = 0; ti < 5; ++ti) {
        const int kb = n0 - 128 + 32 * ti;
        if (kb < 0) continue;
        f32x16 S;
#pragma unroll
        for (int t = 0; t < 16; ++t) S[t] = 0.f;
#pragma unroll
        for (int ks = 0; ks < 4; ++ks) S = MFMA32(kf[ti][ks], qf[ks], S);
        float s[16]; float mx = -1.0e29f;
#pragma unroll
        for (int t = 0; t < 16; ++t) { const int nk = kb + (t & 7) + 8 * hh + 16 * (t >> 3);
            int idx = pq - posL[(nk << lr) + rho]; idx = idx < 0 ? 0 : (idx > 2047 ? 2047 : idx);
            const float v = S[t] + tab[idx];
            s[t] = (nk <= nq && nk >= nq - 128) ? v : -1.0e30f; mx = fmaxf(mx, s[t]); }
        mx = fmaxf(mx, __shfl_xor(mx, 32));
        const float mnew = fmaxf(m, mx);
        float p[16]; float ls = 0.f;
#pragma unroll
        for (int t = 0; t < 16; ++t) { p[t] = __builtin_amdgcn_exp2f(s[t] - mnew); ls += p[t]; }
        if (!__all(mnew == m)) { const float alpha = __builtin_amdgcn_exp2f(m - mnew); l *= alpha;
#pragma unroll
            for (int db = 0; db < 2; ++db)
#pragma unroll
                for (int t = 0; t < 16; ++t) O[db][t] *= alpha; }
        l += ls; m = mnew;
        const bf16x8 pf0 = pack8(p[0], p[1], p[2], p[3], p[4], p[5], p[6], p[7]), pf1 = pack8(p[8], p[9], p[10], p[11], p[12], p[13], p[14], p[15]);
#pragma unroll
        for (int db = 0; db < 2; ++db) { O[db] = MFMA32(vf[ti][2 * db], pf0, O[db]); O[db] = MFMA32(vf[ti][2 * db + 1], pf1, O[db]); }
    }
    l += __shfl_xor(l, 32);
    const float inv = 1.0f / l;
    bf16* op = OG + tokq * 3072 + g * 1024 + head * 64 + 4 * hh;
#pragma unroll
    for (int db = 0; db < 2; ++db)
#pragma unroll
        for (int gg = 0; gg < 4; ++gg) { v2u w2; w2.x = pk2(O[db][4 * gg] * inv, O[db][4 * gg + 1] * inv); w2.y = pk2(O[db][4 * gg + 2] * inv, O[db][4 * gg + 3] * inv); *(v2u*)(op + 32 * db + 8 * gg) = w2; }
    if (hh == 0) LSE[tokq * 48 + g * 16 + head] = m + __builtin_amdgcn_logf(l);
}
__device__ __forceinline__ void p13_merge(Frame& F) {
    const bf16* OG = (const bf16*)(F.ws + WS_OG); const float* LSE = (const float*)(F.ws + WS_LSE); bf16* O1 = (bf16*)(F.ws + WS_O1);
    const int gt = F.bid * (NWAVES * 64) + F.tid, NT = F.G * NWAVES * 64;
    for (int i = gt; i < MTOK * 128; i += NT) { const int tok = i >> 7, c8 = i & 127, head = c8 >> 3;
        const float l0 = LSE[(size_t)tok * 48 + head], l1 = LSE[(size_t)tok * 48 + 16 + head], l2 = LSE[(size_t)tok * 48 + 32 + head];
        const float mm = fmaxf(l0, fmaxf(l1, l2)); float w0 = __builtin_amdgcn_exp2f(l0 - mm), w1 = __builtin_amdgcn_exp2f(l1 - mm), w2 = __builtin_amdgcn_exp2f(l2 - mm);
        const float inv = 1.0f / (w0 + w1 + w2); w0 *= inv; w1 *= inv; w2 *= inv;
        const v4u a = *(const v4u*)(OG + (size_t)tok * 3072 + c8 * 8), bb = *(const v4u*)(OG + (size_t)tok * 3072 + 1024 + c8 * 8), cc = *(const v4u*)(OG + (size_t)tok * 3072 + 2048 + c8 * 8);
        v4u o;
        o.x = pk2(w0 * bflo(a.x) + w1 * bflo(bb.x) + w2 * bflo(cc.x), w0 * bfhi(a.x) + w1 * bfhi(bb.x) + w2 * bfhi(cc.x));
        o.y = pk2(w0 * bflo(a.y) + w1 * bflo(bb.y) + w2 * bflo(cc.y), w0 * bfhi(a.y) + w1 * bfhi(bb.y) + w2 * bfhi(cc.y));
        o.z = pk2(w0 * bflo(a.z) + w1 * bflo(bb.z) + w2 * bflo(cc.z), w0 * bfhi(a.z) + w1 * bfhi(bb.z) + w2 * bfhi(cc.z));
        o.w = pk2(w0 * bflo(a.w) + w1 * bflo(bb.w) + w2 * bflo(cc.w), w0 * bfhi(a.w) + w1 * bfhi(bb.w) + w2 * bfhi(cc.w));
        *(v4u*)(O1 + (size_t)tok * 1024 + c8 * 8) = o; }
}

__device__ __forceinline__ void p15_norm_route(Frame& F, const Args& A) {
    const float* X = A.out; const float* MOD = (const float*)(F.ws + WS_MOD); bf16* HA = (bf16*)(F.ws + WS_HA);
    const float* g = (const float*)A.in[7] + DM; const float* router = (const float*)A.in[23]; const float* rb = (const float*)A.in[24];
    int* r_exp = (int*)(F.ws + WS_ROUTE); int* r_pos = r_exp + 2 * MTOK; float* r_gate = (float*)(r_pos + 2 * MTOK);
    LAS float* RT = (LAS float*)F.lds;
    __syncthreads();
    for (int i = F.tid; i < DM * NEXP; i += NWAVES * 64) RT[(i & 7) * DM + (i >> 3)] = router[i];
    __syncthreads();
    const int gw = F.bid * NWAVES + F.wave, NGW = F.G * NWAVES;
    for (int row = gw; row < MTOK; row += NGW) { const int b = row >> 11;
        f32x4 v[8]; const float* xr = X + (size_t)row * DM + 4 * F.lane;
#pragma unroll
        for (int j = 0; j < 8; ++j) v[j] = *(const f32x4*)(xr + 256 * j);
        const float rstd = row_rstd(v);
        const float* sh = MOD + (size_t)b * NMOD + 12288 + 6144; const float* sc = MOD + (size_t)b * NMOD + 12288 + 8192;
        float lg[8];
#pragma unroll
        for (int e = 0; e < 8; ++e) lg[e] = 0.f;
        bf16* orow = HA + (size_t)row * DM;
#pragma unroll
        for (int j = 0; j < 8; ++j) { const int col = 4 * F.lane + 256 * j;
            const f32x4 gg = *(const f32x4*)(g + col), s1 = *(const f32x4*)(sc + col), s0 = *(const f32x4*)(sh + col);
            const f32x4 y = v[j] * rstd * gg * (s1 + 1.0f) + s0;
            v2u w; w.x = pk2(y.x, y.y); w.y = pk2(y.z, y.w); *(v2u*)(orow + col) = w;
#pragma unroll
            for (int e = 0; e < 8; ++e) { const f32x4 rr = *(const LAS f32x4*)(RT + e * DM + col); lg[e] += (y.x * rr.x + y.y * rr.y) + (y.z * rr.z + y.w * rr.w); }
            asm volatile("" ::: "memory"); }
#pragma unroll
        for (int e = 0; e < 8; ++e) lg[e] = wave_sum(lg[e]) + rb[e];
        int e0 = 0; float v0 = lg[0];
#pragma unroll
        for (int e = 1; e < 8; ++e) if (lg[e] > v0) { v0 = lg[e]; e0 = e; }
        int e1 = -1; float v1 = -3.0e38f;
#pragma unroll
        for (int e = 0; e < 8; ++e) if (e != e0 && lg[e] > v1) { v1 = lg[e]; e1 = e; }
        const float g1 = 1.0f / (1.0f + __expf(v0 - v1)), g0 = 1.0f - g1;
        if (F.lane == 0) {
            const unsigned p0 = __hip_atomic_fetch_add((unsigned*)(F.ctl + CW_CNT + 64 * e0), 1u, RLX_AGENT);
            const unsigned p1 = __hip_atomic_fetch_add((unsigned*)(F.ctl + CW_CNT + 64 * e1), 1u, RLX_AGENT);
            r_exp[2 * row] = e0; r_exp[2 * row + 1] = e1; r_pos[2 * row] = (int)p0; r_pos[2 * row + 1] = (int)p1; r_gate[2 * row] = g0; r_gate[2 * row + 1] = g1;
        }
    }
}
__device__ __forceinline__ void moe_offsets(Frame& F, int (&off)[9]) {
    off[0] = 0;
#pragma unroll
    for (int e = 0; e < 8; ++e) { const unsigned cnt = __hip_atomic_load((unsigned*)(F.ctl + CW_CNT + 64 * e), RLX_AGENT); off[e + 1] = off[e] + (int)((cnt + 255u) & ~255u); }
}
__device__ __forceinline__ void p16_gather(Frame& F) {
    const bf16* HA = (const bf16*)(F.ws + WS_HA); bf16* AS = (bf16*)(F.ws + WS_AS); float* RG = (float*)(F.ws + WS_RG); int* TR = (int*)(F.ws + WS_TR);
    const int* r_exp = (const int*)(F.ws + WS_ROUTE); const int* r_pos = r_exp + 2 * MTOK; const float* r_gate = (const float*)(r_pos + 2 * MTOK);
    int off[9]; moe_offsets(F, off);
    const int gw = F.bid * NWAVES + F.wave, NGW = F.G * NWAVES;
    for (int idx = gw; idx < 2 * MTOK; idx += NGW) {
        const int e = r_exp[idx], p = r_pos[idx]; int base = 0;
#pragma unroll
        for (int k = 1; k < 8; ++k) base = (e >= k) ? off[k] : base;
        const int row = base + p, tok = idx >> 1;
        const v4u* src = (const v4u*)(HA + (size_t)tok * DM) + F.lane; v4u* dst = (v4u*)(AS + (size_t)row * DM) + F.lane;
        const v4u a = src[0], b2 = src[64], c2 = src[128], d2 = src[192];
        dst[0] = a; dst[64] = b2; dst[128] = c2; dst[192] = d2;
        if (F.lane == 0) { RG[row] = r_gate[idx]; TR[idx] = row; }
    }
}
__device__ __forceinline__ void p19_final(Frame& F, const Args& A) {
    float* X = A.out; const float* MOD = (const float*)(F.ws + WS_MOD); const bf16* Y = (const bf16*)(F.ws + WS_Y); const int* TR = (const int*)(F.ws + WS_TR);
    constexpr size_t PS = (WS_Y2 - WS_Y) / 2;
    const int gw = F.bid * NWAVES + F.wave, NGW = F.G * NWAVES;
    for (int row = gw; row < MTOK; row += NGW) { const int b = row >> 11; const int r0 = TR[2 * row], r1 = TR[2 * row + 1];
        const float* gt = MOD + (size_t)b * NMOD + 12288 + 10240 + 8 * F.lane;
        float* xr = X + (size_t)row * DM + 8 * F.lane; const bf16* y0 = Y + (size_t)r0 * DM + 8 * F.lane; const bf16* y1 = Y + (size_t)r1 * DM + 8 * F.lane;
#pragma unroll
        for (int j = 0; j < 4; ++j) { const v4u a = *(const v4u*)(y0 + 512 * j), a2 = *(const v4u*)(y0 + PS + 512 * j), c2 = *(const v4u*)(y1 + 512 * j), c3 = *(const v4u*)(y1 + PS + 512 * j);
            const f32x4 x0 = *(const f32x4*)(xr + 512 * j), x1 = *(const f32x4*)(xr + 512 * j + 4), g0 = *(const f32x4*)(gt + 512 * j), g1 = *(const f32x4*)(gt + 512 * j + 4);
            f32x4 s0v, s1v;
            s0v.x = (bflo(a.x) + bflo(a2.x)) + (bflo(c2.x) + bflo(c3.x)); s0v.y = (bfhi(a.x) + bfhi(a2.x)) + (bfhi(c2.x) + bfhi(c3.x));
            s0v.z = (bflo(a.y) + bflo(a2.y)) + (bflo(c2.y) + bflo(c3.y)); s0v.w = (bfhi(a.y) + bfhi(a2.y)) + (bfhi(c2.y) + bfhi(c3.y));
            s1v.x = (bflo(a.z) + bflo(a2.z)) + (bflo(c2.z) + bflo(c3.z)); s1v.y = (bfhi(a.z) + bfhi(a2.z)) + (bfhi(c2.z) + bfhi(c3.z));
            s1v.z = (bflo(a.w) + bflo(a2.w)) + (bflo(c2.w) + bflo(c3.w)); s1v.w = (bfhi(a.w) + bfhi(a2.w)) + (bfhi(c2.w) + bfhi(c3.w));
            *(f32x4*)(xr + 512 * j) = x0 + g0 * s0v; *(f32x4*)(xr + 512 * j + 4) = x1 + g1 * s1v; }
    }
}

constexpr int N_PHASES = 20;
__global__ void __launch_bounds__(NWAVES * 64, 2) yoco_fwd(Args args) {
    extern __shared__ __attribute__((aligned(16))) unsigned char lds[];
    Frame F;
    F.lds = (LAS unsigned char*)lds; F.MISC = (volatile LAS unsigned*)(F.lds + MISC_OFF);
    F.tid = threadIdx.x; F.lane = F.tid & 63; F.wave = __builtin_amdgcn_readfirstlane(F.tid >> 6); F.G = gridDim.x; F.bid = blockIdx.x;
    F.ws = args.ws; F.ctl = (gu32*)(args.ws + WS_CTL);
    for (int u = F.tid; u < (LDS_BYTES - LDSCTL_OFF) / 4; u += NWAVES * 64) ((LAS unsigned*)(F.lds + LDSCTL_OFF))[u] = 0u;
    __syncthreads();
    const int lo = args.ph_lo, hi = args.ph_hi;
    const bool one_launch = (hi - lo) > 1;
    XcdBarrier bar; bar.bar = (unsigned*)(F.ctl + CW_BAR); bar.x = 0; bar.st = nullptr;
    if (one_launch) bar = xcd_barrier_post((unsigned*)(F.ctl + CW_BAR), F.MISC + 8);
    int cv_cur = F.bid * NWAVES + F.wave;
#define IN(k) (lo <= (k) && (k) < hi)
#define SEAM(k) do { if (IN(k) && IN((k) + 1)) xcd_barrier(bar); } while (0)
#define TAIL_FILL(nunits, budget) do { if (one_launch) { const int nu_ = (nunits), rounds_ = (nu_ + F.G - 1) / F.G, nlast_ = nu_ - (rounds_ - 1) * F.G; \
        if (nlast_ < F.G && F.bid >= nlast_) cv_cur = conv_fixed(F, args, cv_cur, (budget)); } } while (0)
#define CONV_BEGIN(k) if (IN(k)) {
#define CONV_END(k)   }
    const float* const MODc = (const float*)(F.ws + WS_MOD);
    bf16* const HA = (bf16*)(F.ws + WS_HA);

    if (IN(0)) { p0_prologue(F, args); } SEAM(0);
    CONV_BEGIN(1) normmod_phase(F, (const float*)args.in[0], (const float*)args.in[6], MODc + 0, MODc + 2048, HA); CONV_END(1) SEAM(1);
    CONV_BEGIN(2) pg8::Gemm g{HA, (const bf16*)(F.ws + WS_WIN), MTOK, A_INP, DM, DM}; pg8::StaticOrder S; S.init(MTOK, A_INP, F.G, F.bid);
        pg8::EpiBf16Sel E{(bf16*)(F.ws + WS_P0), A_INP, nullptr, 0, 0, 1 << 30};
        pg8::gemm_phase<pg8::EpiBf16Sel, pg8::StaticOrder, true, true>(F.lds + RING_OFF, g, S, E); TAIL_FILL(S.nwg, 9); CONV_END(2) SEAM(2);
    CONV_BEGIN(3) p3_qknorm(F, args); p3_vtrans(F);
        { const int gw = F.bid * NWAVES + F.wave, NGW = F.G * NWAVES;
          for (int q = gw; q < MTOK / 4; q += NGW) {
            const int s0 = q, s1 = MTOK / 2 - 1 - q;
            p3_indexer_pair(F, (s0 & 3) * 1024 + (s0 >> 2)); p3_indexer_pair(F, (s1 & 3) * 1024 + (s1 >> 2)); } } CONV_END(3) SEAM(3);
    CONV_BEGIN(4) for (int r = 0, base = 0; base < 512; ++r, base += F.G) { const int i = base + ((r & 1) ? F.G - 1 - F.bid : F.bid); if (i < 512) p4_attn_item(F, args, ((31 - (i >> 4)) << 4) | (i & 15)); } __syncthreads(); CONV_END(4) SEAM(4);
    if (IN(5)) { pg8::Gemm g{(const bf16*)(F.ws + WS_O), (const bf16*)(F.ws + WS_WAOUT), MTOK, DM, DM, DM}; pg8::StaticOrder S; S.init(MTOK, DM, F.G, F.bid);
        pg8::EpiResGate E{(const float*)args.in[0], args.out, MODc + 4096, NMOD};
        pg8::gemm_phase<pg8::EpiResGate, pg8::StaticOrder, false, true>(F.lds + RING_OFF, g, S, E); } SEAM(5);
    CONV_BEGIN(6) normmod_phase(F, args.out, (const float*)args.in[7], MODc + 6144, MODc + 8192, HA); CONV_END(6) SEAM(6);
    CONV_BEGIN(7) pg8::Gemm g{HA, (const bf16*)(F.ws + WS_WF13), MTOK, 2 * DFF, DM, DM}; pg8::StaticOrder S; S.init(MTOK, 2 * DFF, F.G, F.bid);
        pg8::EpiSwiGLU E{(bf16*)(F.ws + WS_U), DFF, 2 * DFF / 256};
        pg8::gemm_phase<pg8::EpiSwiGLU, pg8::StaticOrder, true, true>(F.lds + RING_OFF, g, S, E); TAIL_FILL(S.nwg, 12); CONV_END(7) SEAM(7);
    if (IN(8)) { pg8::Gemm g{(const bf16*)(F.ws + WS_U), (const bf16*)(F.ws + WS_WF2), MTOK, DM, DFF, DFF}; pg8::StaticOrder S; S.init(MTOK, DM, F.G, F.bid);
        pg8::EpiResGate E{args.out, args.out, MODc + 10240, NMOD};
        pg8::gemm_phase<pg8::EpiResGate, pg8::StaticOrder, false, true>(F.lds + RING_OFF, g, S, E); } SEAM(8);
    CONV_BEGIN(9) const float* X = args.out; const float* gk = (const float*)args.in[14]; const float* ga = (const float*)args.in[6] + DM;
        const int gw = F.bid * NWAVES + F.wave, NGW = F.G * NWAVES;
        for (int row = gw; row < MTOK; row += NGW) { const int b = row >> 11;
            f32x4 v[8]; const float* xr = X + (size_t)row * DM + 4 * F.lane;
#pragma unroll
            for (int j = 0; j < 8; ++j) v[j] = *(const f32x4*)(xr + 256 * j);
            const float rstd = row_rstd(v);
            modulate_store(v, rstd, gk, MODc + (size_t)b * NMOD + 24576, MODc + (size_t)b * NMOD + 24576 + 2048, HA + (size_t)row * DM, F.lane);
            modulate_store(v, rstd, ga, MODc + (size_t)b * NMOD + 12288, MODc + (size_t)b * NMOD + 12288 + 2048, HA + (size_t)(MTOK + row) * DM, F.lane); } CONV_END(9) SEAM(9);
    CONV_BEGIN(10) pg8::Gemm g{HA, (const bf16*)(F.ws + WS_WKVQ), 2 * MTOK, 9216, DM, DM}; pg8::DualOrder S; S.init(MTOK / 256, 24, 12, MTOK / 256, 24, F.G, F.bid);
        pg8::EpiBf16Sel E{(bf16*)(F.ws + WS_KV), 6144, (bf16*)(F.ws + WS_Q1), 3072, MTOK / 256, 24};
        pg8::gemm_phase<pg8::EpiBf16Sel, pg8::DualOrder, true, true>(F.lds + RING_OFF, g, S, E); TAIL_FILL(S.ntot, 12); CONV_END(10) SEAM(10);
    CONV_BEGIN(11) p11_qknorm(F, args); p11_vtrans(F); CONV_END(11) SEAM(11);
    CONV_BEGIN(12) for (int item = F.bid; item < NB * 3 * 16 * 8; item += F.G) p12_attn_item(F, args, item); __syncthreads(); CONV_END(12) SEAM(12);
    CONV_BEGIN(13) p13_merge(F); CONV_END(13) SEAM(13);
    if (IN(14)) { pg8::Gemm g{(const bf16*)(F.ws + WS_O1), (const bf16*)(F.ws + WS_WBOUT), MTOK, DM, 1024, 1024}; pg8::StaticOrder S; S.init(MTOK, DM, F.G, F.bid);
        pg8::EpiResGate E{args.out, args.out, MODc + 12288 + 4096, NMOD};
        pg8::gemm_phase<pg8::EpiResGate, pg8::StaticOrder, false, true>(F.lds + RING_OFF, g, S, E); } SEAM(14);
    CONV_BEGIN(15) p15_norm_route(F, args); CONV_END(15)
    if (IN(15) && F.lane == 0) __hip_atomic_store((unsigned*)(F.ctl + CW_CUR + F.bid * NWAVES + F.wave), (unsigned)cv_cur, RLX_AGENT);
    SEAM(15);
    if (IN(16)) { p16_gather(F); conv_drain(F, args); } SEAM(16);
    if (IN(17)) { int off[9]; moe_offsets(F, off); pg8::MoeOrder S;
#pragma unroll
        for (int e = 0; e < 9; ++e) S.toff[e] = off[e] >> 8;
        S.nN = 2 * DFFE / 256; S.T = S.toff[8]; S.total = S.T * S.nN; S.G = F.G; S.c = F.bid; S.ksplit = 1; S.klen = DM;
        pg8::Gemm g{(const bf16*)(F.ws + WS_AS), (const bf16*)(F.ws + WS_WM13), MROWS, 2 * DFFE, DM, DM};
        pg8::EpiSwiGLU E{(bf16*)(F.ws + WS_UM), DFFE, 2 * DFFE / 256};
        pg8::gemm_phase<pg8::EpiSwiGLU, pg8::MoeOrder, true, true>(F.lds + RING_OFF, g, S, E); } SEAM(17);
    if (IN(18)) { int off[9]; moe_offsets(F, off); pg8::MoeOrder S;
#pragma unroll
        for (int e = 0; e < 9; ++e) S.toff[e] = off[e] >> 8;
        S.nN = DM / 256; S.T = S.toff[8]; S.total = S.T * S.nN * 2; S.G = F.G; S.c = F.bid; S.ksplit = 2; S.klen = DFFE / 2;
        pg8::Gemm g{(const bf16*)(F.ws + WS_UM), (const bf16*)(F.ws + WS_WM2), MROWS, DM, DFFE, DFFE / 2};
        pg8::EpiRowScale E{(bf16*)(F.ws + WS_Y), (const float*)(F.ws + WS_RG), DM / 256, (size_t)(WS_Y2 - WS_Y) / 2};
        pg8::gemm_phase<pg8::EpiRowScale, pg8::MoeOrder, true, true>(F.lds + RING_OFF, g, S, E); } SEAM(18);
    if (IN(19)) { p19_final(F, args); }
#undef IN
#undef SEAM
#undef CONV_BEGIN
#undef CONV_END
#undef TAIL_FILL
}

#ifndef MK_PER_PHASE
#define MK_PER_PHASE 0
#endif
extern "C" void kernel_launch(void* const* d_in, const int* in_sizes, int n_in, void* d_out, int out_size, void* d_ws, size_t ws_size, hipStream_t stream) {
    static int grid = 0;
    if (grid == 0) {
        if (n_in != 28 || out_size != MTOK * DM || ws_size < WS_END) { fprintf(stderr, "kernel_launch: unexpected shapes (n_in %d, out %d, ws %zu < %zu)\n", n_in, out_size, ws_size, (size_t)WS_END); grid = -1; return; }
        int dev = 0, cus = 0, per_cu = 0;
        if (hipGetDevice(&dev) != hipSuccess || hipDeviceGetAttribute(&cus, hipDeviceAttributeMultiprocessorCount, dev) != hipSuccess) { grid = -1; return; }
        if (hipFuncSetAttribute((const void*)yoco_fwd, hipFuncAttributeMaxDynamicSharedMemorySize, LDS_BYTES) != hipSuccess) { fprintf(stderr, "kernel_launch: hipFuncSetAttribute failed\n"); grid = -1; return; }
        if (hipOccupancyMaxActiveBlocksPerMultiprocessor(&per_cu, (const void*)yoco_fwd, NWAVES * 64, LDS_BYTES) != hipSuccess || per_cu < 1) fprintf(stderr, "kernel_launch: occupancy query reports %d\n", per_cu);
        (void)hipGetLastError();
        grid = cus;
    }
    if (grid < 0) return;
    if (hipMemsetAsync((char*)d_ws + WS_CTL, 0, CTL_ZERO_BYTES, stream) != hipSuccess) return;
    Args a{};
    for (int i = 0; i < 28; ++i) a.in[i] = d_in[i];
    a.out = (float*)d_out; a.ws = (unsigned char*)d_ws;
#if MK_PER_PHASE
    for (int p = 0; p < N_PHASES; ++p) { a.ph_lo = p; a.ph_hi = p + 1; hipLaunchKernelGGL(yoco_fwd, dim3(grid), dim3(NWAVES * 64), LDS_BYTES, stream, a); }
#else
    a.ph_lo = 0; a.ph_hi = N_PHASES;
    hipLaunchKernelGGL(yoco_fwd, dim3(grid), dim3(NWAVES * 64), LDS_BYTES, stream, a);
#endif
    const hipError_t le = hipPeekAtLastError();
    if (le != hipSuccess) fprintf(stderr, "kernel_launch: launch failed: %s\n", hipGetErrorName(le));
}
```

```cpp
#include <hip/hip_runtime.h>
#include <cstdio>
#include <cstdint>
namespace pg8 {
#define PG8_LAS __attribute__((address_space(3)))
typedef unsigned short bf16_t;
typedef short bf16x8 __attribute__((ext_vector_type(8)));
typedef float f32x4 __attribute__((ext_vector_type(4)));
typedef unsigned u32x4 __attribute__((ext_vector_type(4)));
constexpr int BM = 256, BK = 64, HALF = 128, HTB = HALF * BK * 2  , STAGE_BYTES = 8 * HTB, NXCD = 8, WGM = 8;

__host__ __device__ __forceinline__ int lds_byte(int r, int c) { const int st = (r >> 4) * 2 + (c >> 5), rr = r & 15, cc = c & 31, ob = rr * 64 + cc * 2; return st * 1024 + (ob ^ (((ob >> 9) & 1) << 5)); }
__host__ __device__ __forceinline__ void stage_rc(int b, int& R, int& C) { const int st = b / 1024, sb = b % 1024, swz = sb ^ (((sb >> 9) & 1) << 5); R = (st >> 1) * 16 + swz / 64; C = (st & 1) * 32 + (swz % 64) / 2; }
__host__ __device__ __forceinline__ int perm32(int rho) { const int n = rho >> 4, i = rho & 15; return 8 * (i >> 2) + 4 * n + (i & 3); }

struct Unit { int pm, pn, kofs; };
struct Gemm { const bf16_t* A; const bf16_t* Bt; int M, N, K, Kext; };

__device__ __forceinline__ void tile_map(int L, int nM, int nN, int& pm, int& pn) {
    const int nwg = nM * nN; int wgid = L;
    { const int q = nwg / NXCD, r = nwg % NXCD, xcd = wgid % NXCD, off = wgid / NXCD; wgid = (xcd < r ? xcd * (q + 1) : r * (q + 1) + (xcd - r) * q) + off; }
    const int nig = WGM * nN, gid = wgid / nig, fm = gid * WGM, gsz = (nM - fm) < WGM ? (nM - fm) : WGM;
    pm = fm + ((wgid % nig) % gsz); pn = (wgid % nig) / gsz;
}
struct StaticOrder {
    int nM, nN, nwg, G, c;
    __device__ void init(int M, int N, int G_, int c_) { nM = M / BM; nN = N / BM; nwg = nM * nN; G = G_; c = c_; }
    __device__ bool next(int i, Unit& u) const { const long L = (long)i * G + c; if (L >= nwg) return false; tile_map((int)L, nM, nN, u.pm, u.pn); u.kofs = 0; return true; }
    __device__ __forceinline__ void a_ready(const Unit&) const {}
    __device__ __forceinline__ void done(const Unit&) const {}
};
struct DualOrder {
    int nM, nN1, nN2, n1, ntot, pm_off, pn_off, G, c;
    __device__ void init(int nM_, int nN1_, int nN2_, int pm_off_, int pn_off_, int G_, int c_) { nM = nM_; nN1 = nN1_; nN2 = nN2_; n1 = nM * nN1; ntot = n1 + nM * nN2; pm_off = pm_off_; pn_off = pn_off_; G = G_; c = c_; }
    __device__ bool next(int i, Unit& u) const { const long L = (long)i * G + c; if (L >= ntot) return false;
        if (L < n1) tile_map((int)L, nM, nN1, u.pm, u.pn); else { tile_map((int)L - n1, nM, nN2, u.pm, u.pn); u.pm += pm_off; u.pn += pn_off; } u.kofs = 0; return true; }
    __device__ __forceinline__ void a_ready(const Unit&) const {}
    __device__ __forceinline__ void done(const Unit&) const {}
};
struct MoeOrder {
    int toff[9]; int nN, T, total, G, c, ksplit, klen;
    __device__ bool next(int i, Unit& u) const {
        long v;
        if ((G & 7) == 0) { const int x = c & 7, j = c >> 3, nper = G >> 3; const long s0 = ((long)x * total) >> 3, s1 = ((long)(x + 1) * total) >> 3; v = s0 + (long)i * nper + j; if (v >= s1) return false; }
        else { v = (long)i * G + c; if (v >= total) return false; }
        const int per = nN * ksplit;
        int e = 0, te = 0, te1 = toff[1];
#pragma unroll
        for (int k = 1; k < 8; ++k) { const bool ge = v >= (long)toff[k] * per; e = ge ? k : e; te = ge ? toff[k] : te; te1 = ge ? toff[k + 1] : te1; }
        const int r = (int)(v - (long)te * per), ne = te1 - te, q = r / ne, kh = q % ksplit;
        u.pm = te + r % ne; u.pn = e * nN + q / ksplit; u.kofs = kh * klen; return true; }
    __device__ __forceinline__ void a_ready(const Unit&) const {}
    __device__ __forceinline__ void done(const Unit&) const {}
};

__device__ __forceinline__ unsigned cvt_pk_bf16(float lo, float hi) { unsigned r; asm volatile("v_cvt_pk_bf16_f32 %0, %1, %2" : "=v"(r) : "v"(lo), "v"(hi)); return r; }

struct EpiBf16Sel {
    static constexpr bool PERM = true, AFTER_DRAIN = false;
    bf16_t* O0; int ld0; bf16_t* O1; int ld1; int pm_split, pn_split;
    __device__ __forceinline__ void operator()(const f32x4 (&acc)[2][2][4][2], const Unit& u, int wr, int wc, int fr, int fq) const {
        bf16_t* base = O0; int ldc = ld0, pm = u.pm, pn = u.pn;
        if (pn >= pn_split) { base = O1; ldc = ld1; pm -= pm_split; pn -= pn_split; }
        const int row0 = pm * BM + wr * 64 + fr, col0 = pn * BM + wc * 32 + 8 * fq;
#pragma unroll
        for (int ai = 0; ai < 2; ++ai)
#pragma unroll
            for (int m = 0; m < 4; ++m) { bf16_t* rowp = base + (size_t)(row0 + ai * HALF + m * 16) * ldc + col0;
#pragma unroll
                for (int bj = 0; bj < 2; ++bj) { const f32x4 v0 = acc[ai][bj][m][0], v1 = acc[ai][bj][m][1];
                    u32x4 w; w.x = cvt_pk_bf16(v0[0], v0[1]); w.y = cvt_pk_bf16(v0[2], v0[3]); w.z = cvt_pk_bf16(v1[0], v1[1]); w.w = cvt_pk_bf16(v1[2], v1[3]);
                    *(u32x4*)(rowp + bj * HALF) = w; } }
    }
};
struct EpiResGate {
    static constexpr bool PERM = false, AFTER_DRAIN = false;
    const float* base; float* out; const float* gate; int gstride;
    __device__ __forceinline__ void operator()(const f32x4 (&acc)[2][2][4][2], const Unit& u, int wr, int wc, int fr, int fq) const {
        const int row0 = u.pm * BM + wr * 64 + fr, col0 = u.pn * BM + wc * 32 + 4 * fq;
        const float* gp = gate + (size_t)(u.pm >> 3) * gstride + col0;
        f32x4 gv[2][2];
#pragma unroll
        for (int bj = 0; bj < 2; ++bj)
#pragma unroll
            for (int n = 0; n < 2; ++n) gv[bj][n] = *(const f32x4*)(gp + bj * HALF + n * 16);
#pragma unroll
        for (int ai = 0; ai < 2; ++ai)
#pragma unroll
            for (int m = 0; m < 4; ++m) { const size_t off = (size_t)(row0 + ai * HALF + m * 16) * 2048 + col0;
#pragma unroll
                for (int bj = 0; bj < 2; ++bj)
#pragma unroll
                    for (int n = 0; n < 2; ++n) { const f32x4 bs = *(const f32x4*)(base + off + bj * HALF + n * 16); *(f32x4*)(out + off + bj * HALF + n * 16) = bs + gv[bj][n] * acc[ai][bj][m][n]; }
                asm volatile("" ::: "memory"); }
    }
};
struct EpiSwiGLU {
    static constexpr bool PERM = true, AFTER_DRAIN = false;
    bf16_t* O; int ldc; int nN;
    __device__ __forceinline__ void operator()(const f32x4 (&acc)[2][2][4][2], const Unit& u, int wr, int wc, int fr, int fq) const {
        const int row0 = u.pm * BM + wr * 64 + fr, col0 = (u.pn % nN) * HALF + wc * 32 + 8 * fq;
#pragma unroll
        for (int ai = 0; ai < 2; ++ai)
#pragma unroll
            for (int m = 0; m < 4; ++m) { bf16_t* rowp = O + (size_t)(row0 + ai * HALF + m * 16) * ldc + col0;
                float r[8];
#pragma unroll
                for (int n = 0; n < 2; ++n)
#pragma unroll
                    for (int j = 0; j < 4; ++j) { const float g = acc[ai][0][m][n][j], up = acc[ai][1][m][n][j];
                        r[4 * n + j] = g * up * __builtin_amdgcn_rcpf(1.0f + __builtin_amdgcn_exp2f(-1.4426950408889634f * g)); }
                u32x4 w; w.x = cvt_pk_bf16(r[0], r[1]); w.y = cvt_pk_bf16(r[2], r[3]); w.z = cvt_pk_bf16(r[4], r[5]); w.w = cvt_pk_bf16(r[6], r[7]);
                *(u32x4*)rowp = w; }
    }
};
struct EpiRowScale {
    static constexpr bool PERM = true, AFTER_DRAIN = false;
    bf16_t* Y; const float* rs; int nN; size_t part_stride;
    __device__ __forceinline__ void operator()(const f32x4 (&acc)[2][2][4][2], const Unit& u, int wr, int wc, int fr, int fq) const {
        const int row0 = u.pm * BM + wr * 64 + fr, col0 = (u.pn % nN) * BM + wc * 32 + 8 * fq;
        bf16_t* Yp = Y + (u.kofs ? part_stride : 0);
#pragma unroll
        for (int ai = 0; ai < 2; ++ai)
#pragma unroll
            for (int m = 0; m < 4; ++m) { const int row = row0 + ai * HALF + m * 16; const float s = rs[row]; bf16_t* rowp = Yp + (size_t)row * 2048 + col0;
#pragma unroll
                for (int bj = 0; bj < 2; ++bj) { const f32x4 v0 = acc[ai][bj][m][0] * s, v1 = acc[ai][bj][m][1] * s;
                    u32x4 w; w.x = cvt_pk_bf16(v0[0], v0[1]); w.y = cvt_pk_bf16(v0[2], v0[3]); w.z = cvt_pk_bf16(v1[0], v1[1]); w.w = cvt_pk_bf16(v1[2], v1[3]);
                    *(u32x4*)(rowp + bj * HALF) = w; } }
    }
};

template <class Epi, class Sched, bool ALIGN_EPI = false, bool SP2 = false>
__device__ __forceinline__ void gemm_phase(PG8_LAS unsigned char* lds, const Gemm g, const Sched& S, const Epi& E) {
    const int tid = threadIdx.x, wid = __builtin_amdgcn_readfirstlane(tid >> 6), lane = tid & 63, wr = wid >> 2, wc = wid & 3, fr = lane & 15, fq = lane >> 4;
    const int K = g.K, nt = g.Kext / BK;
    unsigned voffA[2], voffB[2];
#pragma unroll
    for (int i = 0; i < 2; ++i) { int R, C; stage_rc(tid * 16 + i * 8192, R, C); const int Rb = Epi::PERM ? ((R & ~31) + perm32(R & 31)) : R;
        voffA[i] = (unsigned)(R * K + C) * 2u; voffB[i] = (unsigned)(Rb * K + C) * 2u; }
    const size_t kstep = (size_t)(BK * 2);
    const size_t hstep = (size_t)HALF * K * 2;
    const size_t tstep = 2 * hstep;
    const unsigned ldsw = (unsigned)wid * 1024u;
    const int aoff = lds_byte(wr * 64 + fr, fq * 8), boff = lds_byte(wc * 32 + fr, fq * 8);
#define PG8_SA(b, h) (((b) * 2 + (h)) * HTB)
#define PG8_SB(b, h) ((4 + (b) * 2 + (h)) * HTB)
#define PG8_STAGE(bufoff, gbase, voff) do { _Pragma("unroll") for (int _i = 0; _i < 2; ++_i) \
        __builtin_amdgcn_global_load_lds((const unsigned*)((const char*)(gbase) + (voff)[_i]), (PG8_LAS unsigned*)(lds + (bufoff) + ldsw + _i * 8192), 16, 0, 0); } while (0)
#define PG8_LDA(dst, b, h) do { _Pragma("unroll") for (int m = 0; m < 4; ++m) _Pragma("unroll") for (int k = 0; k < 2; ++k) dst[m][k] = *(const PG8_LAS bf16x8*)(lds + PG8_SA(b, h) + aoff + m * 2048 + k * 1024); } while (0)
#define PG8_LDB(dst, b, h) do { _Pragma("unroll") for (int n = 0; n < 2; ++n) _Pragma("unroll") for (int k = 0; k < 2; ++k) dst[n][k] = *(const PG8_LAS bf16x8*)(lds + PG8_SB(b, h) + boff + n * 2048 + k * 1024); } while (0)
#define PG8_MMA(ai, bj, At, Bt) do { __builtin_amdgcn_s_setprio(1); _Pragma("unroll") for (int m = 0; m < 4; ++m) _Pragma("unroll") for (int n = 0; n < 2; ++n) _Pragma("unroll") for (int k = 0; k < 2; ++k) \
        acc[ai][bj][m][n] = __builtin_amdgcn_mfma_f32_16x16x32_bf16(Bt[n][k], At[m][k], acc[ai][bj][m][n], 0, 0, 0); __builtin_amdgcn_s_setprio(0); } while (0)
#define PG8_WAIT_V(n) asm volatile("s_waitcnt vmcnt(" #n ")" ::: "memory")
#define PG8_WAIT_L(n) asm volatile("s_waitcnt lgkmcnt(" #n ")" ::: "memory")
#define PG8_BAR __builtin_amdgcn_s_barrier()
#define PG8_SCHED __builtin_amdgcn_sched_barrier(0)
    Unit cur, nxt; int ui = 0;
    if (!S.next(0, cur)) return;
    f32x4 acc[2][2][4][2];
#pragma unroll
    for (int a = 0; a < 2; ++a)
#pragma unroll
        for (int b = 0; b < 2; ++b)
#pragma unroll
            for (int m = 0; m < 4; ++m)
#pragma unroll
                for (int n = 0; n < 2; ++n) acc[a][b][m][n] = (f32x4){0.f, 0.f, 0.f, 0.f};
    bf16x8 At[4][2], B0[2][2], B1[2][2];
    const char* cA = (const char*)g.A + (size_t)cur.pm * tstep + (size_t)cur.kofs * 2; const char* cB = (const char*)g.Bt + (size_t)cur.pn * tstep + (size_t)cur.kofs * 2;
    S.a_ready(cur);
    if constexpr (SP2) {
        PG8_STAGE(PG8_SB(0, 0), cB, voffB); PG8_STAGE(PG8_SB(0, 1), cB + hstep, voffB); PG8_STAGE(PG8_SA(0, 0), cA, voffA); PG8_STAGE(PG8_SA(0, 1), cA + hstep, voffA);
        if (wr == 1) PG8_BAR;
        PG8_WAIT_V(2); PG8_BAR;
        PG8_STAGE(PG8_SB(1, 0), cB + kstep, voffB); PG8_STAGE(PG8_SA(1, 0), cA + kstep, voffA); PG8_STAGE(PG8_SB(1, 1), cB + hstep + kstep, voffB);
        PG8_WAIT_V(6); PG8_BAR;
    } else {
        PG8_STAGE(PG8_SB(0, 0), cB, voffB); PG8_STAGE(PG8_SA(0, 0), cA, voffA); PG8_STAGE(PG8_SB(0, 1), cB + hstep, voffB); PG8_STAGE(PG8_SA(0, 1), cA + hstep, voffA);
        if (wr == 1) PG8_BAR;
        PG8_WAIT_V(4); PG8_BAR;
        PG8_STAGE(PG8_SB(1, 0), cB + kstep, voffB); PG8_STAGE(PG8_SA(1, 0), cA + kstep, voffA); PG8_STAGE(PG8_SB(1, 1), cB + hstep + kstep, voffB);
        PG8_WAIT_V(6); PG8_BAR;
    }
    for (;;) {
        const bool has_next = S.next(ui + 1, nxt);
        const char* nA = has_next ? (const char*)g.A + (size_t)nxt.pm * tstep + (size_t)nxt.kofs * 2 : cA; const char* nB = has_next ? (const char*)g.Bt + (size_t)nxt.pn * tstep + (size_t)nxt.kofs * 2 : cB;
        for (int t = 0; t < nt; t += 2) {
            const bool last = (t == nt - 2);
            const char* a1 = cA + (size_t)(t + 1) * kstep;
            const char* a2 = last ? nA : cA + (size_t)(t + 2) * kstep; const char* b2 = last ? nB : cB + (size_t)(t + 2) * kstep;
            const char* a3 = a2 + kstep; const char* b3 = b2 + kstep;
            if (last && has_next) S.a_ready(nxt);
            if constexpr (SP2) {
            PG8_LDB(B0, 0, 0); PG8_LDB(B1, 0, 1); PG8_SCHED; PG8_LDA(At, 0, 0); PG8_STAGE(PG8_SA(1, 1), a1 + hstep, voffA);
            PG8_WAIT_V(8); PG8_WAIT_L(0); PG8_BAR; PG8_MMA(0, 0, At, B0); PG8_MMA(0, 1, At, B1); PG8_BAR; PG8_SCHED;
            PG8_LDA(At, 0, 1); PG8_STAGE(PG8_SB(0, 0), b2, voffB); PG8_STAGE(PG8_SB(0, 1), b2 + hstep, voffB); PG8_STAGE(PG8_SA(0, 0), a2, voffA);
            PG8_WAIT_V(8); PG8_WAIT_L(0); PG8_BAR; PG8_MMA(1, 0, At, B0); PG8_MMA(1, 1, At, B1); PG8_BAR; PG8_SCHED;
            PG8_LDB(B0, 1, 0); PG8_LDB(B1, 1, 1); PG8_SCHED; PG8_LDA(At, 1, 0); PG8_STAGE(PG8_SA(0, 1), a2 + hstep, voffA);
            PG8_WAIT_V(8); PG8_WAIT_L(0); PG8_BAR; PG8_MMA(0, 0, At, B0); PG8_MMA(0, 1, At, B1); PG8_BAR; PG8_SCHED;
            PG8_LDA(At, 1, 1); PG8_STAGE(PG8_SB(1, 0), b3, voffB); PG8_STAGE(PG8_SB(1, 1), b3 + hstep, voffB); PG8_STAGE(PG8_SA(1, 0), a3, voffA);
            PG8_WAIT_V(8); PG8_WAIT_L(0); PG8_BAR; PG8_MMA(1, 0, At, B0); PG8_MMA(1, 1, At, B1); PG8_BAR; PG8_SCHED;
            } else {
            PG8_LDB(B0, 0, 0); PG8_SCHED; PG8_LDA(At, 0, 0); PG8_STAGE(PG8_SA(1, 1), a1 + hstep, voffA);
            PG8_WAIT_L(8); PG8_BAR; PG8_WAIT_L(0); PG8_MMA(0, 0, At, B0); PG8_BAR; PG8_SCHED;
            PG8_LDB(B1, 0, 1); PG8_STAGE(PG8_SB(0, 0), b2, voffB);
            PG8_BAR; PG8_WAIT_L(0); PG8_MMA(0, 1, At, B1); PG8_BAR;
            PG8_LDA(At, 0, 1); PG8_STAGE(PG8_SA(0, 0), a2, voffA);
            PG8_BAR; PG8_WAIT_L(0); PG8_MMA(1, 0, At, B0); PG8_BAR; PG8_SCHED;
            PG8_STAGE(PG8_SB(0, 1), b2 + hstep, voffB);
            PG8_WAIT_V(6); PG8_BAR; PG8_MMA(1, 1, At, B1); PG8_BAR;
            PG8_LDB(B0, 1, 0); PG8_SCHED; PG8_LDA(At, 1, 0); PG8_STAGE(PG8_SA(0, 1), a2 + hstep, voffA);
            PG8_WAIT_L(8); PG8_BAR; PG8_WAIT_L(0); PG8_MMA(0, 0, At, B0); PG8_BAR; PG8_SCHED;
            PG8_LDB(B1, 1, 1); PG8_STAGE(PG8_SB(1, 0), b3, voffB);
            PG8_BAR; PG8_WAIT_L(0); PG8_MMA(0, 1, At, B1); PG8_BAR;
            PG8_LDA(At, 1, 1); PG8_STAGE(PG8_SA(1, 0), a3, voffA);
            PG8_BAR; PG8_WAIT_L(0); PG8_MMA(1, 0, At, B0); PG8_BAR; PG8_SCHED;
            PG8_STAGE(PG8_SB(1, 1), b3 + hstep, voffB);
            PG8_WAIT_V(6); PG8_BAR; PG8_MMA(1, 1, At, B1); PG8_BAR;
            }
        }
        if constexpr (ALIGN_EPI) { if (wr == 0) PG8_BAR; }
        if constexpr (!Epi::AFTER_DRAIN) { E(acc, cur, wr, wc, fr, fq); S.done(cur); }
        if (!has_next) break;
#pragma unroll
        for (int a = 0; a < 2; ++a)
#pragma unroll
            for (int b = 0; b < 2; ++b)
#pragma unroll
                for (int m = 0; m < 4; ++m)
#pragma unroll
                    for (int n = 0; n < 2; ++n) acc[a][b][m][n] = (f32x4){0.f, 0.f, 0.f, 0.f};
        cur = nxt; cA = nA; cB = nB; ++ui;
        if constexpr (ALIGN_EPI) { if (wr == 1) PG8_BAR; }
    }
    PG8_WAIT_V(0);
    if constexpr (!ALIGN_EPI) { if (wr == 0) PG8_BAR; }
    PG8_BAR;
    if constexpr (Epi::AFTER_DRAIN) { E.fused(acc, cur, wr, wc, fr, fq, lds, wid, lane); S.done(cur); }
#undef PG8_SA
#undef PG8_SB
#undef PG8_STAGE
#undef PG8_LDA
#undef PG8_LDB
#undef PG8_MMA
#undef PG8_WAIT_V
#undef PG8_WAIT_L
#undef PG8_BAR
#undef PG8_SCHED
}
}

constexpr int NB = 4, SEQ = 2048, DM = 2048, MTOK = NB * SEQ;
constexpr int A_IN = 4176, A_INP = 4352;
constexpr int C_Q = 0, C_K = 2048, C_V = 2560, C_QI = 3072, C_KI = 4096, C_WI = 4160;
constexpr int DFF = 5632, DFFE = 7168, NEXP = 8;
constexpr int NMOD = 28672;
constexpr float EPS = 1e-6f, LOG2E = 1.4426950408889634f;
constexpr int MROWS = 2 * MTOK + NEXP * 256;

constexpr size_t MiB = 1u << 20;
constexpr size_t WS_CTL = 0, CTL_ZERO_BYTES = 1 * MiB;
constexpr size_t WS_MOD = 1 * MiB, WS_BT = WS_MOD + 512 * 1024, WS_ROUTE = WS_MOD + 768 * 1024;
constexpr size_t WS_WIN = 2 * MiB, WS_WAOUT = 19 * MiB, WS_WF13 = 27 * MiB, WS_WF2 = 71 * MiB, WS_WKVQ = 93 * MiB, WS_WBOUT = 129 * MiB, WS_WM13 = 133 * MiB, WS_WM2 = 581 * MiB;
constexpr size_t WS_HA = 805 * MiB, WS_AR = 869 * MiB;
constexpr size_t WS_P0 = WS_AR, WS_QN = WS_AR + 68 * MiB, WS_KN = WS_AR + 100 * MiB, WS_VT = WS_AR + 108 * MiB, WS_MASK = WS_AR + 116 * MiB, WS_O = WS_AR + 118 * MiB, WS_U = WS_AR + 150 * MiB;
constexpr size_t WS_KV = WS_AR, WS_Q1 = WS_AR + 96 * MiB, WS_K1N = WS_AR + 144 * MiB, WS_Q1N = WS_AR + 192 * MiB, WS_VT1 = WS_AR + 240 * MiB, WS_OG = WS_AR + 288 * MiB, WS_LSE = WS_AR + 336 * MiB, WS_O1 = WS_AR + 338 * MiB;
constexpr size_t WS_AS = WS_AR, WS_UM = WS_AR + 72 * MiB, WS_Y = WS_AR + 324 * MiB, WS_Y2 = WS_AR + 468 * MiB, WS_RG = WS_AR + 612 * MiB, WS_TR = WS_AR + 613 * MiB;
constexpr size_t WS_END = WS_AR + 614 * MiB;
static_assert((size_t)A_INP * DM * 2 <= 17 * MiB && (size_t)MROWS * DFFE * 2 <= 252 * MiB && (size_t)MROWS * DM * 4 <= 144 * MiB && (size_t)MROWS * DM * 2 <= 72 * MiB, "ws map");
constexpr int CW_TMO = 0, CW_CODE = 1, CW_BAR = 4096, CW_CNT = 8192, CW_CUR = 16384;

constexpr int RING_OFF = 0, RING_BYTES = 131072;
constexpr int LDSCTL_OFF = RING_BYTES, MISC_OFF = LDSCTL_OFF + 320;
constexpr int LDS_BYTES = 147456;
constexpr int NWAVES = 8;

#define GAS __attribute__((address_space(1)))
#define LAS __attribute__((address_space(3)))
typedef unsigned short bf16;
typedef unsigned v4u __attribute__((ext_vector_type(4)));
typedef unsigned v2u __attribute__((ext_vector_type(2)));
typedef float f32x4 __attribute__((ext_vector_type(4)));
typedef float f32x2 __attribute__((ext_vector_type(2)));
typedef float f32x16 __attribute__((ext_vector_type(16)));
typedef int i32x4 __attribute__((ext_vector_type(4)));
typedef short bf16x8 __attribute__((ext_vector_type(8)));
typedef GAS unsigned gu32;
#define RLX_AGENT __ATOMIC_RELAXED, __HIP_MEMORY_SCOPE_AGENT
#define MFMA32(a, b, c) __builtin_amdgcn_mfma_f32_32x32x16_bf16((a), (b), (c), 0, 0, 0)
__device__ __forceinline__ unsigned f2bf(float f) { unsigned u = __builtin_bit_cast(unsigned, f); return (u + 0x7fffu + ((u >> 16) & 1u)) >> 16; }
__device__ __forceinline__ unsigned pk2(float lo, float hi) { return f2bf(lo) | (f2bf(hi) << 16); }
__device__ __forceinline__ float bflo(unsigned w) { return __builtin_bit_cast(float, w << 16); }
__device__ __forceinline__ float bfhi(unsigned w) { return __builtin_bit_cast(float, w & 0xffff0000u); }
typedef float f32x2_t __attribute__((ext_vector_type(2)));
typedef __bf16 bf16x2_t __attribute__((ext_vector_type(2)));
__device__ __forceinline__ unsigned cvtpk(float lo, float hi) { f32x2_t v = {lo, hi}; bf16x2_t b = __builtin_convertvector(v, bf16x2_t); return __builtin_bit_cast(unsigned, b); }
__device__ __forceinline__ bf16x8 pack8(float a0, float a1, float a2, float a3, float a4, float a5, float a6, float a7) {
    v4u p; p.x = cvtpk(a0, a1); p.y = cvtpk(a2, a3); p.z = cvtpk(a4, a5); p.w = cvtpk(a6, a7); return __builtin_bit_cast(bf16x8, p); }
#define XB_TMO      128
#define XB_XCNT(j)  (256  + 64 * (j))
#define XB_XSUB(j)  (1280 + 64 * (j))
#define XB_XGEN(j)  (2304 + 64 * (j))
#define XB_TOP      3328
#define XB_TOPGEN   3392
#define XCD_BAR_WORDS 3456
#define XB_SPIN_CAP (1u << 18)

__device__ __forceinline__ unsigned xb_ld(unsigned* p)              { return __hip_atomic_load(p, __ATOMIC_RELAXED, __HIP_MEMORY_SCOPE_AGENT); }
__device__ __forceinline__ unsigned xb_add(unsigned* p, unsigned v) { return __hip_atomic_fetch_add(p, v, __ATOMIC_RELAXED, __HIP_MEMORY_SCOPE_AGENT); }
__device__ __forceinline__ unsigned xb_xcc_id() { return (unsigned)__builtin_amdgcn_s_getreg((3 << 11) | 20) & 0xFu; }
#define XB_SPIN(cond, bar) do { unsigned _sp = 0; while (cond) { __builtin_amdgcn_s_sleep(1); \
    if ((++_sp & 255u) == 0u) { if (xb_ld(&(bar)[XB_TMO])) break; if (_sp > XB_SPIN_CAP) { atomicAdd(&(bar)[XB_TMO], 1u); break; } } } } while (0)

struct XcdBarrier {
    unsigned* bar; unsigned x;
    volatile LAS unsigned* st;
};

__device__ __forceinline__ XcdBarrier xcd_barrier_post(unsigned* bar, volatile LAS unsigned* st) {
    XcdBarrier b; b.bar = bar; b.x = xb_xcc_id(); b.st = st;
    if (threadIdx.x == 0) (void)xb_add(&bar[XB_XCNT(b.x)], 1u);
    return b;
}
__device__ __forceinline__ void xcd_barrier_complete(unsigned* bar, unsigned x, unsigned& nloc, unsigned& nx) {
    const unsigned G = gridDim.x * gridDim.y * gridDim.z;
    unsigned sum, cnt, mine, sp = 0u;
    for (;;) {
        sum = 0u; cnt = 0u; mine = 0u;
#pragma unroll
        for (unsigned j = 0; j < 16; ++j) { const unsigned c = xb_ld(&bar[XB_XCNT(j)]); sum += c; cnt += (c > 0u) ? 1u : 0u; mine = (j == x) ? c : mine; }
        if (sum == G) break;
        __builtin_amdgcn_s_sleep(1);
        if ((++sp & 255u) == 0u) { if (xb_ld(&bar[XB_TMO])) break; if (sp > XB_SPIN_CAP) { atomicAdd(&bar[XB_TMO], 1u); break; } }
    }
    nloc = mine > 0u ? mine : 1u; nx = cnt > 0u ? cnt : 1u;
}

__device__ __forceinline__ void xcd_barrier(const XcdBarrier& b) {
    asm volatile("s_waitcnt vmcnt(0)" ::: "memory");
    __syncthreads();
    if (threadIdx.x == 0) {
        unsigned* bar = b.bar;
        __builtin_amdgcn_s_waitcnt(0);
        unsigned nloc = b.st[0], nx = b.st[1];
        if (nloc == 0u) { xcd_barrier_complete(bar, b.x, nloc, nx); b.st[0] = nloc; b.st[1] = nx; }
        const unsigned old = xb_add(&bar[XB_XSUB(b.x)], 1u);
        const unsigned gen = old / nloc;
        if (old + 1u == (gen + 1u) * nloc) {
            __builtin_amdgcn_fence(__ATOMIC_RELEASE, "agent");
            asm volatile("s_waitcnt vmcnt(0)" ::: "memory");
            const unsigned og = xb_add(&bar[XB_TOP], 1u);
            const unsigned tg = og / nx;
            if (og + 1u == (tg + 1u) * nx) xb_add(&bar[XB_TOPGEN], 1u);
            else XB_SPIN(xb_ld(&bar[XB_TOPGEN]) == tg, bar);
            __builtin_amdgcn_fence(__ATOMIC_ACQUIRE, "agent");
            xb_add(&bar[XB_XGEN(b.x)], 1u);
            asm volatile("s_waitcnt vmcnt(0)" ::: "memory");
        } else {
            XB_SPIN(xb_ld(&bar[XB_XGEN(b.x)]) == gen, bar);
            __builtin_amdgcn_fence(__ATOMIC_ACQUIRE, "agent");
            asm volatile("s_waitcnt vmcnt(0)" ::: "memory");
        }
    }
    __syncthreads();
}

struct Args { const void* in[28]; float* out; unsigned char* ws; int ph_lo, ph_hi; };
struct Frame {
    LAS unsigned char* lds; volatile LAS unsigned* MISC; gu32* ctl; unsigned char* ws;
    int tid, lane, wave, G, bid;
};
#define LDS_WAIT() asm volatile("s_waitcnt lgkmcnt(0)" ::: "memory")
__device__ __forceinline__ float wave_sum(float v) {
#pragma unroll
    for (int o = 1; o < 64; o <<= 1) v += __shfl_xor(v, o);
    return v;
}

__device__ __forceinline__ int t5_bucket(int n) {
    if (n < 16) return n;
    const float v = logf((float)n / 16.0f) / 4.852030263919617f * 16.0f;
    const int l = 16 + (int)v; return l < 31 ? l : 31;
}
__device__ __forceinline__ void cvt_tile(const float* __restrict__ src, int N, int k0, int n0, int nvalid, bf16* __restrict__ dst, size_t drow0, int Kd, int lane) {
    const int cl = lane & 15, kg = lane >> 4;
    f32x4 v[16];
    const float* sp = src + (size_t)(k0 + 16 * kg) * N + n0 + 4 * cl;
    const bool ok = 4 * cl < nvalid;
#pragma unroll
    for (int i = 0; i < 16; ++i) v[i] = ok ? *(const f32x4*)(sp + (size_t)i * N) : (f32x4){0.f, 0.f, 0.f, 0.f};
    bf16* dp = dst + (drow0 + 4 * cl) * (size_t)Kd + k0 + 16 * kg;
#pragma unroll
    for (int e = 0; e < 4; ++e) {
        v4u a, b;
        a.x = pk2(v[0][e], v[1][e]); a.y = pk2(v[2][e], v[3][e]); a.z = pk2(v[4][e], v[5][e]); a.w = pk2(v[6][e], v[7][e]);
        b.x = pk2(v[8][e], v[9][e]); b.y = pk2(v[10][e], v[11][e]); b.z = pk2(v[12][e], v[13][e]); b.w = pk2(v[14][e], v[15][e]);
        *(v4u*)(dp + (size_t)e * Kd) = a; *(v4u*)(dp + (size_t)e * Kd + 8) = b;
    }
}
__device__ __forceinline__ void p0_prologue(Frame& F, const Args& A) {
    const float* c_in = (const float*)A.in[1];
    const float* rel_bias = (const float*)A.in[3];
    float* MOD = (float*)(F.ws + WS_MOD); float* BT = (float*)(F.ws + WS_BT);
    LAS float* cs = (LAS float*)F.lds; LAS float* red = (LAS float*)(F.lds + 32768);
    for (int i = F.tid; i < NB * DM; i += NWAVES * 64) { const float v = c_in[i]; cs[i] = v / (1.0f + __expf(-v)); }
    __syncthreads();
    for (int item = F.bid; item < NMOD / 128; item += F.G) {
        const int j0 = item * 128; const float* W; const float* bias; int N, jl;
        if (j0 < 12288) { W = (const float*)A.in[4]; N = 12288; jl = j0; bias = (const float*)A.in[5]; }
        else if (j0 < 24576) { W = (const float*)A.in[4] + (size_t)DM * 12288; N = 12288; jl = j0 - 12288; bias = (const float*)A.in[5] + 12288; }
        else { W = (const float*)A.in[12]; N = 4096; jl = j0 - 24576; bias = (const float*)A.in[13]; }
        const float* wp = W + (size_t)(256 * F.wave) * N + jl + 2 * F.lane;
        float a[4][2];
#pragma unroll
        for (int b = 0; b < 4; ++b) { a[b][0] = 0.f; a[b][1] = 0.f; }
        for (int k = 0; k < 256; k += 8) {
            f32x2 w[8];
#pragma unroll
            for (int i = 0; i < 8; ++i) w[i] = *(const f32x2*)(wp + (size_t)(k + i) * N);
#pragma unroll
            for (int i = 0; i < 8; ++i)
#pragma unroll
                for (int b = 0; b < 4; ++b) { const float cv = cs[b * DM + 256 * F.wave + k + i]; a[b][0] += cv * w[i].x; a[b][1] += cv * w[i].y; }
        }
#pragma unroll
        for (int b = 0; b < 4; ++b) { red[(F.wave * 4 + b) * 128 + 2 * F.lane] = a[b][0]; red[(F.wave * 4 + b) * 128 + 2 * F.lane + 1] = a[b][1]; }
        __syncthreads();
        { const int b = F.tid >> 7, col = F.tid & 127; float s = bias[jl + col];
#pragma unroll
          for (int w = 0; w < 8; ++w) s += red[(w * 4 + b) * 128 + col];
          MOD[(size_t)b * NMOD + j0 + col] = s; }
        __syncthreads();
    }
    for (int idx = F.bid * (NWAVES * 64) + F.tid; idx < 16 * 2048; idx += F.G * NWAVES * 64) { const int h = idx >> 11, n = idx & 2047; BT[idx] = rel_bias[t5_bucket(n) * 16 + h] * LOG2E; }
    const int gw = F.bid * NWAVES + F.wave, NGW = F.G * NWAVES;
    constexpr int T_IN = 32 * 68, T_AOUT = 32 * 32, T_F1 = 32 * 88, T_F2 = 88 * 32, T_KV = 32 * 96, T_BQ = 32 * 48, T_BOUT = 16 * 32;
    constexpr int NITEMS = T_IN + T_AOUT + 2 * T_F1 + T_F2 + T_KV + T_BQ + T_BOUT;
    for (int it = gw; it < NITEMS; it += NGW) {
        int r = it;
        if (r < T_IN) { const int kb = r / 68, nb = r % 68; cvt_tile((const float*)A.in[8], A_IN, 64 * kb, 64 * nb, A_IN - 64 * nb, (bf16*)(F.ws + WS_WIN), (size_t)64 * nb, DM, F.lane); continue; } r -= T_IN;
        if (r < T_AOUT) { const int kb = r / 32, nb = r % 32; cvt_tile((const float*)A.in[9], DM, 64 * kb, 64 * nb, 64, (bf16*)(F.ws + WS_WAOUT), (size_t)64 * nb, DM, F.lane); continue; } r -= T_AOUT;
        if (r < T_F1) { const int kb = r / 88, nb = r % 88, n0 = 64 * nb; cvt_tile((const float*)A.in[20], DFF, 64 * kb, n0, 64, (bf16*)(F.ws + WS_WF13), (size_t)((n0 >> 7) * 256 + (n0 & 127)), DM, F.lane); continue; } r -= T_F1;
        if (r < T_F1) { const int kb = r / 88, nb = r % 88, n0 = 64 * nb; cvt_tile((const float*)A.in[21], DFF, 64 * kb, n0, 64, (bf16*)(F.ws + WS_WF13), (size_t)((n0 >> 7) * 256 + 128 + (n0 & 127)), DM, F.lane); continue; } r -= T_F1;
        if (r < T_F2) { const int kb = r / 32, nb = r % 32; cvt_tile((const float*)A.in[22], DM, 64 * kb, 64 * nb, 64, (bf16*)(F.ws + WS_WF2), (size_t)64 * nb, DFF, F.lane); continue; } r -= T_F2;
        if (r < T_KV) { const int kb = r / 96, nb = r % 96; cvt_tile((const float*)A.in[15], 6144, 64 * kb, 64 * nb, 64, (bf16*)(F.ws + WS_WKVQ), (size_t)64 * nb, DM, F.lane); continue; } r -= T_KV;
        if (r < T_BQ) { const int kb = r / 48, nb = r % 48; cvt_tile((const float*)A.in[17], 3072, 64 * kb, 64 * nb, 64, (bf16*)(F.ws + WS_WKVQ), (size_t)(6144 + 64 * nb), DM, F.lane); continue; } r -= T_BQ;
        { const int kb = r / 32, nb = r % 32; cvt_tile((const float*)A.in[18], DM, 64 * kb, 64 * nb, 64, (bf16*)(F.ws + WS_WBOUT), (size_t)64 * nb, 1024, F.lane); }
    }
}
constexpr int CV_TME = 3584, CV_TM = 8 * CV_TME, NT_MOE = 3 * CV_TM;
__device__ __forceinline__ void moe_tile_addr(Frame& F, const Args& A, int t, const float*& sp, int& N, bf16*& dp, int& Kd) {
    const int cl = F.lane & 15, kg = F.lane >> 4; int r = t;
    if (r < 2 * CV_TM) { const int up = r >= CV_TM ? 1 : 0; r -= up * CV_TM; const int e = r / CV_TME, rr = r % CV_TME, kb = rr / 112, nb = rr % 112, n0 = 64 * nb;
        N = DFFE; Kd = DM; sp = (const float*)A.in[25 + up] + (size_t)e * DM * DFFE + (size_t)(64 * kb + 16 * kg) * DFFE + n0 + 4 * cl;
        dp = (bf16*)(F.ws + WS_WM13) + ((size_t)e * 14336 + (n0 >> 7) * 256 + 128 * up + (n0 & 127) + 4 * cl) * DM + 64 * kb + 16 * kg; }
    else { r -= 2 * CV_TM; const int e = r / CV_TME, rr = r % CV_TME, kb = rr / 32, nb = rr % 32;
        N = DM; Kd = DFFE; sp = (const float*)A.in[27] + (size_t)e * DFFE * DM + (size_t)(64 * kb + 16 * kg) * DM + 64 * nb + 4 * cl;
        dp = (bf16*)(F.ws + WS_WM2) + ((size_t)e * 2048 + 64 * nb + 4 * cl) * DFFE + 64 * kb + 16 * kg; }
}
__device__ __forceinline__ void cvt_load(f32x4 (&v)[16], const float* __restrict__ sp, int N) {
#pragma unroll
    for (int i = 0; i < 16; ++i) v[i] = *(const f32x4*)(sp + (size_t)i * N);
}
__device__ __forceinline__ void cvt_store(const f32x4 (&v)[16], bf16* __restrict__ dp, int Kd) {
#pragma unroll
    for (int e = 0; e < 4; ++e) {
        v4u a, b;
        a.x = pk2(v[0][e], v[1][e]); a.y = pk2(v[2][e], v[3][e]); a.z = pk2(v[4][e], v[5][e]); a.w = pk2(v[6][e], v[7][e]);
        b.x = pk2(v[8][e], v[9][e]); b.y = pk2(v[10][e], v[11][e]); b.z = pk2(v[12][e], v[13][e]); b.w = pk2(v[14][e], v[15][e]);
        *(v4u*)(dp + (size_t)e * Kd) = a; *(v4u*)(dp + (size_t)e * Kd + 8) = b;
    }
}
__device__ __forceinline__ int conv_fixed(Frame& F, const Args& A, int cur, int ntiles) {
    const int CV_STRIPES = F.G * NWAVES;
    f32x4 va[16], vb[16]; const float* sp; bf16* dpa; bf16* dpb; int N, Kda, Kdb;
    int left = ntiles;
    if (left <= 0 || cur >= NT_MOE) return cur;
    moe_tile_addr(F, A, cur, sp, N, dpa, Kda); cvt_load(va, sp, N); cur += CV_STRIPES; --left;
    for (;;) {
        const bool haveB = left > 0 && cur < NT_MOE;
        if (haveB) { moe_tile_addr(F, A, cur, sp, N, dpb, Kdb); cvt_load(vb, sp, N); cur += CV_STRIPES; --left; }
        cvt_store(va, dpa, Kda);
        if (!haveB) break;
        const bool haveA = left > 0 && cur < NT_MOE;
        if (haveA) { moe_tile_addr(F, A, cur, sp, N, dpa, Kda); cvt_load(va, sp, N); cur += CV_STRIPES; --left; }
        cvt_store(vb, dpb, Kdb);
        if (!haveA) break;
    }
    return cur;
}
__device__ __forceinline__ void conv_drain(Frame& F, const Args& A) {
    LAS int* curL = (LAS int*)F.lds;
    const int gw = F.bid * NWAVES + F.wave, NGW = F.G * NWAVES;
    __syncthreads();
    for (int j = F.tid; j < NGW; j += NWAVES * 64) curL[j] = (int)__hip_atomic_load((unsigned*)(F.ctl + CW_CUR + j), RLX_AGENT);
    __syncthreads();
    const int rows = (NT_MOE + NGW - 1) / NGW;
    for (int i = 0; i < rows; ++i) {
        const int j = (gw + 97 * i) % NGW, t = i * NGW + j;
        if (t >= NT_MOE || t < curL[j]) continue;
        const float* sp; bf16* dp; int N, Kd; f32x4 v[16];
        moe_tile_addr(F, A, t, sp, N, dp, Kd); cvt_load(v, sp, N); cvt_store(v, dp, Kd);
    }
    __syncthreads();
}

__device__ __forceinline__ float row_rstd(const f32x4 (&v)[8]) {
    float ss = 0.f;
#pragma unroll
    for (int j = 0; j < 8; ++j) ss += (v[j].x * v[j].x + v[j].y * v[j].y) + (v[j].z * v[j].z + v[j].w * v[j].w);
    return 1.0f / sqrtf(wave_sum(ss) * (1.0f / DM) + EPS);
}
__device__ __forceinline__ void modulate_store(const f32x4 (&v)[8], float rstd, const float* g, const float* sh, const float* sc, bf16* orow, int lane) {
#pragma unroll
    for (int j = 0; j < 8; ++j) { const int col = 4 * lane + 256 * j;
        const f32x4 gg = *(const f32x4*)(g + col), s1 = *(const f32x4*)(sc + col), s0 = *(const f32x4*)(sh + col);
        const f32x4 y = v[j] * rstd * gg * (s1 + 1.0f) + s0;
        v2u w; w.x = pk2(y.x, y.y); w.y = pk2(y.z, y.w); *(v2u*)(orow + col) = w; }
}
__device__ __forceinline__ void normmod_phase(Frame& F, const float* X, const float* g, const float* modsh, const float* modsc, bf16* out) {
    const int gw = F.bid * NWAVES + F.wave, NGW = F.G * NWAVES;
    for (int row = gw; row < MTOK; row += NGW) { const int b = row >> 11;
        f32x4 v[8]; const float* xr = X + (size_t)row * DM + 4 * F.lane;
#pragma unroll
        for (int j = 0; j < 8; ++j) v[j] = *(const f32x4*)(xr + 256 * j);
        const float rstd = row_rstd(v);
        modulate_store(v, rstd, g, modsh + (size_t)b * NMOD, modsc + (size_t)b * NMOD, out + (size_t)row * DM, F.lane); }
}

constexpr float NEG_S = -3.0e38f;
__device__ __forceinline__ void p3_qknorm(Frame& F, const Args& A) {
    const bf16* P0 = (const bf16*)(F.ws + WS_P0); bf16* QN = (bf16*)(F.ws + WS_QN); bf16* KN = (bf16*)(F.ws + WS_KN);
    const float* gq = (const float*)A.in[10]; const float* gk = (const float*)A.in[11];
    const int gw = F.bid * NWAVES + F.wave, NGW = F.G * NWAVES, li = F.lane & 15, g4 = F.lane >> 4;
    const float QS = 0.08838834764831845f * LOG2E;
    float gqv[8], gkv[8];
#pragma unroll
    for (int e = 0; e < 8; ++e) { gqv[e] = gq[8 * li + e] * QS; gkv[e] = gk[8 * li + e]; }
    for (int tok = gw; tok < MTOK; tok += NGW) {
        const bf16* pr = P0 + (size_t)tok * A_INP;
#pragma unroll
        for (int i = 0; i < 5; ++i) { const int head = 4 * i + g4;
            const v4u w = *(const v4u*)(pr + head * 128 + 8 * li);
            float x[8] = {bflo(w.x), bfhi(w.x), bflo(w.y), bfhi(w.y), bflo(w.z), bfhi(w.z), bflo(w.w), bfhi(w.w)};
            float ss = 0.f;
#pragma unroll
            for (int e = 0; e < 8; ++e) ss += x[e] * x[e];
            ss += __shfl_xor(ss, 8); ss += __shfl_xor(ss, 4); ss += __shfl_xor(ss, 2); ss += __shfl_xor(ss, 1);
            const float rstd = 1.0f / sqrtf(ss * (1.0f / 128.0f) + EPS);
            v4u o;
            if (i < 4) { o.x = pk2(x[0] * rstd * gqv[0], x[1] * rstd * gqv[1]); o.y = pk2(x[2] * rstd * gqv[2], x[3] * rstd * gqv[3]); o.z = pk2(x[4] * rstd * gqv[4], x[5] * rstd * gqv[5]); o.w = pk2(x[6] * rstd * gqv[6], x[7] * rstd * gqv[7]);
                *(v4u*)(QN + (size_t)tok * DM + head * 128 + 8 * li) = o; }
            else { o.x = pk2(x[0] * rstd * gkv[0], x[1] * rstd * gkv[1]); o.y = pk2(x[2] * rstd * gkv[2], x[3] * rstd * gkv[3]); o.z = pk2(x[4] * rstd * gkv[4], x[5] * rstd * gkv[5]); o.w = pk2(x[6] * rstd * gkv[6], x[7] * rstd * gkv[7]);
                *(v4u*)(KN + (size_t)tok * 512 + (head - 16) * 128 + 8 * li) = o; }
        }
    }
}
__device__ __forceinline__ void p3_vtrans(Frame& F) {
    const bf16* P0 = (const bf16*)(F.ws + WS_P0); bf16* VT = (bf16*)(F.ws + WS_VT);
    LAS unsigned* tile = (LAS unsigned*)F.lds;
    for (int item = F.bid; item < MTOK / 64; item += F.G) { const int tok0 = item * 64, b = tok0 >> 11, t0 = tok0 & 2047;
        __syncthreads();
#pragma unroll
        for (int p = 0; p < 8; ++p) { const int row = p * 8 + (F.tid >> 6), cw = (F.tid & 63) * 4;
            const v4u w = *(const v4u*)(P0 + (size_t)(tok0 + row) * A_INP + C_V + 2 * cw);
            tile[row * 257 + cw] = w.x; tile[row * 257 + cw + 1] = w.y; tile[row * 257 + cw + 2] = w.z; tile[row * 257 + cw + 3] = w.w; }
        __syncthreads();
#pragma unroll
        for (int p = 0; p < 8; ++p) { const int task = p * 512 + F.tid, tg = task & 7, col = task >> 3;
            const LAS unsigned short* tp = (const LAS unsigned short*)tile + col;
            unsigned short h[8];
#pragma unroll
            for (int i = 0; i < 8; ++i) h[i] = tp[(size_t)(tg * 8 + i) * 514];
            v4u o; o.x = h[0] | ((unsigned)h[1] << 16); o.y = h[2] | ((unsigned)h[3] << 16); o.z = h[4] | ((unsigned)h[5] << 16); o.w = h[6] | ((unsigned)h[7] << 16);
            *(v4u*)(VT + ((size_t)(b * 512 + col)) * SEQ + t0 + tg * 8) = o; }
    }
    __syncthreads();
}
__device__ __forceinline__ void p3_indexer_pair(Frame& F, int pair) {
    const bf16* P0 = (const bf16*)(F.ws + WS_P0); unsigned* MASK = (unsigned*)(F.ws + WS_MASK);
    const int b = pair >> 10, t0 = (pair & 1023) * 2, lane = F.lane, c = lane & 31, hh = lane >> 5;
    const bf16* Pb = P0 + (size_t)b * SEQ * A_INP;
    const int qsel = (c >> 2) & 1, ahead = (c & 3) + 4 * (c >> 3);
    const bf16* ap = Pb + (size_t)(t0 + qsel) * A_INP + C_QI + ahead * 64 + 8 * hh;
    bf16x8 af[4];
#pragma unroll
    for (int ks = 0; ks < 4; ++ks) af[ks] = *(const bf16x8*)(ap + 16 * ks);
    const bf16* wp = Pb + (size_t)(t0 + hh) * A_INP + C_WI;
    const v4u w0 = *(const v4u*)wp, w1 = *(const v4u*)(wp + 8);
    const float WS_ = 0.25f * 0.125f;
    const float wv[16] = {bflo(w0.x) * WS_, bfhi(w0.x) * WS_, bflo(w0.y) * WS_, bfhi(w0.y) * WS_, bflo(w0.z) * WS_, bfhi(w0.z) * WS_, bflo(w0.w) * WS_, bfhi(w0.w) * WS_,
                          bflo(w1.x) * WS_, bfhi(w1.x) * WS_, bflo(w1.y) * WS_, bfhi(w1.y) * WS_, bflo(w1.z) * WS_, bfhi(w1.z) * WS_, bflo(w1.w) * WS_, bfhi(w1.w) * WS_};
    const int tq = t0 + hh, ktmax = (t0 + 1) >> 5;
    LAS float* scL = (LAS float*)(F.lds + F.wave * 16384) + lane;
#define IDX_LOAD(dst, kg_) do { const bf16* bp_ = Pb + (size_t)(128 * (kg_) + c) * A_INP + C_KI + 8 * hh; \
        _Pragma("unroll") for (int u = 0; u < 4; ++u) _Pragma("unroll") for (int ks = 0; ks < 4; ++ks) dst[u][ks] = *(const bf16x8*)(bp_ + (size_t)(32 * u) * A_INP + 16 * ks); } while (0)
#define IDX_COMP(src, kg_) do { _Pragma("unroll") for (int u = 0; u < 4; ++u) { f32x16 d; \
            _Pragma("unroll") for (int t = 0; t < 16; ++t) d[t] = 0.f; \
            _Pragma("unroll") for (int ks = 0; ks < 4; ++ks) d = MFMA32(af[ks], src[u][ks], d); \
            float s_ = 0.f; \
            _Pragma("unroll") for (int t = 0; t < 16; ++t) s_ += fmaxf(d[t], 0.f) * wv[t]; \
            scL[(4 * (kg_) + u) * 64] = (32 * (4 * (kg_) + u) + c <= tq) ? s_ : NEG_S; } } while (0)
    { const int ng = (ktmax >> 2) + 1;
      bf16x8 bA[4][4], bB[4][4];
      IDX_LOAD(bA, 0);
      for (int kg = 0; kg < ng; kg += 2) {
          if (kg + 1 < ng) IDX_LOAD(bB, kg + 1);
          IDX_COMP(bA, kg);
          if (kg + 1 < ng) { if (kg + 2 < ng) IDX_LOAD(bA, kg + 2); IDX_COMP(bB, kg + 1); }
      } }
#undef IDX_LOAD
#undef IDX_COMP
    LDS_WAIT();
    float sc[64];
#pragma unroll
    for (int k = 0; k < 64; ++k) { const float v = scL[k * 64]; sc[k] = (k <= ktmax) ? v : NEG_S; }
    LDS_WAIT();
    float mx = NEG_S, mn = 3.0e38f;
#pragma unroll
    for (int k = 0; k < 64; ++k) { mx = fmaxf(mx, sc[k]); mn = (sc[k] > -1.0e38f) ? fminf(mn, sc[k]) : mn; }
#pragma unroll
    for (int o = 16; o >= 1; o >>= 1) { mx = fmaxf(mx, __shfl_xor(mx, o)); mn = fminf(mn, __shfl_xor(mn, o)); }
    bool done = (tq + 1 <= 256); float lo = mn, hi = mx, thr = done ? -1.0e38f : mn;
    for (int it = 0; it < 48; ++it) {
        if (__all(done)) break;
        const float mid = 0.5f * (lo + hi);
        int cnt = 0;
#pragma unroll
        for (int k = 0; k < 64; ++k) cnt += (sc[k] >= mid) ? 1 : 0;
#pragma unroll
        for (int o = 16; o >= 1; o >>= 1) cnt += __shfl_xor(cnt, o);
        if (!done) {
            if (!(mid > lo) || !(mid < hi)) { done = true; thr = lo; }
            else if (cnt >= 256) { lo = mid; thr = mid; done = (cnt == 256); }
            else hi = mid;
        }
    }
    unsigned wA = 0u, wB = 0u;
#pragma unroll
    for (int k = 0; k < 64; ++k) { const unsigned long long bal = __ballot(sc[k] >= thr); if (lane == k) { wA = (unsigned)bal; wB = (unsigned)(bal >> 32); } }
    MASK[((size_t)b * SEQ + t0) * 64 + lane] = wA; MASK[((size_t)b * SEQ + t0 + 1) * 64 + lane] = wB;
}

__device__ __forceinline__ int kperm(int r) { return (r & ~12) | ((r & 4) << 1) | ((r & 8) >> 1); }
constexpr int P4_TAB = 0, P4_POS = 32768, P4_MASK = 40960, P4_MPITCH = 65, P4_NSLOT = 3, P4_K = 57600, P4_V = P4_K + P4_NSLOT * 8192, P4_END = P4_V + P4_NSLOT * 8192;
static_assert(P4_MASK + 64 * P4_MPITCH * 4 <= P4_K && P4_END <= RING_BYTES, "P4 LDS map");
__device__ __forceinline__ void p4_attn_item(Frame& F, const Args& A, int item) {
    const bf16* QN = (const bf16*)(F.ws + WS_QN); const bf16* KN = (const bf16*)(F.ws + WS_KN); const bf16* VT = (const bf16*)(F.ws + WS_VT);
    const unsigned* MASK = (const unsigned*)(F.ws + WS_MASK); const float* BT = (const float*)(F.ws + WS_BT); bf16* OB = (bf16*)(F.ws + WS_O);
    const int* pos = (const int*)A.in[2];
    const int qt = item >> 4, bk = item & 15, b = bk >> 2, kvh = bk & 3;
    LAS float* tab = (LAS float*)(F.lds + P4_TAB); LAS int* posL = (LAS int*)(F.lds + P4_POS); LAS unsigned* maskL = (LAS unsigned*)(F.lds + P4_MASK);
    const int w = F.wave, hd = w & 3, head = kvh * 4 + hd, qw0 = qt * 64 + 32 * (w >> 2), lane = F.lane, c = lane & 31, hh = lane >> 5;
    const size_t tokq = (size_t)b * SEQ + qw0 + c;
    __syncthreads();
    for (int i = F.tid; i < 4 * 2048; i += NWAVES * 64) tab[i] = BT[kvh * 4 * 2048 + i];
    for (int i = F.tid; i < SEQ; i += NWAVES * 64) posL[i] = pos[b * SEQ + i];
    for (int i = F.tid; i < 64 * 64; i += NWAVES * 64) maskL[(i >> 6) * P4_MPITCH + (i & 63)] = MASK[((size_t)b * SEQ + qt * 64 + (i >> 6)) * 64 + (i & 63)];
    if (F.tid == 0) F.MISC[20] = 1u;
    const bf16* qp = QN + tokq * DM + head * 128 + 8 * hh;
    bf16x8 qf[8];
#pragma unroll
    for (int ks = 0; ks < 8; ++ks) qf[ks] = *(const bf16x8*)(qp + 16 * ks);
    __syncthreads();
    for (int i = F.tid; i < SEQ - 1; i += NWAVES * 64) if (posL[i + 1] != posL[i] + 1) F.MISC[20] = 0u;
    __syncthreads();
    const bool contig = F.MISC[20] != 0u;
    const int krow = 4 * w + (lane >> 4), kch = (lane & 15) ^ (krow & 15);
    const bf16* kg = KN + ((size_t)b * SEQ + krow) * 512 + kvh * 128 + 8 * kch;
    const int vd = 16 * w + (lane >> 2), vch = (lane & 3) ^ ((vd >> 2) & 3);
    const bf16* vg = VT + ((size_t)(b * 4 + kvh) * 128 + vd) * SEQ + 8 * vch;
    LAS unsigned char* kdst = F.lds + P4_K + 1024 * w; LAS unsigned char* vdst = F.lds + P4_V + 1024 * w;
#define P4_DMA(kt_, slot_) do { const int sl_ = (slot_) * 8192; \
        __builtin_amdgcn_global_load_lds((const unsigned*)(kg + (size_t)(kt_) * 32 * 512), (LAS unsigned*)(kdst + sl_), 16, 0, 0); \
        __builtin_amdgcn_global_load_lds((const unsigned*)(vg + (kt_) * 32), (LAS unsigned*)(vdst + sl_), 16, 0, 0); } while (0)
    const int pq = posL[qw0 + c], pos0 = posL[0];
    const LAS float* tb = tab + hd * 2048;
    const LAS unsigned* mrow = maskL + (32 * (w >> 2) + c) * P4_MPITCH;
    f32x16 O[4];
#pragma unroll
    for (int db = 0; db < 4; ++db)
#pragma unroll
        for (int t = 0; t < 16; ++t) O[db][t] = 0.f;
    float m = -1.0e29f, l = 0.f;
    const int ktmax = (qw0 + 31) >> 5, nkt = 2 * qt + 2;
    const int prow = kperm(c);
    const LAS unsigned char* kfrag = F.lds + P4_K + prow * 256;
    const LAS unsigned char* vfrag = F.lds + P4_V + c * 64;
    P4_DMA(0, 0); P4_DMA(1, 1);
    asm volatile("s_waitcnt vmcnt(2)" ::: "memory"); __builtin_amdgcn_s_barrier(); asm volatile("" ::: "memory");
    int cslot = 0, nslot = 2;
    for (int kt = 0; kt < nkt; ++kt) {
        const int sl = cslot * 8192;
        if (kt + 2 < nkt) P4_DMA(kt + 2, nslot);
        if (kt <= ktmax) {
            const int key0 = kt * 32;
            f32x16 S;
#pragma unroll
            for (int t = 0; t < 16; ++t) S[t] = 0.f;
#pragma unroll
            for (int ks = 0; ks < 8; ++ks) { const bf16x8 kf = *(const LAS bf16x8*)(kfrag + sl + (((2 * ks + hh) ^ (prow & 15)) << 4)); S = MFMA32(kf, qf[ks], S); }
            const unsigned mw = mrow[kt] >> (8 * hh);
            float s[16]; float mx = -1.0e29f;
            if (contig) {
                const LAS float* tbp = tb + (pq - pos0 - key0 - 8 * hh - 23);
#pragma unroll
                for (int t = 0; t < 16; ++t) { const int bit = (t & 7) + 16 * (t >> 3);
                    const float v = S[t] + tbp[23 - bit];
                    s[t] = ((mw >> bit) & 1u) ? v : -1.0e30f; mx = fmaxf(mx, s[t]); }
            } else {
                const i32x4 p0 = *(const LAS i32x4*)(posL + key0 + 8 * hh), p1 = *(const LAS i32x4*)(posL + key0 + 8 * hh + 4), p2 = *(const LAS i32x4*)(posL + key0 + 16 + 8 * hh), p3 = *(const LAS i32x4*)(posL + key0 + 16 + 8 * hh + 4);
                const int pk[16] = {p0.x, p0.y, p0.z, p0.w, p1.x, p1.y, p1.z, p1.w, p2.x, p2.y, p2.z, p2.w, p3.x, p3.y, p3.z, p3.w};
#pragma unroll
                for (int t = 0; t < 16; ++t) { const int bit = (t & 7) + 16 * (t >> 3);
                    int idx = pq - pk[t]; idx = idx < 0 ? 0 : (idx > 2047 ? 2047 : idx);
                    const float v = S[t] + tb[idx];
                    s[t] = ((mw >> bit) & 1u) ? v : -1.0e30f; mx = fmaxf(mx, s[t]); }
            }
            mx = fmaxf(mx, __shfl_xor(mx, 32));
            const float mnew = fmaxf(m, mx);
            float p[16]; float ls = 0.f;
#pragma unroll
            for (int t = 0; t < 16; ++t) { p[t] = __builtin_amdgcn_exp2f(s[t] - mnew); ls += p[t]; }
            if (!__all(mnew == m)) {
                const float alpha = __builtin_amdgcn_exp2f(m - mnew); l *= alpha;
#pragma unroll
                for (int db = 0; db < 4; ++db)
#pragma unroll
                    for (int t = 0; t < 16; ++t) O[db][t] *= alpha;
            }
            l += ls; m = mnew;
            const bf16x8 pf0 = pack8(p[0], p[1], p[2], p[3], p[4], p[5], p[6], p[7]), pf1 = pack8(p[8], p[9], p[10], p[11], p[12], p[13], p[14], p[15]);
            const int vsw = (c >> 2) & 3;
#pragma unroll
            for (int db = 0; db < 4; ++db) {
                const bf16x8 v0 = *(const LAS bf16x8*)(vfrag + sl + 32 * 64 * db + (((0 + hh) ^ vsw) << 4)), v1 = *(const LAS bf16x8*)(vfrag + sl + 32 * 64 * db + (((2 + hh) ^ vsw) << 4));
                O[db] = MFMA32(v0, pf0, O[db]); O[db] = MFMA32(v1, pf1, O[db]); }
        }
        if (kt + 2 < nkt) asm volatile("s_waitcnt vmcnt(2) lgkmcnt(0)" ::: "memory"); else asm volatile("s_waitcnt vmcnt(0) lgkmcnt(0)" ::: "memory");
        __builtin_amdgcn_s_barrier(); asm volatile("" ::: "memory");
        cslot = cslot == 2 ? 0 : cslot + 1; nslot = nslot == 2 ? 0 : nslot + 1;
    }
#undef P4_DMA
    l += __shfl_xor(l, 32);
    const float inv = 1.0f / l;
    bf16* op = OB + tokq * DM + head * 128 + 4 * hh;
#pragma unroll
    for (int db = 0; db < 4; ++db)
#pragma unroll
        for (int g = 0; g < 4; ++g) { v2u w2; w2.x = pk2(O[db][4 * g] * inv, O[db][4 * g + 1] * inv); w2.y = pk2(O[db][4 * g + 2] * inv, O[db][4 * g + 3] * inv); *(v2u*)(op + 32 * db + 8 * g) = w2; }
}

__device__ __forceinline__ void p11_qknorm(Frame& F, const Args& A) {
    const bf16* KV = (const bf16*)(F.ws + WS_KV); const bf16* Q1 = (const bf16*)(F.ws + WS_Q1); bf16* K1N = (bf16*)(F.ws + WS_K1N); bf16* Q1N = (bf16*)(F.ws + WS_Q1N);
    const float* gk = (const float*)A.in[16]; const float* gq = (const float*)A.in[19];
    const int gw = F.bid * NWAVES + F.wave, NGW = F.G * NWAVES, li = F.lane & 7, g8 = F.lane >> 3;
    const float QS = 0.125f * LOG2E;
    float gqv[8], gkv[8];
#pragma unroll
    for (int e = 0; e < 8; ++e) { gqv[e] = gq[8 * li + e] * QS; gkv[e] = gk[8 * li + e]; }
    for (int tok = gw; tok < MTOK; tok += NGW) {
#pragma unroll
        for (int i = 0; i < 12; ++i) { const int head = 8 * (i % 6) + g8; const bool isq = i < 6;
            const bf16* src = isq ? Q1 + (size_t)tok * 3072 : KV + (size_t)tok * 6144;
            const v4u w = *(const v4u*)(src + head * 64 + 8 * li);
            float x[8] = {bflo(w.x), bfhi(w.x), bflo(w.y), bfhi(w.y), bflo(w.z), bfhi(w.z), bflo(w.w), bfhi(w.w)};
            float ss = 0.f;
#pragma unroll
            for (int e = 0; e < 8; ++e) ss += x[e] * x[e];
            ss += __shfl_xor(ss, 4); ss += __shfl_xor(ss, 2); ss += __shfl_xor(ss, 1);
            const float rstd = 1.0f / sqrtf(ss * (1.0f / 64.0f) + EPS);
            v4u o;
            if (isq) { o.x = pk2(x[0] * rstd * gqv[0], x[1] * rstd * gqv[1]); o.y = pk2(x[2] * rstd * gqv[2], x[3] * rstd * gqv[3]); o.z = pk2(x[4] * rstd * gqv[4], x[5] * rstd * gqv[5]); o.w = pk2(x[6] * rstd * gqv[6], x[7] * rstd * gqv[7]);
                *(v4u*)(Q1N + (size_t)tok * 3072 + head * 64 + 8 * li) = o; }
            else { o.x = pk2(x[0] * rstd * gkv[0], x[1] * rstd * gkv[1]); o.y = pk2(x[2] * rstd * gkv[2], x[3] * rstd * gkv[3]); o.z = pk2(x[4] * rstd * gkv[4], x[5] * rstd * gkv[5]); o.w = pk2(x[6] * rstd * gkv[6], x[7] * rstd * gkv[7]);
                *(v4u*)(K1N + (size_t)tok * 3072 + head * 64 + 8 * li) = o; }
        }
    }
}
__device__ __forceinline__ void p11_vtrans(Frame& F) {
    const bf16* KV = (const bf16*)(F.ws + WS_KV); bf16* VT1 = (bf16*)(F.ws + WS_VT1);
    LAS unsigned* tile = (LAS unsigned*)F.lds;
    for (int item = F.bid; item < NB * 3 * 16 * 4; item += F.G) {
        const int cg = item & 3, ch = (item >> 2) & 15, bg = item >> 6, g = bg % 3, b = bg / 3, t0 = ch * 128, lr = 2 * g, r = 1 << lr, nsub = SEQ >> lr;
        __syncthreads();
#pragma unroll
        for (int p = 0; p < 8; ++p) { const int row = p * 16 + (F.tid >> 5), cw = (F.tid & 31) * 4;
            const v4u w = *(const v4u*)(KV + (size_t)(b * SEQ + t0 + row) * 6144 + 3072 + g * 1024 + cg * 256 + 2 * cw);
            tile[row * 129 + cw] = w.x; tile[row * 129 + cw + 1] = w.y; tile[row * 129 + cw + 2] = w.z; tile[row * 129 + cw + 3] = w.w; }
        __syncthreads();
#pragma unroll
        for (int p = 0; p < 8; ++p) { const int task = p * 512 + F.tid, q = task & 15, col = task >> 4;
            const int rho = q & (r - 1), run = q >> lr;
            const LAS unsigned short* tp = (const LAS unsigned short*)tile + col;
            unsigned short h[8];
#pragma unroll
            for (int i = 0; i < 8; ++i) h[i] = tp[(size_t)(((8 * run + i) << lr) + rho) * 258];
            v4u o; o.x = h[0] | ((unsigned)h[1] << 16); o.y = h[2] | ((unsigned)h[3] << 16); o.z = h[4] | ((unsigned)h[5] << 16); o.w = h[6] | ((unsigned)h[7] << 16);
            *(v4u*)(VT1 + ((size_t)((b * 3 + g) * 1024 + cg * 256 + col)) * SEQ + rho * nsub + (t0 >> lr) + 8 * run) = o; }
    }
    __syncthreads();
}
__device__ __forceinline__ void p12_attn_item(Frame& F, const Args& A, int item) {
    const bf16* Q1N = (const bf16*)(F.ws + WS_Q1N); const bf16* K1N = (const bf16*)(F.ws + WS_K1N); const bf16* VT1 = (const bf16*)(F.ws + WS_VT1);
    const float* BT = (const float*)(F.ws + WS_BT); bf16* OG = (bf16*)(F.ws + WS_OG); float* LSE = (float*)(F.ws + WS_LSE);
    const int* pos = (const int*)A.in[2];
    const int jb = item & 7, head = (item >> 3) & 15, bg = item >> 7, g = bg % 3, b = bg / 3, lr = 2 * g, nsub = SEQ >> lr, tps = nsub >> 5;
    LAS float* tab = (LAS float*)F.lds; LAS int* posL = (LAS int*)(F.lds + 8192);
    __syncthreads();
    for (int i = F.tid; i < 2048; i += NWAVES * 64) { tab[i] = BT[head * 2048 + i]; posL[i] = pos[b * SEQ + i]; }
    __syncthreads();
    const int j = 8 * jb + F.wave, rho = j / tps, n0 = 32 * (j % tps), lane = F.lane, c = lane & 31, hh = lane >> 5;
    const int tq = ((n0 + c) << lr) + rho;
    const size_t tokq = (size_t)b * SEQ + tq;
    const bf16* qp = Q1N + tokq * 3072 + g * 1024 + head * 64 + 8 * hh;
    bf16x8 qf[4];
#pragma unroll
    for (int ks = 0; ks < 4; ++ks) qf[ks] = *(const bf16x8*)(qp + 16 * ks);
    const int pq = posL[tq];
    f32x16 O[2];
#pragma unroll
    for (int db = 0; db < 2; ++db)
#pragma unroll
        for (int t = 0; t < 16; ++t) O[db][t] = 0.f;
    float m = -1.0e29f, l = 0.f;
    const bf16* kcol = K1N + (size_t)b * SEQ * 3072 + g * 1024 + head * 64 + 8 * hh;
    const bf16* vbase = VT1 + ((size_t)((b * 3 + g) * 1024 + head * 64 + c)) * SEQ + rho * nsub + 8 * hh;
    const int pc = kperm(c), nq = n0 + c;
    bf16x8 kf[5][4], vf[5][4];
#pragma unroll
    for (int ti = 0; ti < 5; ++ti) { const int kb = n0 - 128 + 32 * ti, kbc = kb < 0 ? 0 : kb;
        const bf16* kp = kcol + (size_t)(((kbc + pc) << lr) + rho) * 3072;
#pragma unroll
        for (int ks = 0; ks < 4; ++ks) kf[ti][ks] = *(const bf16x8*)(kp + 16 * ks);
#pragma unroll
        for (int db = 0; db < 2; ++db) { vf[ti][2 * db] = *(const bf16x8*)(vbase + (size_t)(32 * db) * SEQ + kbc); vf[ti][2 * db + 1] = *(const bf16x8*)(vbase + (size_t)(32 * db) * SEQ + kbc + 16); } }
#pragma unroll
    for (int ti = 0; ti < 5; ++ti) {
        const int kb = n0 - 128 + 32 * ti;
        if (kb < 0) continue;
        f32x16 S;
#pragma unroll
        for (int t = 0; t < 16; ++t) S[t] = 0.f;
#pragma unroll
        for (int ks = 0; ks < 4; ++ks) S = MFMA32(kf[ti][ks], qf[ks], S);
        float s[16]; float mx = -1.0e29f;
#pragma unroll
        for (int t = 0; t < 16; ++t) { const int nk = kb + (t & 7) + 8 * hh + 16 * (t >> 3);
            int idx = pq - posL[(nk << lr) + rho]; idx = idx < 0 ? 0 : (idx > 2047 ? 2047 : idx);
            const float v = S[t] + tab[idx];
            s[t] = (nk <= nq && nk >= nq - 128) ? v : -1.0e30f; mx = fmaxf(mx, s[t]); }
        mx = fmaxf(mx, __shfl_xor(mx, 32));
        const float mnew = fmaxf(m, mx);
        float p[16]; float ls = 0.f;
#pragma unroll
        for (int t = 0; t < 16; ++t) { p[t] = __builtin_amdgcn_exp2f(s[t] - mnew); ls += p[t]; }
        if (!__all(mnew == m)) { const float alpha = __builtin_amdgcn_exp2f(m - mnew); l *= alpha;
#pragma unroll
            for (int db = 0; db < 2; ++db)
#pragma unroll
                for (int t = 0; t < 16; ++t) O[db][t] *= alpha; }
        l += ls; m = mnew;
        const bf16x8 pf0 = pack8(p[0], p[1], p[2], p[3], p[4], p[5], p[6], p[7]), pf1 = pack8(p[8], p[9], p[10], p[11], p[12], p[13], p[14], p[15]);
#pragma unroll
        for (int db = 0; db < 2; ++db) { O[db] = MFMA32(vf[ti][2 * db], pf0, O[db]); O[db] = MFMA32(vf[ti][2 * db + 1], pf1, O[db]); }
    }
    l += __shfl_xor(l, 32);
    const float inv = 1.0f / l;
    bf16* op = OG + tokq * 3072 + g * 1024 + head * 64 + 4 * hh;
#pragma unroll
    for (int db = 0; db < 2; ++db)
#pragma unroll
        for (int gg = 0; gg < 4; ++gg) { v2u w2; w2.x = pk2(O[db][4 * gg] * inv, O[db][4 * gg + 1] * inv); w2.y = pk2(O[db][4 * gg + 2] * inv, O[db][4 * gg + 3] * inv); *(v2u*)(op + 32 * db + 8 * gg) = w2; }
    if (hh == 0) LSE[tokq * 48 + g * 16 + head] = m + __builtin_amdgcn_logf(l);
}
__device__ __forceinline__ void p13_merge(Frame& F) {
    const bf16* OG = (const bf16*)(F.ws + WS_OG); const float* LSE = (const float*)(F.ws + WS_LSE); bf16* O1 = (bf16*)(F.ws + WS_O1);
    const int gt = F.bid * (NWAVES * 64) + F.tid, NT = F.G * NWAVES * 64;
    for (int i = gt; i < MTOK * 128; i += NT) { const int tok = i >> 7, c8 = i & 127, head = c8 >> 3;
        const float l0 = LSE[(size_t)tok * 48 + head], l1 = LSE[(size_t)tok * 48 + 16 + head], l2 = LSE[(size_t)tok * 48 + 32 + head];
        const float mm = fmaxf(l0, fmaxf(l1, l2)); float w0 = __builtin_amdgcn_exp2f(l0 - mm), w1 = __builtin_amdgcn_exp2f(l1 - mm), w2 = __builtin_amdgcn_exp2f(l2 - mm);
        const float inv = 1.0f / (w0 + w1 + w2); w0 *= inv; w1 *= inv; w2 *= inv;
        const v4u a = *(const v4u*)(OG + (size_t)tok * 3072 + c8 * 8), bb = *(const v4u*)(OG + (size_t)tok * 3072 + 1024 + c8 * 8), cc = *(const v4u*)(OG + (size_t)tok * 3072 + 2048 + c8 * 8);
        v4u o;
        o.x = pk2(w0 * bflo(a.x) + w1 * bflo(bb.x) + w2 * bflo(cc.x), w0 * bfhi(a.x) + w1 * bfhi(bb.x) + w2 * bfhi(cc.x));
        o.y = pk2(w0 * bflo(a.y) + w1 * bflo(bb.y) + w2 * bflo(cc.y), w0 * bfhi(a.y) + w1 * bfhi(bb.y) + w2 * bfhi(cc.y));
        o.z = pk2(w0 * bflo(a.z) + w1 * bflo(bb.z) + w2 * bflo(cc.z), w0 * bfhi(a.z) + w1 * bfhi(bb.z) + w2 * bfhi(cc.z));
        o.w = pk2(w0 * bflo(a.w) + w1 * bflo(bb.w) + w2 * bflo(cc.w), w0 * bfhi(a.w) + w1 * bfhi(bb.w) + w2 * bfhi(cc.w));
        *(v4u*)(O1 + (size_t)tok * 1024 + c8 * 8) = o; }
}

__device__ __forceinline__ void p15_norm_route(Frame& F, const Args& A) {
    const float* X = A.out; const float* MOD = (const float*)(F.ws + WS_MOD); bf16* HA = (bf16*)(F.ws + WS_HA);
    const float* g = (const float*)A.in[7] + DM; const float* router = (const float*)A.in[23]; const float* rb = (const float*)A.in[24];
    int* r_exp = (int*)(F.ws + WS_ROUTE); int* r_pos = r_exp + 2 * MTOK; float* r_gate = (float*)(r_pos + 2 * MTOK);
    LAS float* RT = (LAS float*)F.lds;
    __syncthreads();
    for (int i = F.tid; i < DM * NEXP; i += NWAVES * 64) RT[(i & 7) * DM + (i >> 3)] = router[i];
    __syncthreads();
    const int gw = F.bid * NWAVES + F.wave, NGW = F.G * NWAVES;
    for (int row = gw; row < MTOK; row += NGW) { const int b = row >> 11;
        f32x4 v[8]; const float* xr = X + (size_t)row * DM + 4 * F.lane;
#pragma unroll
        for (int j = 0; j < 8; ++j) v[j] = *(const f32x4*)(xr + 256 * j);
        const float rstd = row_rstd(v);
        const float* sh = MOD + (size_t)b * NMOD + 12288 + 6144; const float* sc = MOD + (size_t)b * NMOD + 12288 + 8192;
        float lg[8];
#pragma unroll
        for (int e = 0; e < 8; ++e) lg[e] = 0.f;
        bf16* orow = HA + (size_t)row * DM;
#pragma unroll
        for (int j = 0; j < 8; ++j) { const int col = 4 * F.lane + 256 * j;
            const f32x4 gg = *(const f32x4*)(g + col), s1 = *(const f32x4*)(sc + col), s0 = *(const f32x4*)(sh + col);
            const f32x4 y = v[j] * rstd * gg * (s1 + 1.0f) + s0;
            v2u w; w.x = pk2(y.x, y.y); w.y = pk2(y.z, y.w); *(v2u*)(orow + col) = w;
#pragma unroll
            for (int e = 0; e < 8; ++e) { const f32x4 rr = *(const LAS f32x4*)(RT + e * DM + col); lg[e] += (y.x * rr.x + y.y * rr.y) + (y.z * rr.z + y.w * rr.w); }
            asm volatile("" ::: "memory"); }
#pragma unroll
        for (int e = 0; e < 8; ++e) lg[e] = wave_sum(lg[e]) + rb[e];
        int e0 = 0; float v0 = lg[0];
#pragma unroll
        for (int e = 1; e < 8; ++e) if (lg[e] > v0) { v0 = lg[e]; e0 = e; }
        int e1 = -1; float v1 = -3.0e38f;
#pragma unroll
        for (int e = 0; e < 8; ++e) if (e != e0 && lg[e] > v1) { v1 = lg[e]; e1 = e; }
        const float g1 = 1.0f / (1.0f + __expf(v0 - v1)), g0 = 1.0f - g1;
        if (F.lane == 0) {
            const unsigned p0 = __hip_atomic_fetch_add((unsigned*)(F.ctl + CW_CNT + 64 * e0), 1u, RLX_AGENT);
            const unsigned p1 = __hip_atomic_fetch_add((unsigned*)(F.ctl + CW_CNT + 64 * e1), 1u, RLX_AGENT);
            r_exp[2 * row] = e0; r_exp[2 * row + 1] = e1; r_pos[2 * row] = (int)p0; r_pos[2 * row + 1] = (int)p1; r_gate[2 * row] = g0; r_gate[2 * row + 1] = g1;
        }
    }
}
__device__ __forceinline__ void moe_offsets(Frame& F, int (&off)[9]) {
    off[0] = 0;
#pragma unroll
    for (int e = 0; e < 8; ++e) { const unsigned cnt = __hip_atomic_load((unsigned*)(F.ctl + CW_CNT + 64 * e), RLX_AGENT); off[e + 1] = off[e] + (int)((cnt + 255u) & ~255u); }
}
__device__ __forceinline__ void p16_gather(Frame& F) {
    const bf16* HA = (const bf16*)(F.ws + WS_HA); bf16* AS = (bf16*)(F.ws + WS_AS); float* RG = (float*)(F.ws + WS_RG); int* TR = (int*)(F.ws + WS_TR);
    const int* r_exp = (const int*)(F.ws + WS_ROUTE); const int* r_pos = r_exp + 2 * MTOK; const float* r_gate = (const float*)(r_pos + 2 * MTOK);
    int off[9]; moe_offsets(F, off);
    const int gw = F.bid * NWAVES + F.wave, NGW = F.G * NWAVES;
    for (int idx = gw; idx < 2 * MTOK; idx += NGW) {
        const int e = r_exp[idx], p = r_pos[idx]; int base = 0;
#pragma unroll
        for (int k = 1; k < 8; ++k) base = (e >= k) ? off[k] : base;
        const int row = base + p, tok = idx >> 1;
        const v4u* src = (const v4u*)(HA + (size_t)tok * DM) + F.lane; v4u* dst = (v4u*)(AS + (size_t)row * DM) + F.lane;
        const v4u a = src[0], b2 = src[64], c2 = src[128], d2 = src[192];
        dst[0] = a; dst[64] = b2; dst[128] = c2; dst[192] = d2;
        if (F.lane == 0) { RG[row] = r_gate[idx]; TR[idx] = row; }
    }
}
__device__ __forceinline__ void p19_final(Frame& F, const Args& A) {
    float* X = A.out; const float* MOD = (const float*)(F.ws + WS_MOD); const bf16* Y = (const bf16*)(F.ws + WS_Y); const int* TR = (const int*)(F.ws + WS_TR);
    constexpr size_t PS = (WS_Y2 - WS_Y) / 2;
    const int gw = F.bid * NWAVES + F.wave, NGW = F.G * NWAVES;
    for (int row = gw; row < MTOK; row += NGW) { const int b = row >> 11; const int r0 = TR[2 * row], r1 = TR[2 * row + 1];
        const float* gt = MOD + (size_t)b * NMOD + 12288 + 10240 + 8 * F.lane;
        float* xr = X + (size_t)row * DM + 8 * F.lane; const bf16* y0 = Y + (size_t)r0 * DM + 8 * F.lane; const bf16* y1 = Y + (size_t)r1 * DM + 8 * F.lane;
#pragma unroll
        for (int j = 0; j < 4; ++j) { const v4u a = *(const v4u*)(y0 + 512 * j), a2 = *(const v4u*)(y0 + PS + 512 * j), c2 = *(const v4u*)(y1 + 512 * j), c3 = *(const v4u*)(y1 + PS + 512 * j);
            const f32x4 x0 = *(const f32x4*)(xr + 512 * j), x1 = *(const f32x4*)(xr + 512 * j + 4), g0 = *(const f32x4*)(gt + 512 * j), g1 = *(const f32x4*)(gt + 512 * j + 4);
            f32x4 s0v, s1v;
            s0v.x = (bflo(a.x) + bflo(a2.x)) + (bflo(c2.x) + bflo(c3.x)); s0v.y = (bfhi(a.x) + bfhi(a2.x)) + (bfhi(c2.x) + bfhi(c3.x));
            s0v.z = (bflo(a.y) + bflo(a2.y)) + (bflo(c2.y) + bflo(c3.y)); s0v.w = (bfhi(a.y) + bfhi(a2.y)) + (bfhi(c2.y) + bfhi(c3.y));
            s1v.x = (bflo(a.z) + bflo(a2.z)) + (bflo(c2.z) + bflo(c3.z)); s1v.y = (bfhi(a.z) + bfhi(a2.z)) + (bfhi(c2.z) + bfhi(c3.z));
            s1v.z = (bflo(a.w) + bflo(a2.w)) + (bflo(c2.w) + bflo(c3.w)); s1v.w = (bfhi(a.w) + bfhi(a2.w)) + (bfhi(c2.w) + bfhi(c3.w));
            *(f32x4*)(xr + 512 * j) = x0 + g0 * s0v; *(f32x4*)(xr + 512 * j + 4) = x1 + g1 * s1v; }
    }
}

constexpr int N_PHASES = 20;
__global__ void __launch_bounds__(NWAVES * 64, 2) yoco_fwd(Args args) {
    extern __shared__ __attribute__((aligned(16))) unsigned char lds[];
    Frame F;
    F.lds = (LAS unsigned char*)lds; F.MISC = (volatile LAS unsigned*)(F.lds + MISC_OFF);
    F.tid = threadIdx.x; F.lane = F.tid & 63; F.wave = __builtin_amdgcn_readfirstlane(F.tid >> 6); F.G = gridDim.x; F.bid = blockIdx.x;
    F.ws = args.ws; F.ctl = (gu32*)(args.ws + WS_CTL);
    for (int u = F.tid; u < (LDS_BYTES - LDSCTL_OFF) / 4; u += NWAVES * 64) ((LAS unsigned*)(F.lds + LDSCTL_OFF))[u] = 0u;
    __syncthreads();
    const int lo = args.ph_lo, hi = args.ph_hi;
    const bool one_launch = (hi - lo) > 1;
    XcdBarrier bar; bar.bar = (unsigned*)(F.ctl + CW_BAR); bar.x = 0; bar.st = nullptr;
    if (one_launch) bar = xcd_barrier_post((unsigned*)(F.ctl + CW_BAR), F.MISC + 8);
    int cv_cur = F.bid * NWAVES + F.wave;
#define IN(k) (lo <= (k) && (k) < hi)
#define SEAM(k) do { if (IN(k) && IN((k) + 1)) xcd_barrier(bar); } while (0)
#define TAIL_FILL(nunits, budget) do { if (one_launch) { const int nu_ = (nunits), rounds_ = (nu_ + F.G - 1) / F.G, nlast_ = nu_ - (rounds_ - 1) * F.G; \
        if (nlast_ < F.G && F.bid >= nlast_) cv_cur = conv_fixed(F, args, cv_cur, (budget)); } } while (0)
#define PH_BEGIN(k) if (IN(k)) {
#define PH_END(k)   }
    const float* const MODc = (const float*)(F.ws + WS_MOD);
    bf16* const HA = (bf16*)(F.ws + WS_HA);

    if (IN(0)) { p0_prologue(F, args); } SEAM(0);
    PH_BEGIN(1) normmod_phase(F, (const float*)args.in[0], (const float*)args.in[6], MODc + 0, MODc + 2048, HA); PH_END(1) SEAM(1);
    PH_BEGIN(2) pg8::Gemm g{HA, (const bf16*)(F.ws + WS_WIN), MTOK, A_INP, DM, DM}; pg8::StaticOrder S; S.init(MTOK, A_INP, F.G, F.bid);
        pg8::EpiBf16Sel E{(bf16*)(F.ws + WS_P0), A_INP, nullptr, 0, 0, 1 << 30};
        pg8::gemm_phase<pg8::EpiBf16Sel, pg8::StaticOrder, true, true>(F.lds + RING_OFF, g, S, E); TAIL_FILL(S.nwg, 9); PH_END(2) SEAM(2);
    PH_BEGIN(3) p3_qknorm(F, args); p3_vtrans(F);
        { const int gw = F.bid * NWAVES + F.wave, NGW = F.G * NWAVES;
          for (int q = gw; q < MTOK / 4; q += NGW) {
            const int s0 = q, s1 = MTOK / 2 - 1 - q;
            p3_indexer_pair(F, (s0 & 3) * 1024 + (s0 >> 2)); p3_indexer_pair(F, (s1 & 3) * 1024 + (s1 >> 2)); } } PH_END(3) SEAM(3);
    PH_BEGIN(4) for (int r = 0, base = 0; base < 512; ++r, base += F.G) { const int i = base + ((r & 1) ? F.G - 1 - F.bid : F.bid); if (i < 512) p4_attn_item(F, args, ((31 - (i >> 4)) << 4) | (i & 15)); } __syncthreads(); PH_END(4) SEAM(4);
    if (IN(5)) { pg8::Gemm g{(const bf16*)(F.ws + WS_O), (const bf16*)(F.ws + WS_WAOUT), MTOK, DM, DM, DM}; pg8::StaticOrder S; S.init(MTOK, DM, F.G, F.bid);
        pg8::EpiResGate E{(const float*)args.in[0], args.out, MODc + 4096, NMOD};
        pg8::gemm_phase<pg8::EpiResGate, pg8::StaticOrder, false, true>(F.lds + RING_OFF, g, S, E); } SEAM(5);
    PH_BEGIN(6) normmod_phase(F, args.out, (const float*)args.in[7], MODc + 6144, MODc + 8192, HA); PH_END(6) SEAM(6);
    PH_BEGIN(7) pg8::Gemm g{HA, (const bf16*)(F.ws + WS_WF13), MTOK, 2 * DFF, DM, DM}; pg8::StaticOrder S; S.init(MTOK, 2 * DFF, F.G, F.bid);
        pg8::EpiSwiGLU E{(bf16*)(F.ws + WS_U), DFF, 2 * DFF / 256};
        pg8::gemm_phase<pg8::EpiSwiGLU, pg8::StaticOrder, true, true>(F.lds + RING_OFF, g, S, E); TAIL_FILL(S.nwg, 12); PH_END(7) SEAM(7);
    if (IN(8)) { pg8::Gemm g{(const bf16*)(F.ws + WS_U), (const bf16*)(F.ws + WS_WF2), MTOK, DM, DFF, DFF}; pg8::StaticOrder S; S.init(MTOK, DM, F.G, F.bid);
        pg8::EpiResGate E{args.out, args.out, MODc + 10240, NMOD};
        pg8::gemm_phase<pg8::EpiResGate, pg8::StaticOrder, false, true>(F.lds + RING_OFF, g, S, E); } SEAM(8);
    PH_BEGIN(9) const float* X = args.out; const float* gk = (const float*)args.in[14]; const float* ga = (const float*)args.in[6] + DM;
        const int gw = F.bid * NWAVES + F.wave, NGW = F.G * NWAVES;
        for (int row = gw; row < MTOK; row += NGW) { const int b = row >> 11;
            f32x4 v[8]; const float* xr = X + (size_t)row * DM + 4 * F.lane;
#pragma unroll
            for (int j = 0; j < 8; ++j) v[j] = *(const f32x4*)(xr + 256 * j);
            const float rstd = row_rstd(v);
            modulate_store(v, rstd, gk, MODc + (size_t)b * NMOD + 24576, MODc + (size_t)b * NMOD + 24576 + 2048, HA + (size_t)row * DM, F.lane);
            modulate_store(v, rstd, ga, MODc + (size_t)b * NMOD + 12288, MODc + (size_t)b * NMOD + 12288 + 2048, HA + (size_t)(MTOK + row) * DM, F.lane); } PH_END(9) SEAM(9);
    PH_BEGIN(10) pg8::Gemm g{HA, (const bf16*)(F.ws + WS_WKVQ), 2 * MTOK, 9216, DM, DM}; pg8::DualOrder S; S.init(MTOK / 256, 24, 12, MTOK / 256, 24, F.G, F.bid);
        pg8::EpiBf16Sel E{(bf16*)(F.ws + WS_KV), 6144, (bf16*)(F.ws + WS_Q1), 3072, MTOK / 256, 24};
        pg8::gemm_phase<pg8::EpiBf16Sel, pg8::DualOrder, true, true>(F.lds + RING_OFF, g, S, E); TAIL_FILL(S.ntot, 12); PH_END(10) SEAM(10);
    PH_BEGIN(11) p11_qknorm(F, args); p11_vtrans(F); PH_END(11) SEAM(11);
    PH_BEGIN(12) for (int item = F.bid; item < NB * 3 * 16 * 8; item += F.G) p12_attn_item(F, args, item); __syncthreads(); PH_END(12) SEAM(12);
    PH_BEGIN(13) p13_merge(F); PH_END(13) SEAM(13);
    if (IN(14)) { pg8::Gemm g{(const bf16*)(F.ws + WS_O1), (const bf16*)(F.ws + WS_WBOUT), MTOK, DM, 1024, 1024}; pg8::StaticOrder S; S.init(MTOK, DM, F.G, F.bid);
        pg8::EpiResGate E{args.out, args.out, MODc + 12288 + 4096, NMOD};
        pg8::gemm_phase<pg8::EpiResGate, pg8::StaticOrder, false, true>(F.lds + RING_OFF, g, S, E); } SEAM(14);
    PH_BEGIN(15) p15_norm_route(F, args); PH_END(15)
    if (IN(15) && F.lane == 0) __hip_atomic_store((unsigned*)(F.ctl + CW_CUR + F.bid * NWAVES + F.wave), (unsigned)cv_cur, RLX_AGENT);
    SEAM(15);
    if (IN(16)) { p16_gather(F); conv_drain(F, args); } SEAM(16);
    if (IN(17)) { int off[9]; moe_offsets(F, off); pg8::MoeOrder S;
#pragma unroll
        for (int e = 0; e < 9; ++e) S.toff[e] = off[e] >> 8;
        S.nN = 2 * DFFE / 256; S.T = S.toff[8]; S.total = S.T * S.nN; S.G = F.G; S.c = F.bid; S.ksplit = 1; S.klen = DM;
        pg8::Gemm g{(const bf16*)(F.ws + WS_AS), (const bf16*)(F.ws + WS_WM13), MROWS, 2 * DFFE, DM, DM};
        pg8::EpiSwiGLU E{(bf16*)(F.ws + WS_UM), DFFE, 2 * DFFE / 256};
        pg8::gemm_phase<pg8::EpiSwiGLU, pg8::MoeOrder, true, true>(F.lds + RING_OFF, g, S, E); } SEAM(17);
    if (IN(18)) { int off[9]; moe_offsets(F, off); pg8::MoeOrder S;
#pragma unroll
        for (int e = 0; e < 9; ++e) S.toff[e] = off[e] >> 8;
        S.nN = DM / 256; S.T = S.toff[8]; S.total = S.T * S.nN * 2; S.G = F.G; S.c = F.bid; S.ksplit = 2; S.klen = DFFE / 2;
        pg8::Gemm g{(const bf16*)(F.ws + WS_UM), (const bf16*)(F.ws + WS_WM2), MROWS, DM, DFFE, DFFE / 2};
        pg8::EpiRowScale E{(bf16*)(F.ws + WS_Y), (const float*)(F.ws + WS_RG), DM / 256, (size_t)(WS_Y2 - WS_Y) / 2};
        pg8::gemm_phase<pg8::EpiRowScale, pg8::MoeOrder, true, true>(F.lds + RING_OFF, g, S, E); } SEAM(18);
    if (IN(19)) { p19_final(F, args); }
#undef IN
#undef SEAM
#undef PH_BEGIN
#undef PH_END
#undef TAIL_FILL
}

#ifndef MK_PER_PHASE
#define MK_PER_PHASE 0
#endif
extern "C" void kernel_launch(void* const* d_in, const int* in_sizes, int n_in, void* d_out, int out_size, void* d_ws, size_t ws_size, hipStream_t stream) {
    static int grid = 0;
    if (grid == 0) {
        if (n_in != 28 || out_size != MTOK * DM || ws_size < WS_END) { fprintf(stderr, "kernel_launch: unexpected shapes (n_in %d, out %d, ws %zu < %zu)\n", n_in, out_size, ws_size, (size_t)WS_END); grid = -1; return; }
        int dev = 0, cus = 0, per_cu = 0;
        if (hipGetDevice(&dev) != hipSuccess || hipDeviceGetAttribute(&cus, hipDeviceAttributeMultiprocessorCount, dev) != hipSuccess) { grid = -1; return; }
        if (hipFuncSetAttribute((const void*)yoco_fwd, hipFuncAttributeMaxDynamicSharedMemorySize, LDS_BYTES) != hipSuccess) { fprintf(stderr, "kernel_launch: hipFuncSetAttribute failed\n"); grid = -1; return; }
        if (hipOccupancyMaxActiveBlocksPerMultiprocessor(&per_cu, (const void*)yoco_fwd, NWAVES * 64, LDS_BYTES) != hipSuccess || per_cu < 1) fprintf(stderr, "kernel_launch: occupancy query reports %d\n", per_cu);
        (void)hipGetLastError();
        grid = cus;
    }
    if (grid < 0) return;
    if (hipMemsetAsync((char*)d_ws + WS_CTL, 0, CTL_ZERO_BYTES, stream) != hipSuccess) return;
    Args a{};
    for (int i = 0; i < 28; ++i) a.in[i] = d_in[i];
    a.out = (float*)d_out; a.ws = (unsigned char*)d_ws;
#if MK_PER_PHASE
    for (int p = 0; p < N_PHASES; ++p) { a.ph_lo = p; a.ph_hi = p + 1; hipLaunchKernelGGL(yoco_fwd, dim3(grid), dim3(NWAVES * 64), LDS_BYTES, stream, a); }
#else
    a.ph_lo = 0; a.ph_hi = N_PHASES;
    hipLaunchKernelGGL(yoco_fwd, dim3(grid), dim3(NWAVES * 64), LDS_BYTES, stream, a);
#endif
    const hipError_t le = hipPeekAtLastError();
    if (le != hipSuccess) fprintf(stderr, "kernel_launch: launch failed: %s\n", hipGetErrorName(le));
}
```
